# Optimizing an MI355X kernel written in HIP

```python
import math
import jax, jax.numpy as jnp
from jax import lax
import numpy as np

D_MODEL = 1024
BATCH = 4
SEQ = 4096
DEPTH = 4

EPS = 1e-6
CHUNK = 64
CONV_K = 4
GDN_HEADS = 4
GDN_HEAD_DIM = 128
GDN_DIM = GDN_HEADS * GDN_HEAD_DIM
SSM_HEADS = 8
SSM_HEAD_DIM = 64
SSM_INNER = SSM_HEADS * SSM_HEAD_DIM
SSM_GROUPS = 2
SSM_STATE = 128
SSM_CONV_DIM = SSM_INNER + 2 * SSM_GROUPS * SSM_STATE
MLA_HEADS = 4
MLA_Q_LORA = 512
MLA_KV_LORA = 256
MLA_NOPE = 128
MLA_ROPE = 64
MLA_V = 128
MLA_DIM = MLA_HEADS * MLA_V
ROPE_THETA = 10000.0
Q_BLOCK = 128
N_BRANCH = 3
FFN_DIM = 2816
N_EXPERTS = 8
TOP_K = 2
EXPERT_DIM = 3584
MOE_BLOCK = 256
N_DENSE = (DEPTH + 1) // 2
N_MOE = DEPTH // 2

IN_SPLITS = (
    3 * GDN_DIM,
    GDN_DIM,
    GDN_HEADS,
    GDN_HEADS,
    SSM_INNER,
    SSM_CONV_DIM,
    SSM_HEADS,
    MLA_Q_LORA,
    MLA_KV_LORA,
    MLA_ROPE,
    N_BRANCH * D_MODEL,
)
IN_DIM = sum(IN_SPLITS)

kernel_name = 'hybrid_gdn_ssd_mla_moe_block'


def rms_norm(x, w=None):
    xf = x.astype(jnp.float32)
    y = xf * lax.rsqrt(jnp.mean(xf * xf, axis=-1, keepdims=True) + EPS)
    if w is not None:
        y = y * w.astype(jnp.float32)
    return y.astype(x.dtype)


def l2_normalize(x):
    return x * lax.rsqrt(jnp.sum(x * x, axis=-1, keepdims=True) + EPS)


def split_cols(y, sizes):
    idx = [int(i) for i in np.cumsum(sizes)[:-1]]
    return jnp.split(y, idx, axis=-1)


def causal_conv(x, w, b=None):
    k = w.shape[0]
    y = lax.conv_general_dilated(x, w[:, None, :].astype(x.dtype), window_strides=(1,),
                                 padding=[(k - 1, 0)], dimension_numbers=('NWC', 'WIO', 'NWC'),
                                 feature_group_count=x.shape[-1])
    if b is not None:
        y = y + b
    return y


def swiglu(x, w_gate, w_up, w_down):
    return (jax.nn.silu(x @ w_gate) * (x @ w_up)) @ w_down


def gated_delta_net(qkv, z, a, b, conv_w, a_log, dt_bias, norm_w):
    bsz, s, _ = qkv.shape
    H, Dh, C = GDN_HEADS, GDN_HEAD_DIM, CHUNK
    nc = s // C
    f32 = jnp.float32
    qkv = jax.nn.silu(causal_conv(qkv, conv_w)).astype(f32)
    q, k, v = jnp.split(qkv, 3, axis=-1)
    q = l2_normalize(q.reshape(bsz, s, H, Dh)) * (Dh ** -0.5)
    k = l2_normalize(k.reshape(bsz, s, H, Dh))
    v = v.reshape(bsz, s, H, Dh)
    beta = jax.nn.sigmoid(b.astype(f32))
    g = -jnp.exp(a_log.astype(f32)) * jax.nn.softplus(a.astype(f32) + dt_bias.astype(f32))

    def to_chunks(t):
        return t.reshape(bsz, nc, C, H, -1).transpose(0, 3, 1, 2, 4)
    q, k, v = to_chunks(q), to_chunks(k), to_chunks(v)
    beta = beta.reshape(bsz, nc, C, H).transpose(0, 3, 1, 2)
    g = g.reshape(bsz, nc, C, H).transpose(0, 3, 1, 2)
    G = jnp.cumsum(g, axis=-1)
    incl = jnp.tril(jnp.ones((C, C), dtype=bool))
    strict = jnp.tril(jnp.ones((C, C), dtype=bool), -1)
    decay = jnp.exp(jnp.where(incl, G[..., :, None] - G[..., None, :], -jnp.inf))
    kk = jnp.einsum('bhnid,bhnjd->bhnij', k, k)
    ia = jnp.eye(C, dtype=f32) + jnp.where(strict, beta[..., :, None] * kk * decay, 0.0)
    rhs = jnp.concatenate([v * beta[..., None], k * (beta * jnp.exp(G))[..., None]], axis=-1)
    sol = lax.linalg.triangular_solve(ia, rhs, left_side=True, lower=True, unit_diagonal=True)
    u, w = jnp.split(sol, 2, axis=-1)
    qk = jnp.einsum('bhnid,bhnjd->bhnij', q, k) * decay
    q_dec = q * jnp.exp(G)[..., None]
    k_dec = k * jnp.exp(G[..., -1:] - G)[..., None]
    g_last = jnp.exp(G[..., -1])

    def step(state, inp):
        qd, kd, uc, wc, qkc, gl = inp
        v_new = uc - jnp.einsum('bhcd,bhde->bhce', wc, state)
        o = jnp.einsum('bhcd,bhde->bhce', qd, state) + jnp.einsum('bhij,bhje->bhie', qkc, v_new)
        state = state * gl[..., None, None] + jnp.einsum('bhcd,bhce->bhde', kd, v_new)
        return state, o

    xs = tuple(jnp.moveaxis(t, 2, 0) for t in (q_dec, k_dec, u, w, qk, g_last))
    _, o = lax.scan(step, jnp.zeros((bsz, H, Dh, Dh), f32), xs)
    o = o.transpose(1, 0, 3, 2, 4).reshape(bsz, s, H, Dh)
    o = rms_norm(o, norm_w) * jax.nn.silu(z.astype(f32).reshape(bsz, s, H, Dh))
    return o.reshape(bsz, s, GDN_DIM).astype(z.dtype)


def mamba2_ssd(xbc, z, dt, conv_w, conv_b, a_log, dt_bias, d_skip, norm_w):
    bsz, s, _ = xbc.shape
    H, P, Gn, N, C = SSM_HEADS, SSM_HEAD_DIM, SSM_GROUPS, SSM_STATE, CHUNK
    E = H // Gn
    nc = s // C
    f32 = jnp.float32
    xbc = jax.nn.silu(causal_conv(xbc, conv_w, conv_b)).astype(f32)
    xs, bm, cm = jnp.split(xbc, [SSM_INNER, SSM_INNER + Gn * N], axis=-1)
    x = xs.reshape(bsz, s, H, P)
    dt = jax.nn.softplus(dt.astype(f32) + dt_bias.astype(f32))
    A = -jnp.exp(a_log.astype(f32))
    X = (x * dt[..., None]).reshape(bsz, nc, C, Gn, E, P)
    ad = (dt * A).reshape(bsz, nc, C, Gn, E).transpose(0, 3, 4, 1, 2)
    bm = bm.reshape(bsz, nc, C, Gn, N)
    cm = cm.reshape(bsz, nc, C, Gn, N)
    acs = jnp.cumsum(ad, axis=-1)
    incl = jnp.tril(jnp.ones((C, C), dtype=bool))
    L = jnp.exp(jnp.where(incl, acs[..., :, None] - acs[..., None, :], -jnp.inf))
    cb = jnp.einsum('bclgn,bcsgn->bcgls', cm, bm)
    y_diag = jnp.einsum('bcgls,bgecls,bcsgep->bclgep', cb, L, X)
    decay_states = jnp.exp(acs[..., -1:] - acs)
    states = jnp.einsum('bclgn,bgecl,bclgep->cbgepn', bm, decay_states, X)
    chunk_decay = jnp.moveaxis(jnp.exp(acs[..., -1]), -1, 0)

    def step(h, inp):
        s_c, d_c = inp
        return h * d_c[..., None, None] + s_c, h

    _, prev = lax.scan(step, jnp.zeros(states.shape[1:], f32), (states, chunk_decay))
    y_off = jnp.einsum('bclgn,cbgepn,bgecl->bclgep', cm, prev, jnp.exp(acs))
    y = (y_diag + y_off).reshape(bsz, s, H, P) + d_skip.astype(f32)[:, None] * x
    y = y.reshape(bsz, s, Gn, SSM_INNER // Gn) * jax.nn.silu(z.astype(f32).reshape(bsz, s, Gn, -1))
    y = rms_norm(y, norm_w.reshape(Gn, -1))
    return y.reshape(bsz, s, SSM_INNER).astype(z.dtype)


def apply_rope(x, cos, sin):
    x1, x2 = jnp.split(x, 2, axis=-1)
    return jnp.concatenate([x1 * cos - x2 * sin, x2 * cos + x1 * sin], axis=-1)


def mla_attention(c_q, c_kv, k_r, positions, q_norm_w, w_uq, kv_norm_w, w_uk, w_uv):
    bsz, s, _ = c_q.shape
    H = MLA_HEADS
    f32 = jnp.float32
    q = (rms_norm(c_q, q_norm_w) @ w_uq).reshape(bsz, s, H, MLA_NOPE + MLA_ROPE)
    q_nope, q_rope = q[..., :MLA_NOPE], q[..., MLA_NOPE:]
    ckv = rms_norm(c_kv, kv_norm_w)
    k_nope = (ckv @ w_uk).reshape(bsz, s, H, MLA_NOPE)
    v = (ckv @ w_uv).reshape(bsz, s, H, MLA_V)
    inv_freq = ROPE_THETA ** (-jnp.arange(0, MLA_ROPE, 2, dtype=f32) / MLA_ROPE)
    ang = positions.astype(f32)[..., None] * inv_freq
    cos, sin = jnp.cos(ang), jnp.sin(ang)
    q_rope = apply_rope(q_rope.astype(f32), cos[:, :, None], sin[:, :, None])
    k_rope = apply_rope(k_r.astype(f32), cos, sin)
    scale = (MLA_NOPE + MLA_ROPE) ** -0.5
    qn = q_nope.transpose(0, 2, 1, 3)
    qr = q_rope.transpose(0, 2, 1, 3)
    kn = k_nope.transpose(0, 2, 1, 3)
    vh = v.transpose(0, 2, 1, 3)
    key_idx = jnp.arange(s)

    def attend_block(i):
        start = i * Q_BLOCK
        qn_b = lax.dynamic_slice_in_dim(qn, start, Q_BLOCK, axis=2)
        qr_b = lax.dynamic_slice_in_dim(qr, start, Q_BLOCK, axis=2)
        sc = (jnp.einsum('bhqd,bhkd->bhqk', qn_b, kn).astype(f32)
              + jnp.einsum('bhqr,bkr->bhqk', qr_b, k_rope)) * scale
        causal = (start + jnp.arange(Q_BLOCK))[:, None] >= key_idx[None, :]
        p = jax.nn.softmax(jnp.where(causal, sc, -jnp.inf), axis=-1)
        return jnp.einsum('bhqk,bhkd->bhqd', p.astype(vh.dtype), vh)

    o = lax.map(attend_block, jnp.arange(s // Q_BLOCK))
    return o.transpose(1, 0, 3, 2, 4).reshape(bsz, s, MLA_DIM)


def token_mixer(h, positions, w_in, gdn_conv_w, gdn_a_log, gdn_dt_bias, gdn_norm_w,
                ssm_conv_w, ssm_conv_b, ssm_a_log, ssm_dt_bias, ssm_d, ssm_norm_w,
                mla_q_norm_w, mla_w_uq, mla_kv_norm_w, mla_w_uk, mla_w_uv,
                w_branch_a, w_branch_b, w_branch_c, w_out):
    (gdn_qkv, gdn_z, gdn_a, gdn_b, ssm_z, ssm_xbc, ssm_dt,
     mla_cq, mla_ckv, mla_kr, gates) = split_cols(h @ w_in, IN_SPLITS)
    y_a = gated_delta_net(gdn_qkv, gdn_z, gdn_a, gdn_b, gdn_conv_w, gdn_a_log, gdn_dt_bias, gdn_norm_w)
    y_b = mamba2_ssd(ssm_xbc, ssm_z, ssm_dt, ssm_conv_w, ssm_conv_b, ssm_a_log, ssm_dt_bias, ssm_d, ssm_norm_w)
    y_c = mla_attention(mla_cq, mla_ckv, mla_kr, positions, mla_q_norm_w, mla_w_uq,
                        mla_kv_norm_w, mla_w_uk, mla_w_uv)
    g_a, g_b, g_c = jnp.split(jax.nn.sigmoid(gates), N_BRANCH, axis=-1)
    merged = g_a * (y_a @ w_branch_a) + g_b * (y_b @ w_branch_b) + g_c * (y_c @ w_branch_c)
    return merged @ w_out


def moe_ffn(h, router, w_gate, w_up, w_down):
    bsz, s, d = h.shape
    T = bsz * s
    f32 = jnp.float32
    xt = h.reshape(T, d)
    logits = (xt @ router).astype(f32)
    top_logits, top_idx = lax.top_k(logits, TOP_K)
    top_w = jax.nn.softmax(top_logits, axis=-1)
    n_assign = T * TOP_K
    n_blocks = (n_assign + N_EXPERTS * (MOE_BLOCK - 1)) // MOE_BLOCK
    slots = n_blocks * MOE_BLOCK
    flat_e = top_idx.reshape(-1)
    flat_tok = jnp.repeat(jnp.arange(T, dtype=jnp.int32), TOP_K)
    flat_w = top_w.reshape(-1)
    order = jnp.argsort(flat_e)
    sorted_e = flat_e[order]
    counts = jnp.bincount(flat_e, length=N_EXPERTS)
    padded = (counts + MOE_BLOCK - 1) // MOE_BLOCK * MOE_BLOCK
    start_sorted = jnp.cumsum(counts) - counts
    pad_end = jnp.cumsum(padded)
    start_padded = pad_end - padded
    dest = start_padded[sorted_e] + jnp.arange(n_assign) - start_sorted[sorted_e]
    slot_tok = jnp.full((slots,), T, jnp.int32).at[dest].set(flat_tok[order])
    slot_w = jnp.zeros((slots,), f32).at[dest].set(flat_w[order])
    block_e = jnp.minimum(jnp.searchsorted(pad_end, jnp.arange(n_blocks) * MOE_BLOCK, side='right'),
                          N_EXPERTS - 1)
    x_slots = jnp.take(xt, slot_tok, axis=0, mode='fill', fill_value=0).reshape(n_blocks, MOE_BLOCK, d)

    def expert_block(args):
        xb, e = args
        return swiglu(xb, w_gate[e], w_up[e], w_down[e])

    y_slots = lax.map(expert_block, (x_slots, block_e)).reshape(slots, d)
    out = jnp.zeros((T, d), f32).at[slot_tok].add(y_slots.astype(f32) * slot_w[:, None], mode='drop')
    return out.astype(h.dtype).reshape(bsz, s, d)


def setup_inputs(seed: int = 0) -> dict:
    key = jax.random.key(seed)
    ks = list(jax.random.split(key, 48))
    f32 = jnp.float32
    L = DEPTH

    def normal(shape, scale):
        return jax.random.normal(ks.pop(), shape, f32) * scale

    def uniform(shape, lo, hi):
        return jax.random.uniform(ks.pop(), shape, f32, lo, hi)

    def dt_bias_init(shape):
        dt = jnp.exp(uniform(shape, math.log(1e-3), math.log(1e-1)))
        return jnp.log(jnp.expm1(dt))

    x = normal((BATCH, SEQ, D_MODEL), 1.0)
    c = normal((BATCH, D_MODEL), 1.0)
    positions = (jax.random.randint(ks.pop(), (BATCH, 1), 0, 1024, dtype=jnp.int32)
                 + jnp.arange(SEQ, dtype=jnp.int32)[None, :])
    return {
        'x': x,
        'c': c,
        'positions': positions,
        'w_ada': normal((L, D_MODEL, 6 * D_MODEL), 0.5 * D_MODEL ** -0.5),
        'b_ada': normal((L, 6 * D_MODEL), 0.02),
        'w_in': normal((L, D_MODEL, IN_DIM), D_MODEL ** -0.5),
        'gdn_conv_w': normal((L, CONV_K, 3 * GDN_DIM), CONV_K ** -0.5),
        'gdn_a_log': jnp.log(uniform((L, GDN_HEADS), 1.0, 16.0)),
        'gdn_dt_bias': dt_bias_init((L, GDN_HEADS)),
        'gdn_norm_w': 1.0 + normal((L, GDN_HEAD_DIM), 0.02),
        'ssm_conv_w': normal((L, CONV_K, SSM_CONV_DIM), CONV_K ** -0.5),
        'ssm_conv_b': normal((L, SSM_CONV_DIM), 0.02),
        'ssm_a_log': jnp.log(uniform((L, SSM_HEADS), 1.0, 16.0)),
        'ssm_dt_bias': dt_bias_init((L, SSM_HEADS)),
        'ssm_d': 1.0 + normal((L, SSM_HEADS), 0.1),
        'ssm_norm_w': 1.0 + normal((L, SSM_INNER), 0.02),
        'mla_q_norm_w': 1.0 + normal((L, MLA_Q_LORA), 0.02),
        'mla_w_uq': normal((L, MLA_Q_LORA, MLA_HEADS * (MLA_NOPE + MLA_ROPE)), MLA_Q_LORA ** -0.5),
        'mla_kv_norm_w': 1.0 + normal((L, MLA_KV_LORA), 0.02),
        'mla_w_uk': normal((L, MLA_KV_LORA, MLA_HEADS * MLA_NOPE), MLA_KV_LORA ** -0.5),
        'mla_w_uv': normal((L, MLA_KV_LORA, MLA_HEADS * MLA_V), MLA_KV_LORA ** -0.5),
        'w_branch_a': normal((L, GDN_DIM, D_MODEL), GDN_DIM ** -0.5),
        'w_branch_b': normal((L, SSM_INNER, D_MODEL), SSM_INNER ** -0.5),
        'w_branch_c': normal((L, MLA_DIM, D_MODEL), MLA_DIM ** -0.5),
        'w_out': normal((L, D_MODEL, D_MODEL), D_MODEL ** -0.5),
        'ffn_w_gate': normal((N_DENSE, D_MODEL, FFN_DIM), D_MODEL ** -0.5),
        'ffn_w_up': normal((N_DENSE, D_MODEL, FFN_DIM), D_MODEL ** -0.5),
        'ffn_w_down': normal((N_DENSE, FFN_DIM, D_MODEL), FFN_DIM ** -0.5),
        'moe_router': normal((N_MOE, D_MODEL, N_EXPERTS), D_MODEL ** -0.5),
        'moe_w_gate': normal((N_MOE, N_EXPERTS, D_MODEL, EXPERT_DIM), D_MODEL ** -0.5),
        'moe_w_up': normal((N_MOE, N_EXPERTS, D_MODEL, EXPERT_DIM), D_MODEL ** -0.5),
        'moe_w_down': normal((N_MOE, N_EXPERTS, EXPERT_DIM, D_MODEL), EXPERT_DIM ** -0.5),
        'final_norm_w': 1.0 + normal((D_MODEL,), 0.02),
    }


def reference(x, c, positions, w_ada, b_ada, w_in, gdn_conv_w, gdn_a_log, gdn_dt_bias, gdn_norm_w,
              ssm_conv_w, ssm_conv_b, ssm_a_log, ssm_dt_bias, ssm_d, ssm_norm_w,
              mla_q_norm_w, mla_w_uq, mla_kv_norm_w, mla_w_uk, mla_w_uv,
              w_branch_a, w_branch_b, w_branch_c, w_out,
              ffn_w_gate, ffn_w_up, ffn_w_down,
              moe_router, moe_w_gate, moe_w_up, moe_w_down, final_norm_w):
    cond = jax.nn.silu(c)
    for l in range(DEPTH):
        mod = cond @ w_ada[l] + b_ada[l]
        sh1, sc1, g1, sh2, sc2, g2 = [m[:, None, :] for m in jnp.split(mod, 6, axis=-1)]
        h = rms_norm(x) * (1 + sc1) + sh1
        x = x + g1 * token_mixer(h, positions, w_in[l], gdn_conv_w[l], gdn_a_log[l], gdn_dt_bias[l],
                                 gdn_norm_w[l], ssm_conv_w[l], ssm_conv_b[l], ssm_a_log[l],
                                 ssm_dt_bias[l], ssm_d[l], ssm_norm_w[l], mla_q_norm_w[l],
                                 mla_w_uq[l], mla_kv_norm_w[l], mla_w_uk[l], mla_w_uv[l],
                                 w_branch_a[l], w_branch_b[l], w_branch_c[l], w_out[l])
        h = rms_norm(x) * (1 + sc2) + sh2
        i = l // 2
        if l % 2 == 0:
            f = swiglu(h, ffn_w_gate[i], ffn_w_up[i], ffn_w_down[i])
        else:
            f = moe_ffn(h, moe_router[i], moe_w_gate[i], moe_w_up[i], moe_w_down[i])
        x = x + g2 * f
    return rms_norm(x, final_norm_w)
```

```cpp
#include <hip/hip_runtime.h>
#include <cstdio>
#include <cstdint>

#define GAS __attribute__((address_space(1)))
#define LAS __attribute__((address_space(3)))
typedef unsigned short bf16_t;
typedef short bf16x8 __attribute__((ext_vector_type(8)));
typedef short bf16x4 __attribute__((ext_vector_type(4)));
typedef float f32x4 __attribute__((ext_vector_type(4)));
typedef float f32x2 __attribute__((ext_vector_type(2)));
typedef unsigned u32x4 __attribute__((ext_vector_type(4)));
typedef unsigned u32x2 __attribute__((ext_vector_type(2)));

#ifndef FASTMASK
#define FASTMASK 0xFFFFFFFFu
#endif
#ifndef N_LAUNCH_MODE
#define N_LAUNCH_MODE 1
#endif

constexpr int T = 16384, D = 1024, NB = 4, SEQ = 4096, NL = 4, NCH = 64, CH = 64;
constexpr int NP = 7680;
constexpr int C_QKV = 0, C_GZ = 1536, C_SZ = 2048, C_XBC = 2560, C_CQ = 3584, C_CKV = 4096, C_KR = 4352, C_SMALL = 4416, C_GATE = 4608;
constexpr int FF = 2816, EF = 3584, NE = 8, NSLOT = 34560  ;
constexpr float EPS = 1e-6f;
constexpr int NWAVES = 8, NTHR = 512;

constexpr size_t MiB = 1u << 20;
constexpr size_t O_CTL = 0, CTL_BYTES = 1 * MiB;
constexpr size_t O_MOD = 1 * MiB;
constexpr size_t O_ROPE = 2 * MiB;
constexpr size_t O_RQ = 6 * MiB, O_RKV = O_RQ + 65536;
constexpr size_t O_SMALLF = 7 * MiB;
constexpr size_t O_TOPE = 8 * MiB, O_TOPW = O_TOPE + 65536, O_WGCNT = O_TOPW + 131072, O_TOKSLOT = O_WGCNT + 8192, O_BLKE = O_TOKSLOT + 131072, O_NBLK = O_BLKE + 1024;
constexpr size_t O_GL = 9 * MiB, O_DEC = O_GL + 4096, O_EA = O_DEC + 8192;
constexpr size_t O_WIN = 10 * MiB, O_WUQ = 70 * MiB, O_WUK = 73 * MiB, O_WUV = 74 * MiB, O_WBR = 75 * MiB, O_WOUT = 87 * MiB, O_WGU = 95 * MiB, O_WDN = 117 * MiB,
                 O_WEGU = 128 * MiB, O_WEDN = 240 * MiB;
constexpr size_t O_H = 296 * MiB;
constexpr size_t O_PROJ = 328 * MiB;
constexpr size_t O_KR = 568 * MiB, O_Q = 570 * MiB, O_KN = 594 * MiB, O_VT = 610 * MiB;
constexpr size_t O_YA = 626 * MiB, O_YB = 642 * MiB, O_YC = 658 * MiB;
constexpr size_t O_GU = 674 * MiB, O_GW = 706 * MiB, O_GQD = 722 * MiB, O_GKD = 738 * MiB, O_GQK = 754 * MiB, O_GO = 762 * MiB;
constexpr size_t O_YS = O_GU;
constexpr size_t O_SYP = 794 * MiB, O_SST = 826 * MiB, O_SCC = 890 * MiB;
constexpr size_t O_XS = O_SYP;
constexpr size_t O_MF = 898 * MiB, O_MB = 962 * MiB, WS_END = 994 * MiB;
static_assert((size_t)NSLOT * EF * 2 <= 240 * MiB && (size_t)NSLOT * 1024 * 2 <= 96 * MiB, "overlays");

constexpr int SCR_BYTES = 159744;
constexpr int LDSCTL_OFF = SCR_BYTES, LDS_BYTES = SCR_BYTES + 512;

#define LDS_WAIT() asm volatile("s_waitcnt lgkmcnt(0)" ::: "memory")
#define VM_WAIT() asm volatile("s_waitcnt vmcnt(0)" ::: "memory")
#define LDS_BARRIER() do { asm volatile("s_waitcnt lgkmcnt(0)" ::: "memory"); __builtin_amdgcn_s_barrier(); asm volatile("" ::: "memory"); } while (0)

__device__ __forceinline__ float bf2f(unsigned b) { return __uint_as_float(b << 16); }
__device__ __forceinline__ unsigned f2bf(float f) { unsigned r; asm("v_cvt_pk_bf16_f32 %0, %1, %1" : "=v"(r) : "v"(f)); return r & 0xffffu; }
__device__ __forceinline__ unsigned pk2(float lo, float hi) { unsigned r; asm("v_cvt_pk_bf16_f32 %0, %1, %2" : "=v"(r) : "v"(lo), "v"(hi)); return r; }
__device__ __forceinline__ float lo16(unsigned w) { return __uint_as_float(w << 16); }
__device__ __forceinline__ float hi16(unsigned w) { return __uint_as_float(w & 0xffff0000u); }
__device__ __forceinline__ u32x4 pk8(f32x4 a, f32x4 b) { u32x4 w; w.x = pk2(a[0], a[1]); w.y = pk2(a[2], a[3]); w.z = pk2(b[0], b[1]); w.w = pk2(b[2], b[3]); return w; }
__device__ __forceinline__ void unpk8(u32x4 w, f32x4& a, f32x4& b) { a = (f32x4){lo16(w.x), hi16(w.x), lo16(w.y), hi16(w.y)}; b = (f32x4){lo16(w.z), hi16(w.z), lo16(w.w), hi16(w.w)}; }
__device__ __forceinline__ float sigmoidf_(float x) { return __builtin_amdgcn_rcpf(1.f + __builtin_amdgcn_exp2f(x * -1.4426950408889634f)); }
__device__ __forceinline__ float siluf_(float x) { return x * __builtin_amdgcn_rcpf(1.f + __builtin_amdgcn_exp2f(x * -1.4426950408889634f)); }
__device__ __forceinline__ float softplusf_(float x) { return x > 20.f ? x : log1pf(expf(x)); }
#define DPP_ADD(v_, ctrl_) ((v_) + __builtin_bit_cast(float, __builtin_amdgcn_update_dpp(0, __builtin_bit_cast(int, (v_)), (ctrl_), 0xF, 0xF, true)))
__device__ __forceinline__ float row16_sum(float v) {
    v = DPP_ADD(v, 0xB1); v = DPP_ADD(v, 0x4E); v = DPP_ADD(v, 0x141); v = DPP_ADD(v, 0x140); return v;
}
__device__ __forceinline__ float wave_sum(float v) {
    v = row16_sum(v);
    { const auto r = __builtin_amdgcn_permlane16_swap(__float_as_uint(v), __float_as_uint(v), false, false); v = __uint_as_float(r[0]) + __uint_as_float(r[1]); }
    { const auto r = __builtin_amdgcn_permlane32_swap(__float_as_uint(v), __float_as_uint(v), false, false); v = __uint_as_float(r[0]) + __uint_as_float(r[1]); }
    return v;
}
namespace pg8 {
constexpr int BM = 256, BK = 64, HALF = 128, HTB = HALF * BK * 2, STAGE_BYTES = 8 * HTB, NXCD = 8, WGM = 8;
__host__ __device__ __forceinline__ int lds_byte(int r, int c) { const int st = (r >> 4) * 2 + (c >> 5), rr = r & 15, cc = c & 31, ob = rr * 64 + cc * 2; return st * 1024 + (ob ^ (((ob >> 9) & 1) << 5)); }
__host__ __device__ __forceinline__ void stage_rc(int b, int& R, int& C) { const int st = b / 1024, sb = b % 1024, swz = sb ^ (((sb >> 9) & 1) << 5); R = (st >> 1) * 16 + swz / 64; C = (st & 1) * 32 + (swz % 64) / 2; }
__host__ __device__ __forceinline__ int perm32(int rho) { const int n = rho >> 4, i = rho & 15; return 8 * (i >> 2) + 4 * n + (i & 3); }

struct Unit { int pm, pn; long boff, aoff; int kb; };
struct Gemm { const bf16_t* A; const bf16_t* Bt; int K, lda, ldb; };

struct StaticOrder {
    int nM, nN, nwg, G, c;
    __device__ void init(int nM_, int nN_, int G_, int c_) { nM = nM_; nN = nN_; nwg = nM * nN; G = G_; c = c_; }
    __device__ bool next(int i, Unit& u) const {
        const long L = (long)i * G + c; if (L >= nwg) return false;
        int wgid = (int)L; { const int q = nwg / NXCD, r = nwg % NXCD, xcd = wgid % NXCD, off = wgid / NXCD; wgid = (xcd < r ? xcd * (q + 1) : r * (q + 1) + (xcd - r) * q) + off; }
        const int nig = WGM * nN, gid = wgid / nig, fm = gid * WGM, gsz = (nM - fm) < WGM ? (nM - fm) : WGM;
        u.pm = fm + ((wgid % nig) % gsz); u.pn = (wgid % nig) / gsz; u.boff = 0; u.aoff = 0; u.kb = 0; return true;
    }
};
struct MoeOrder {
    const int* blke; int nblk, nN, G, c; long estride;
    __device__ bool next(int i, Unit& u) const {
        const long L = (long)i * G + c; if (L >= (long)nblk * nN) return false;
        const int j = (int)(L / nN); u.pm = j; u.pn = (int)(L % nN); u.boff = (long)blke[j] * estride; u.aoff = 0; u.kb = 0; return true;
    }
};

struct MoeTailOrder {
    const int* blke; int j0, ntail, nks, kslice, G, c; long estride;
    __device__ bool next(int i, Unit& u) const {
        const int L = i * G + c; if (L >= ntail * 4 * nks) return false;
        const int ks = L % nks, t = L / nks; u.pm = j0 + (t >> 2); u.pn = t & 3; u.kb = ks; u.aoff = (long)ks * kslice; u.boff = (long)blke[u.pm] * estride + (long)ks * kslice; return true;
    }
};
struct BranchOrder {
    StaticOrder base; int nbr; long astride, bstride;
    __device__ bool next(int i, Unit& u) const { const int rd = i / nbr, br = i - rd * nbr; if (!base.next(rd, u)) return false; u.kb = br; u.aoff = (long)br * astride; u.boff = (long)br * bstride; return true; }
};

template <class Epi, class Sched, bool ALIGN_EPI>
__device__ __forceinline__ void gemm_phase(LAS unsigned char* lds, const Gemm g, const Sched& S, const Epi& E) {
    int tid_ = threadIdx.x; asm volatile("" : "+v"(tid_) :: "memory");
    const int tid = tid_, wid = __builtin_amdgcn_readfirstlane(tid >> 6), lane = tid & 63, wr = wid >> 2, wc = wid & 3, fr = lane & 15, fq = lane >> 4;
    const int K = g.K, nt = K / BK;
    unsigned voffA[2], voffB[2];
#pragma unroll
    for (int i = 0; i < 2; ++i) { int R, C; stage_rc(tid * 16 + i * 8192, R, C); const int Rb = Epi::PERM ? ((R & ~31) + perm32(R & 31)) : R;
        voffA[i] = (unsigned)(R * g.lda + C) * 2u; voffB[i] = (unsigned)(Rb * g.ldb + C) * 2u; }
    const size_t kstep = (size_t)(BK * 2);
    const size_t hstepA = (size_t)HALF * g.lda * 2, hstepB = (size_t)HALF * g.ldb * 2;
    const size_t tstepA = 2 * hstepA, tstepB = 2 * hstepB;
    const unsigned ldsw = (unsigned)wid * 1024u;
    const int aoff = lds_byte(wr * 64 + fr, fq * 8), boff = lds_byte(wc * 32 + fr, fq * 8);
#define PG8_SA(b, h) (((b) * 2 + (h)) * HTB)
#define PG8_SB(b, h) ((4 + (b) * 2 + (h)) * HTB)
#define PG8_STAGE(bufoff, gbase, voff) do { _Pragma("unroll") for (int _i = 0; _i < 2; ++_i) \
        __builtin_amdgcn_global_load_lds((const unsigned*)((const char*)(gbase) + (voff)[_i]), (LAS unsigned*)(lds + (bufoff) + ldsw + _i * 8192), 16, 0, 0); } while (0)
#define PG8_LDA(dst, b, h) do { _Pragma("unroll") for (int m = 0; m < 4; ++m) _Pragma("unroll") for (int k = 0; k < 2; ++k) dst[m][k] = *(const LAS bf16x8*)(lds + PG8_SA(b, h) + aoff + m * 2048 + k * 1024); } while (0)
#define PG8_LDB(dst, b, h) do { _Pragma("unroll") for (int n = 0; n < 2; ++n) _Pragma("unroll") for (int k = 0; k < 2; ++k) dst[n][k] = *(const LAS bf16x8*)(lds + PG8_SB(b, h) + boff + n * 2048 + k * 1024); } while (0)
#define PG8_MMA(ai, bj, At, Bt) do { __builtin_amdgcn_s_setprio(1); _Pragma("unroll") for (int m = 0; m < 4; ++m) _Pragma("unroll") for (int n = 0; n < 2; ++n) _Pragma("unroll") for (int k = 0; k < 2; ++k) \
        acc[ai][bj][m][n] = __builtin_amdgcn_mfma_f32_16x16x32_bf16(Bt[n][k], At[m][k], acc[ai][bj][m][n], 0, 0, 0); __builtin_amdgcn_s_setprio(0); } while (0)
#define PG8_WAIT_V(n) asm volatile("s_waitcnt vmcnt(" #n ")" ::: "memory")
#define PG8_WAIT_L(n) asm volatile("s_waitcnt lgkmcnt(" #n ")" ::: "memory")
#define PG8_BAR __builtin_amdgcn_s_barrier()
#define PG8_SCHED __builtin_amdgcn_sched_barrier(0)
    Unit cur, nxt; int ui = 0;
    if (!S.next(0, cur)) return;
    f32x4 acc[2][2][4][2];
#pragma unroll
    for (int a = 0; a < 2; ++a)
#pragma unroll
        for (int b = 0; b < 2; ++b)
#pragma unroll
            for (int m = 0; m < 4; ++m)
#pragma unroll
                for (int n = 0; n < 2; ++n) acc[a][b][m][n] = (f32x4){0.f, 0.f, 0.f, 0.f};
    bf16x8 At[4][2], B0[2][2], B1[2][2];
    const char* cA = (const char*)(g.A + cur.aoff) + (size_t)cur.pm * tstepA; const char* cB = (const char*)(g.Bt + cur.boff) + (size_t)cur.pn * tstepB;
    PG8_STAGE(PG8_SB(0, 0), cB, voffB); PG8_STAGE(PG8_SB(0, 1), cB + hstepB, voffB); PG8_STAGE(PG8_SA(0, 0), cA, voffA); PG8_STAGE(PG8_SA(0, 1), cA + hstepA, voffA);
    if (wr == 1) PG8_BAR;
    PG8_WAIT_V(2); PG8_BAR;
    PG8_STAGE(PG8_SB(1, 0), cB + kstep, voffB); PG8_STAGE(PG8_SA(1, 0), cA + kstep, voffA); PG8_STAGE(PG8_SB(1, 1), cB + hstepB + kstep, voffB);
    PG8_WAIT_V(6); PG8_BAR;
    for (;;) {
        const bool has_next = S.next(ui + 1, nxt);
        const char* nA = has_next ? (const char*)(g.A + nxt.aoff) + (size_t)nxt.pm * tstepA : cA; const char* nB = has_next ? (const char*)(g.Bt + nxt.boff) + (size_t)nxt.pn * tstepB : cB;
        for (int t = 0; t < nt; t += 2) {
            const bool last = (t == nt - 2);
            const char* a1 = cA + (size_t)(t + 1) * kstep;
            const char* a2 = last ? nA : cA + (size_t)(t + 2) * kstep; const char* b2 = last ? nB : cB + (size_t)(t + 2) * kstep;
            const char* a3 = a2 + kstep; const char* b3 = b2 + kstep;
            PG8_LDB(B0, 0, 0); PG8_LDB(B1, 0, 1); PG8_SCHED; PG8_LDA(At, 0, 0); PG8_STAGE(PG8_SA(1, 1), a1 + hstepA, voffA);
            PG8_WAIT_V(8); PG8_WAIT_L(0); PG8_BAR; PG8_MMA(0, 0, At, B0); PG8_MMA(0, 1, At, B1); PG8_BAR; PG8_SCHED;
            PG8_LDA(At, 0, 1); PG8_STAGE(PG8_SB(0, 0), b2, voffB); PG8_STAGE(PG8_SB(0, 1), b2 + hstepB, voffB); PG8_STAGE(PG8_SA(0, 0), a2, voffA);
            PG8_WAIT_V(8); PG8_WAIT_L(0); PG8_BAR; PG8_MMA(1, 0, At, B0); PG8_MMA(1, 1, At, B1); PG8_BAR; PG8_SCHED;
            PG8_LDB(B0, 1, 0); PG8_LDB(B1, 1, 1); PG8_SCHED; PG8_LDA(At, 1, 0); PG8_STAGE(PG8_SA(0, 1), a2 + hstepA, voffA);
            PG8_WAIT_V(8); PG8_WAIT_L(0); PG8_BAR; PG8_MMA(0, 0, At, B0); PG8_MMA(0, 1, At, B1); PG8_BAR; PG8_SCHED;
            PG8_LDA(At, 1, 1); PG8_STAGE(PG8_SB(1, 0), b3, voffB); PG8_STAGE(PG8_SB(1, 1), b3 + hstepB, voffB); PG8_STAGE(PG8_SA(1, 0), a3, voffA);
            PG8_WAIT_V(8); PG8_WAIT_L(0); PG8_BAR; PG8_MMA(1, 0, At, B0); PG8_MMA(1, 1, At, B1); PG8_BAR; PG8_SCHED;
        }
        if constexpr (ALIGN_EPI) { if (wr == 0) PG8_BAR; }
        E(acc, cur, wr, wc, fr, fq);
        if (!has_next) break;
#pragma unroll
        for (int a = 0; a < 2; ++a)
#pragma unroll
            for (int b = 0; b < 2; ++b)
#pragma unroll
                for (int m = 0; m < 4; ++m)
#pragma unroll
                    for (int n = 0; n < 2; ++n) acc[a][b][m][n] = (f32x4){0.f, 0.f, 0.f, 0.f};
        cur = nxt; cA = nA; cB = nB; ++ui;
        if constexpr (ALIGN_EPI) { if (wr == 1) PG8_BAR; }
    }
    PG8_WAIT_V(0);
    if constexpr (!ALIGN_EPI) { if (wr == 0) PG8_BAR; }
    PG8_BAR;
#undef PG8_SA
#undef PG8_SB
#undef PG8_STAGE
#undef PG8_LDA
#undef PG8_LDB
#undef PG8_MMA
#undef PG8_WAIT_V
#undef PG8_WAIT_L
#undef PG8_BAR
#undef PG8_SCHED
}

template <class F> struct EpiOct {
    static constexpr bool PERM = true; F f;
    __device__ __forceinline__ void operator()(const f32x4 (&acc)[2][2][4][2], const Unit& u, int wr, int wc, int fr, int fq) const {
#pragma unroll
        for (int ai = 0; ai < 2; ++ai)
#pragma unroll
            for (int m = 0; m < 4; ++m) { const int row = u.pm * BM + ai * HALF + wr * 64 + m * 16 + fr;
#pragma unroll
                for (int bj = 0; bj < 2; ++bj) f.oct(u, row, u.pn * BM + bj * HALF + wc * 32 + 8 * fq, acc[ai][bj][m][0], acc[ai][bj][m][1]);
                if (m & 1) asm volatile("" ::: "memory"); }
    }
};
template <class F> struct EpiGU {
    static constexpr bool PERM = true; F f;
    __device__ __forceinline__ void operator()(const f32x4 (&acc)[2][2][4][2], const Unit& u, int wr, int wc, int fr, int fq) const {
#pragma unroll
        for (int ai = 0; ai < 2; ++ai)
#pragma unroll
            for (int m = 0; m < 4; ++m) { const int row = u.pm * BM + ai * HALF + wr * 64 + m * 16 + fr;
                f.gu(u, row, u.pn * HALF + wc * 32 + 8 * fq, acc[ai][0][m][0], acc[ai][0][m][1], acc[ai][1][m][0], acc[ai][1][m][1]);
                asm volatile("" ::: "memory"); }
    }
};

__device__ __forceinline__ float dot8(const float (&a)[8], u32x4 b) {
    return a[0] * lo16(b.x) + a[1] * hi16(b.x) + a[2] * lo16(b.y) + a[3] * hi16(b.y) + a[4] * lo16(b.z) + a[5] * hi16(b.z) + a[6] * lo16(b.w) + a[7] * hi16(b.w);
}
template <class F, class Sched>
__device__ __forceinline__ void gemm_simple_oct(const Gemm g, const Sched& S, const F& f) {
    Unit u;
    for (int i = 0; S.next(i, u); ++i) {
        const bf16_t* A = g.A + u.aoff + (size_t)u.pm * BM * g.lda; const bf16_t* B = g.Bt + u.boff + (size_t)u.pn * BM * g.ldb;
        for (int it = threadIdx.x; it < 256 * 32; it += NTHR) {
            const int r = it >> 5, cg = it & 31; float acc[8];
#pragma unroll
            for (int c = 0; c < 8; ++c) acc[c] = 0.f;
            const bf16_t* ar = A + (size_t)r * g.lda; const bf16_t* br = B + (size_t)(cg * 8) * g.ldb;
            for (int k = 0; k < g.K; k += 8) {
                const u32x4 a = *(const u32x4*)(ar + k); float af[8] = {lo16(a.x), hi16(a.x), lo16(a.y), hi16(a.y), lo16(a.z), hi16(a.z), lo16(a.w), hi16(a.w)};
#pragma unroll
                for (int c = 0; c < 8; ++c) acc[c] += dot8(af, *(const u32x4*)(br + (size_t)c * g.ldb + k));
            }
            f.oct(u, u.pm * BM + r, u.pn * BM + cg * 8, (f32x4){acc[0], acc[1], acc[2], acc[3]}, (f32x4){acc[4], acc[5], acc[6], acc[7]});
        }
    }
}
template <class F, class Sched>
__device__ __forceinline__ void gemm_simple_gu(const Gemm g, const Sched& S, const F& f) {
    Unit u;
    for (int i = 0; S.next(i, u); ++i) {
        const bf16_t* A = g.A + u.aoff + (size_t)u.pm * BM * g.lda; const bf16_t* B = g.Bt + u.boff + (size_t)u.pn * BM * g.ldb;
        for (int it = threadIdx.x; it < 256 * 16; it += NTHR) {
            const int r = it >> 4, cg = it & 15; float ag[8], au[8];
#pragma unroll
            for (int c = 0; c < 8; ++c) { ag[c] = 0.f; au[c] = 0.f; }
            const bf16_t* ar = A + (size_t)r * g.lda; const bf16_t* bg = B + (size_t)(cg * 8) * g.ldb; const bf16_t* bu = bg + (size_t)HALF * g.ldb;
            for (int k = 0; k < g.K; k += 8) {
                const u32x4 a = *(const u32x4*)(ar + k); float af[8] = {lo16(a.x), hi16(a.x), lo16(a.y), hi16(a.y), lo16(a.z), hi16(a.z), lo16(a.w), hi16(a.w)};
#pragma unroll
                for (int c = 0; c < 8; ++c) { ag[c] += dot8(af, *(const u32x4*)(bg + (size_t)c * g.ldb + k)); au[c] += dot8(af, *(const u32x4*)(bu + (size_t)c * g.ldb + k)); }
            }
            f.gu(u, u.pm * BM + r, u.pn * HALF + cg * 8, (f32x4){ag[0], ag[1], ag[2], ag[3]}, (f32x4){ag[4], ag[5], ag[6], ag[7]}, (f32x4){au[0], au[1], au[2], au[3]}, (f32x4){au[4], au[5], au[6], au[7]});
        }
    }
}
}
#define XB_TMO      128
#define XB_XCNT(j)  (256  + 64 * (j))
#define XB_XSUB(j)  (1280 + 64 * (j))
#define XB_XGEN(j)  (2304 + 64 * (j))
#define XB_TOP      3328
#define XB_TOPGEN   3392
#define XCD_BAR_WORDS 3456
#define XB_SPIN_CAP (1u << 22)

__device__ __forceinline__ unsigned xb_ld(unsigned* p)              { return __hip_atomic_load(p, __ATOMIC_RELAXED, __HIP_MEMORY_SCOPE_AGENT); }
__device__ __forceinline__ unsigned xb_add(unsigned* p, unsigned v) { return __hip_atomic_fetch_add(p, v, __ATOMIC_RELAXED, __HIP_MEMORY_SCOPE_AGENT); }
__device__ __forceinline__ unsigned xb_xcc_id() { return (unsigned)__builtin_amdgcn_s_getreg((3 << 11) | 20) & 0xFu; }
#define XB_SPIN(cond, bar) do { unsigned _sp = 0; while (cond) { __builtin_amdgcn_s_sleep(1); \
    if ((++_sp & 255u) == 0u) { if (xb_ld(&(bar)[XB_TMO])) break; if (_sp > XB_SPIN_CAP) { atomicAdd(&(bar)[XB_TMO], 1u); break; } } } } while (0)

struct XcdBarrier {
    unsigned* bar; unsigned x;
    volatile LAS unsigned* st;
};

__device__ __forceinline__ XcdBarrier xcd_barrier_post(unsigned* bar, volatile LAS unsigned* st) {
    XcdBarrier b; b.bar = bar; b.x = xb_xcc_id(); b.st = st;
    if (threadIdx.x == 0) (void)xb_add(&bar[XB_XCNT(b.x)], 1u);
    return b;
}
__device__ __forceinline__ void xcd_barrier_complete(unsigned* bar, unsigned x, unsigned& nloc, unsigned& nx) {
    const unsigned G = gridDim.x * gridDim.y * gridDim.z;
    unsigned sum, cnt, mine, sp = 0u;
    for (;;) {
        sum = 0u; cnt = 0u; mine = 0u;
#pragma unroll
        for (unsigned j = 0; j < 16; ++j) { const unsigned c = xb_ld(&bar[XB_XCNT(j)]); sum += c; cnt += (c > 0u) ? 1u : 0u; mine = (j == x) ? c : mine; }
        if (sum == G) break;
        __builtin_amdgcn_s_sleep(1);
        if ((++sp & 255u) == 0u) { if (xb_ld(&bar[XB_TMO])) break; if (sp > XB_SPIN_CAP) { atomicAdd(&bar[XB_TMO], 1u); break; } }
    }
    nloc = mine > 0u ? mine : 1u; nx = cnt > 0u ? cnt : 1u;
}

__device__ __forceinline__ void xcd_barrier(const XcdBarrier& b) {
    asm volatile("s_waitcnt vmcnt(0)" ::: "memory");
    __syncthreads();
    if (threadIdx.x == 0) {
        unsigned* bar = b.bar;
        __builtin_amdgcn_s_waitcnt(0);
        unsigned nloc = b.st[0], nx = b.st[1];
        if (nloc == 0u) { xcd_barrier_complete(bar, b.x, nloc, nx); b.st[0] = nloc; b.st[1] = nx; }
        const unsigned old = xb_add(&bar[XB_XSUB(b.x)], 1u);
        const unsigned gen = old / nloc;
        if (old + 1u == (gen + 1u) * nloc) {
            __builtin_amdgcn_fence(__ATOMIC_RELEASE, "agent");
            asm volatile("s_waitcnt vmcnt(0)" ::: "memory");
            const unsigned og = xb_add(&bar[XB_TOP], 1u);
            const unsigned tg = og / nx;
            if (og + 1u == (tg + 1u) * nx) xb_add(&bar[XB_TOPGEN], 1u);
            else XB_SPIN(xb_ld(&bar[XB_TOPGEN]) == tg, bar);
            __builtin_amdgcn_fence(__ATOMIC_ACQUIRE, "agent");
            xb_add(&bar[XB_XGEN(b.x)], 1u);
            asm volatile("s_waitcnt vmcnt(0)" ::: "memory");
        } else {
            XB_SPIN(xb_ld(&bar[XB_XGEN(b.x)]) == gen, bar);
            __builtin_amdgcn_fence(__ATOMIC_ACQUIRE, "agent");
            asm volatile("s_waitcnt vmcnt(0)" ::: "memory");
        }
    }
    __syncthreads();
}

struct Ctx {
    LAS unsigned char* lds; int tid, lane, wave, G, wg, gw, NGW;
    const float* const __attribute__((address_space(4)))* in; float* X; unsigned char* ws;
};
#define WSP(type, off) ((type*)(c.ws + (off)))
#define WSG(type, off) ((GAS type*)(c.ws + (off)))
#define ING(i) ((const GAS float*)c.in[i])

struct CvtJob { const float* W0; const float* W1; const float* kscale; bf16_t* WT; int ldw, K, Ndst, kind; };
__device__ __forceinline__ int cvt_src_col(int kind, int n, int& which) {
    which = 0;
    if (kind == 0) return n;
    if (kind == 1) {
        if (n < 2048) return n; if (n < 3584) return n + 8; if (n < 4416) return n + 16;
        if (n < 4420) return 2048 + (n - 4416); if (n < 4424) return 2052 + (n - 4420); if (n < 4432) return 3592 + (n - 4424);
        if (n < 4608) return -1; return 4432 + (n - 4608);
    }
    if (kind == 2) { const int h = n / 192, j = n % 192; if (j < 128) return n; const int jj = j - 128; return h * 192 + 128 + (jj & 1) * 32 + (jj >> 1); }
    const int uu = n >> 8, r = n & 255; which = r >> 7; return uu * 128 + (r & 127);
}
__device__ __forceinline__ void cvt_item(const CvtJob& jb, int item, LAS float* scr, int lane) {
    const int nblk = jb.Ndst / 32, kb = item / nblk, nb = item % nblk, k0 = 64 * kb, n0 = 32 * nb;
    int which; const int sc = cvt_src_col(jb.kind, n0 + (lane & 31), which);
    const float* W = (const float*)((uintptr_t)jb.W0 + (uintptr_t)which * ((uintptr_t)jb.W1 - (uintptr_t)jb.W0));
    float v[32];
#pragma unroll
    for (int i = 0; i < 32; ++i) { const int kk = 2 * i + (lane >> 5); v[i] = (sc >= 0) ? W[(size_t)(k0 + kk) * jb.ldw + sc] : 0.f; }
    if (jb.kscale) {
#pragma unroll
        for (int i = 0; i < 32; ++i) v[i] *= jb.kscale[k0 + 2 * i + (lane >> 5)]; }
#pragma unroll
    for (int i = 0; i < 32; ++i) scr[(2 * i + (lane >> 5)) * 33 + (lane & 31)] = v[i];
    LDS_WAIT(); asm volatile("" ::: "memory");
    const int cc = lane & 7;
#pragma unroll
    for (int j = 0; j < 4; ++j) { const int n = (lane >> 3) + 8 * j; const LAS float* s = scr + (8 * cc) * 33 + n;
        u32x4 o; o.x = pk2(s[0 * 33], s[1 * 33]); o.y = pk2(s[2 * 33], s[3 * 33]); o.z = pk2(s[4 * 33], s[5 * 33]); o.w = pk2(s[6 * 33], s[7 * 33]);
        *(u32x4*)(jb.WT + (size_t)(n0 + n) * jb.K + k0 + 8 * cc) = o; }
    LDS_WAIT(); asm volatile("" ::: "memory");
}
__device__ __forceinline__ void cvt_run(const Ctx& c, const CvtJob& jb, LAS float* scr) {
    const int nitems = (jb.K / 64) * (jb.Ndst / 32);
    for (int it = c.gw; it < nitems; it += c.NGW) cvt_item(jb, it, scr, c.lane);
}
__device__ __forceinline__ void cvt_run_ranked(const Ctx& c, const CvtJob& jb, LAS float* scr, int rank, int count) {
    const int nitems = (jb.K / 64) * (jb.Ndst / 32);
    for (int it = rank; it < nitems; it += count) cvt_item(jb, it, scr, c.lane);
}
__device__ __forceinline__ CvtJob make_job(const Ctx& c, int j) {
    CvtJob jb; jb.W0 = nullptr; jb.W1 = nullptr; jb.kscale = nullptr; jb.kind = 0;
    if (j < 8 * NL) {
        const int l = j >> 3, k = j & 7;
        if (k == 0) { jb.W0 = c.in[5] + (size_t)l * 1024 * 7504; jb.ldw = 7504; jb.K = 1024; jb.Ndst = NP; jb.kind = 1; jb.WT = WSP(bf16_t, O_WIN) + (size_t)l * NP * 1024; }
        else if (k == 1) { jb.W0 = c.in[17] + (size_t)l * 512 * 768; jb.ldw = 768; jb.K = 512; jb.Ndst = 768; jb.kind = 2; jb.kscale = c.in[16] + l * 512; jb.WT = WSP(bf16_t, O_WUQ) + (size_t)l * 768 * 512; }
        else if (k == 2) { jb.W0 = c.in[19] + (size_t)l * 256 * 512; jb.ldw = 512; jb.K = 256; jb.Ndst = 512; jb.kscale = c.in[18] + l * 256; jb.WT = WSP(bf16_t, O_WUK) + (size_t)l * 512 * 256; }
        else if (k == 3) { jb.W0 = c.in[20] + (size_t)l * 256 * 512; jb.ldw = 512; jb.K = 256; jb.Ndst = 512; jb.kscale = c.in[18] + l * 256; jb.WT = WSP(bf16_t, O_WUV) + (size_t)l * 512 * 256; }
        else if (k < 7) { jb.W0 = (k == 4 ? c.in[21] : k == 5 ? c.in[22] : c.in[23]) + (size_t)l * 512 * 1024; jb.ldw = 1024; jb.K = 512; jb.Ndst = 1024; jb.WT = WSP(bf16_t, O_WBR) + (size_t)(l * 3 + (k - 4)) * 1024 * 512; }
        else { jb.W0 = c.in[24] + (size_t)l * 1024 * 1024; jb.ldw = 1024; jb.K = 1024; jb.Ndst = 1024; jb.WT = WSP(bf16_t, O_WOUT) + (size_t)l * 1024 * 1024; }
    } else {
        const int i = (j - 8 * NL) >> 1, k = (j - 8 * NL) & 1;
        if (k == 0) { jb.W0 = c.in[25] + (size_t)i * 1024 * FF; jb.W1 = c.in[26] + (size_t)i * 1024 * FF; jb.ldw = FF; jb.K = 1024; jb.Ndst = 2 * FF; jb.kind = 3; jb.WT = WSP(bf16_t, O_WGU) + (size_t)i * 2 * FF * 1024; }
        else { jb.W0 = c.in[27] + (size_t)i * FF * 1024; jb.ldw = 1024; jb.K = FF; jb.Ndst = 1024; jb.WT = WSP(bf16_t, O_WDN) + (size_t)i * 1024 * FF; }
    }
    return jb;
}
__device__ __forceinline__ CvtJob make_moe_job(const Ctx& c, int i, int j) {
    CvtJob jb; jb.W0 = nullptr; jb.W1 = nullptr; jb.kscale = nullptr; jb.kind = 0;
    if (j < 8) { const size_t eo = (size_t)(i * 8 + j) * 1024 * EF; jb.W0 = c.in[29] + eo; jb.W1 = c.in[30] + eo; jb.ldw = EF; jb.K = 1024; jb.Ndst = 2 * EF; jb.kind = 3; jb.WT = WSP(bf16_t, O_WEGU) + (size_t)j * 2 * EF * 1024; }
    else { const int e = j - 8; jb.W0 = c.in[31] + (size_t)(i * 8 + e) * EF * 1024; jb.ldw = 1024; jb.K = EF; jb.Ndst = 1024; jb.WT = WSP(bf16_t, O_WEDN) + (size_t)e * 1024 * EF; }
    return jb;
}

__device__ __forceinline__ void cvt_item(const CvtJob& jb, int item, LAS float* scr, int lane);
struct CvtQueue { unsigned* ctr; unsigned base, off; int lane;
    __device__ __forceinline__ unsigned grab() { unsigned b = 0; if (lane == 0) b = __hip_atomic_fetch_add(ctr, 8u, __ATOMIC_RELAXED, __HIP_MEMORY_SCOPE_AGENT); return (unsigned)__builtin_amdgcn_readfirstlane(b); }
    __device__ __forceinline__ void init(unsigned* c_, int lane_) { ctr = c_; lane = lane_; off = 0; base = grab(); }
    __device__ __forceinline__ void run(const CvtJob& jb, LAS float* scr) { const unsigned n = (unsigned)(jb.K / 64) * (unsigned)(jb.Ndst / 32);
        while (base - off < n) {
#pragma unroll 1
            for (unsigned k = 0; k < 8; ++k) cvt_item(jb, (int)(base - off + k), scr, lane);
            base = grab(); }
        off += n; }
};
__device__ __forceinline__ void p0_prologue(const Ctx& c) {
    LAS float* sil = (LAS float*)c.lds;
    LAS float* red = sil + 4096;
    LAS float* scr = (LAS float*)(c.lds + 32768 + c.wave * 8704);
    for (int i = c.tid; i < 4096; i += NTHR) sil[i] = siluf_(c.in[1][i]);
    __syncthreads();
    float* MOD = WSP(float, O_MOD);
    for (int it = c.wg; it < NL * 96; it += c.G) {
        const int l = it / 96, cg = it % 96, col = cg * 64 + c.lane;
        float a0 = 0.f, a1 = 0.f, a2 = 0.f, a3 = 0.f;
        const float* w = c.in[3] + (size_t)l * 1024 * 6144 + col;
#pragma unroll 32
        for (int k = c.wave * 128; k < c.wave * 128 + 128; ++k) { const float wv = w[(size_t)k * 6144]; a0 += sil[k] * wv; a1 += sil[1024 + k] * wv; a2 += sil[2048 + k] * wv; a3 += sil[3072 + k] * wv; }
        red[(c.wave * 4 + 0) * 64 + c.lane] = a0; red[(c.wave * 4 + 1) * 64 + c.lane] = a1; red[(c.wave * 4 + 2) * 64 + c.lane] = a2; red[(c.wave * 4 + 3) * 64 + c.lane] = a3;
        __syncthreads();
        if (c.tid < 256) { const int b = c.tid >> 6, ln = c.tid & 63; float s = 0.f;
#pragma unroll
            for (int w8 = 0; w8 < 8; ++w8) s += red[(w8 * 4 + b) * 64 + ln];
            MOD[(size_t)(l * 4 + b) * 6144 + cg * 64 + ln] = s + c.in[4][l * 6144 + cg * 64 + ln]; }
        __syncthreads();
    }
    { float* ROPE = WSP(float, O_ROPE); const int* pos = (const int*)c.in[2];
      for (int idx = c.wg * NTHR + c.tid; idx < T * 32; idx += c.G * NTHR) { const int t = idx >> 5, i = idx & 31;
          const float inv = expf(-(float)(2 * i) * (1.f / 64.f) * 9.210340371976184f); const float ang = (float)pos[t] * inv; float sn, cs; sincosf(ang, &sn, &cs);
          ROPE[(size_t)idx * 2] = cs; ROPE[(size_t)idx * 2 + 1] = sn; } }
    { CvtQueue q; q.init((unsigned*)(c.ws + O_CTL) + 256 + 64 * 8, c.lane);
      for (int j = 0; j < 4; ++j) { const CvtJob jb = make_job(c, j); q.run(jb, scr); } }
}

__device__ __forceinline__ void load_row(const Ctx& c, int row, int combine_l, f32x4 (&v)[4], const float* xsrc = nullptr) {
    float* xr = c.X + (size_t)row * D + 4 * c.lane; const float* xs = (xsrc ? xsrc : c.X) + (size_t)row * D + 4 * c.lane;
#pragma unroll
    for (int j = 0; j < 4; ++j) v[j] = *(const f32x4*)(xs + 256 * j);
    if (combine_l >= 0) {
        const int b = row >> 12; const int* ts = WSP(int, O_TOKSLOT) + row * 2; const float* tw = WSP(float, O_TOPW) + row * 2;
        const int s0 = ts[0], s1 = ts[1]; const float w0 = tw[0], w1 = tw[1];
        const float* g2 = WSP(float, O_MOD) + (size_t)(combine_l * 4 + b) * 6144 + 5120 + 4 * c.lane;
        const int nmain = WSP(int, O_NBLK)[1] * 256;
        const bf16_t* y0 = WSP(bf16_t, O_YS) + (size_t)s0 * D + 4 * c.lane; const bf16_t* y1 = WSP(bf16_t, O_YS) + (size_t)s1 * D + 4 * c.lane;
        const float* z0 = WSP(float, O_MF) + (size_t)(s0 - nmain) * D + 4 * c.lane; const float* z1 = WSP(float, O_MF) + (size_t)(s1 - nmain) * D + 4 * c.lane;
#pragma unroll
        for (int j = 0; j < 4; ++j) { const f32x4 g = *(const f32x4*)(g2 + 256 * j); f32x4 ya, yb;
            if (s0 >= nmain) { ya = *(const f32x4*)(z0 + 256 * j);
#pragma unroll
                for (int k = 1; k < 7; ++k) ya = ya + *(const f32x4*)(z0 + (size_t)k * (8 * 256 * 1024) + 256 * j); }
            else { const u32x2 a = *(const u32x2*)(y0 + 256 * j); ya = (f32x4){lo16(a.x), hi16(a.x), lo16(a.y), hi16(a.y)}; }
            if (s1 >= nmain) { yb = *(const f32x4*)(z1 + 256 * j);
#pragma unroll
                for (int k = 1; k < 7; ++k) yb = yb + *(const f32x4*)(z1 + (size_t)k * (8 * 256 * 1024) + 256 * j); }
            else { const u32x2 bb = *(const u32x2*)(y1 + 256 * j); yb = (f32x4){lo16(bb.x), hi16(bb.x), lo16(bb.y), hi16(bb.y)}; }
            v[j] = v[j] + g * (ya * w0 + yb * w1); *(f32x4*)(xr + 256 * j) = v[j]; }
    }
}
__device__ __forceinline__ float row_rstd(const f32x4 (&v)[4]) {
    float ss = 0.f;
#pragma unroll
    for (int j = 0; j < 4; ++j) ss += (v[j][0] * v[j][0] + v[j][1] * v[j][1]) + (v[j][2] * v[j][2] + v[j][3] * v[j][3]);
    return rsqrtf(wave_sum(ss) * (1.f / D) + EPS);
}
__device__ __forceinline__ void norm_phase(const Ctx& c, int l, int which, int combine_l, const float* xsrc = nullptr) {
    bf16_t* H = WSP(bf16_t, O_H);
    for (int row0 = c.gw * 2; row0 < T; row0 += c.NGW * 2) {
        f32x4 v[2][4]; load_row(c, row0, combine_l, v[0], xsrc); load_row(c, row0 + 1, combine_l, v[1], xsrc);
#pragma unroll
        for (int q = 0; q < 2; ++q) { const int row = row0 + q;
            const float r = row_rstd(v[q]); const int b = row >> 12;
            const float* sh = WSP(float, O_MOD) + (size_t)(l * 4 + b) * 6144 + (which ? 3072 : 0) + 4 * c.lane; const float* sc = sh + 1024;
#pragma unroll
            for (int j = 0; j < 4; ++j) { const f32x4 s1 = *(const f32x4*)(sc + 256 * j), s0 = *(const f32x4*)(sh + 256 * j); const f32x4 h = v[q][j] * r * (s1 + 1.f) + s0;
                u32x2 o; o.x = pk2(h[0], h[1]); o.y = pk2(h[2], h[3]); *(u32x2*)(H + (size_t)row * D + 4 * c.lane + 256 * j) = o; } }
    }
}
__device__ __forceinline__ void final_phase(const Ctx& c, int combine_l) {
    for (int row = c.gw; row < T; row += c.NGW) {
        f32x4 v[4]; load_row(c, row, combine_l, v);
        const float r = row_rstd(v); const float* fw = c.in[32] + 4 * c.lane;
#pragma unroll
        for (int j = 0; j < 4; ++j) { const f32x4 w = *(const f32x4*)(fw + 256 * j); *(f32x4*)(c.X + (size_t)row * D + 4 * c.lane + 256 * j) = v[j] * r * w; }
    }
}
__device__ __forceinline__ void norm2_moe_phase(const Ctx& c, int l) {
    bf16_t* H = WSP(bf16_t, O_H);
    LAS float* rt = (LAS float*)c.lds;
    LAS int* hist = (LAS int*)(c.lds + 32768);
    const float* router = c.in[28] + (size_t)(l >> 1) * 1024 * 8;
    for (int i = c.tid; i < 8192; i += NTHR) rt[i] = router[i];
    if (c.tid < 8) hist[c.tid] = 0;
    __syncthreads();
    const int rpw = T / c.G, r0 = c.wg * rpw;
    for (int rr = c.wave; rr < rpw; rr += NWAVES) {
        const int row = r0 + rr;
        f32x4 v[4]; load_row(c, row, -1, v);
        const float r = row_rstd(v); const int b = row >> 12;
        const float* sh = WSP(float, O_MOD) + (size_t)(l * 4 + b) * 6144 + 3072 + 4 * c.lane; const float* sc = sh + 1024;
        float lg[8];
#pragma unroll
        for (int e = 0; e < 8; ++e) lg[e] = 0.f;
#pragma unroll
        for (int j = 0; j < 4; ++j) { const f32x4 s1 = *(const f32x4*)(sc + 256 * j), s0 = *(const f32x4*)(sh + 256 * j); const f32x4 h = v[j] * r * (s1 + 1.f) + s0;
            u32x2 o; o.x = pk2(h[0], h[1]); o.y = pk2(h[2], h[3]); *(u32x2*)(H + (size_t)row * D + 4 * c.lane + 256 * j) = o;
#pragma unroll
            for (int q = 0; q < 4; ++q) { const LAS f32x4* rp = (const LAS f32x4*)(rt + (4 * c.lane + 256 * j + q) * 8); const f32x4 ra = rp[0], rb = rp[1];
                lg[0] += h[q] * ra[0]; lg[1] += h[q] * ra[1]; lg[2] += h[q] * ra[2]; lg[3] += h[q] * ra[3]; lg[4] += h[q] * rb[0]; lg[5] += h[q] * rb[1]; lg[6] += h[q] * rb[2]; lg[7] += h[q] * rb[3]; } }
#pragma unroll
        for (int e = 0; e < 8; ++e) lg[e] = wave_sum(lg[e]);
        if (c.lane == 0) {
            int e0 = 0; float m0 = lg[0];
#pragma unroll
            for (int e = 1; e < 8; ++e) if (lg[e] > m0) { m0 = lg[e]; e0 = e; }
            int e1 = -1; float m1 = -3.0e38f;
#pragma unroll
            for (int e = 0; e < 8; ++e) if (e != e0 && lg[e] > m1) { m1 = lg[e]; e1 = e; }
            const float ex = __expf(m1 - m0), w0 = 1.f / (1.f + ex);
            WSP(int, O_TOPE)[row] = e0 | (e1 << 8); WSP(float, O_TOPW)[row * 2] = w0; WSP(float, O_TOPW)[row * 2 + 1] = ex * w0;
            __hip_atomic_fetch_add(&hist[e0], 1, __ATOMIC_RELAXED, __HIP_MEMORY_SCOPE_WORKGROUP); __hip_atomic_fetch_add(&hist[e1], 1, __ATOMIC_RELAXED, __HIP_MEMORY_SCOPE_WORKGROUP);
        }
    }
    __syncthreads();
    if (c.tid < 8) WSP(int, O_WGCNT)[c.wg * 8 + c.tid] = hist[c.tid];
    __syncthreads();
}
__device__ __forceinline__ void moe_assign_phase(const Ctx& c, int l) {
    LAS int* cnt = (LAS int*)c.lds;
    LAS int* tot = cnt + 2048; LAS int* base = tot + 8; LAS int* spad = base + 8; LAS int* pairs = spad + 16;
    const int rpw = T / c.G, r0 = c.wg * rpw;
    LAS int* tl = pairs + 4 * rpw;
    const int* WGC = WSP(int, O_WGCNT);
    for (int i = c.tid; i < c.G * 8; i += NTHR) cnt[i] = WGC[i];
    if (c.tid < rpw) tl[c.tid] = WSP(int, O_TOPE)[r0 + c.tid];
    __syncthreads();
    if (c.tid < 8) { int t = 0, bs = 0; for (int w = 0; w < c.G; ++w) { if (w == c.wg) bs = t; t += cnt[w * 8 + c.tid]; } tot[c.tid] = t; base[c.tid] = bs; }
    __syncthreads();
    if (c.tid == 0) {
        int sp = 0; for (int e = 0; e < 8; ++e) { spad[e] = sp; sp += (tot[e] + 255) / 256 * 256; } spad[8] = sp;
        if (c.wg == 0) { int* blke = WSP(int, O_BLKE); int nb = 0; for (int e = 0; e < 8; ++e) { const int n = (tot[e] + 255) / 256; for (int k = 0; k < n; ++k) blke[nb++] = e; } *WSP(int, O_NBLK) = nb; WSP(int, O_NBLK)[1] = ((nb * 4) / c.G) * c.G / 4; }
    }
    __syncthreads();
    if (c.wave == 0) {
        int* tokslot = WSP(int, O_TOKSLOT); int runq[8];
#pragma unroll
        for (int q = 0; q < 8; ++q) runq[q] = spad[q] + base[q];
        const unsigned long long lt = (1ull << c.lane) - 1ull;
        for (int a0 = 0; a0 < 2 * rpw; a0 += 64) { const int a = a0 + c.lane, rr = a >> 1, k = a & 1; const bool on = a < 2 * rpw; const int e = on ? ((tl[rr] >> (8 * k)) & 255) : -1; int sl = 0;
#pragma unroll
            for (int q = 0; q < 8; ++q) { const unsigned long long m = __ballot(e == q); if (e == q) sl = runq[q] + __popcll(m & lt); runq[q] += __popcll(m); }
            if (on) { tokslot[(r0 + rr) * 2 + k] = sl; pairs[a * 2] = sl; pairs[a * 2 + 1] = r0 + rr; } }
    }
    __syncthreads();
    { const bf16_t* H = WSP(bf16_t, O_H); bf16_t* XS = WSP(bf16_t, O_XS);
      for (int p = c.wave; p < rpw * 2; p += NWAVES) { const int s = pairs[p * 2], tk = pairs[p * 2 + 1];
          const u32x4* src = (const u32x4*)(H + (size_t)tk * D) + c.lane; u32x4* dst = (u32x4*)(XS + (size_t)s * D) + c.lane; dst[0] = src[0]; dst[64] = src[64]; }
      if (c.wg < 8) { const int e = c.wg, p0 = spad[e] + tot[e], p1 = spad[e + 1];
          for (int s = p0 + c.wave; s < p1; s += NWAVES) { u32x4* dst = (u32x4*)(XS + (size_t)s * D) + c.lane; dst[0] = (u32x4){0u, 0u, 0u, 0u}; dst[64] = (u32x4){0u, 0u, 0u, 0u}; } } }
    __syncthreads();
}
__device__ __forceinline__ void next_layer_convert(const Ctx& c, int l, LAS float* scr, int rank, int count) {
    if (l + 1 >= NL) return;
    for (int j = 8 * (l + 1); j < 8 * (l + 2); ++j) { const CvtJob jb = make_job(c, j); cvt_run_ranked(c, jb, scr, rank, count); }
    if (((l + 1) & 1) == 0) for (int j = 8 * NL + 2 * ((l + 1) >> 1); j < 8 * NL + 2 * ((l + 1) >> 1) + 2; ++j) { const CvtJob jb = make_job(c, j); cvt_run_ranked(c, jb, scr, rank, count); }
}
__device__ __forceinline__ void moe_convert(const Ctx& c, int l, LAS float* scr, int rank, int count) {
    for (int j = 0; j < 16; ++j) { const CvtJob jb = make_moe_job(c, l >> 1, j); cvt_run_ranked(c, jb, scr, rank, count); }
}
__device__ __forceinline__ void moe_convert_queue(const Ctx& c, int l, LAS float* scr) {
    unsigned* ctr = (unsigned*)(c.ws + O_CTL) + 256 + 64 * (l >> 1);
    constexpr unsigned NGU = 8u * 16u * (2 * EF / 32), NDN = 8u * (EF / 64) * 32u;
    for (;;) {
        unsigned base = 0; if (c.lane == 0) base = __hip_atomic_fetch_add(ctr, 8u, __ATOMIC_RELAXED, __HIP_MEMORY_SCOPE_AGENT);
        base = __builtin_amdgcn_readfirstlane(base);
        if (base >= NGU + NDN) break;
#pragma unroll 1
        for (unsigned k = 0; k < 8; ++k) { const unsigned idx = base + k; int j, item;
            if (idx < NGU) { j = idx / (NGU / 8); item = idx % (NGU / 8); } else { const unsigned r = idx - NGU; j = 8 + r / (NDN / 8); item = r % (NDN / 8); }
            const CvtJob jb = make_moe_job(c, l >> 1, j); cvt_item(jb, item, scr, c.lane); }
    }
}
__device__ __forceinline__ void next_layer_convert_queue(const Ctx& c, int l, LAS float* scr) {
    if (l + 1 >= NL) return;
    unsigned* ctr = (unsigned*)(c.ws + O_CTL) + 256 + 64 * (4 + l);
    auto grab = [&]() { unsigned b = 0; if (c.lane == 0) b = __hip_atomic_fetch_add(ctr, 8u, __ATOMIC_RELAXED, __HIP_MEMORY_SCOPE_AGENT); return (unsigned)__builtin_amdgcn_readfirstlane(b); };
    unsigned base = grab(), off = 0;
    auto run = [&](int j) { const CvtJob jb = make_job(c, j); const unsigned n = (unsigned)(jb.K / 64) * (unsigned)(jb.Ndst / 32);
        while (base - off < n) {
#pragma unroll 1
            for (unsigned k = 0; k < 8; ++k) cvt_item(jb, (int)(base - off + k), scr, c.lane);
            base = grab(); }
        off += n; };
    if (l == 0) { for (int j = 4; j < 8; ++j) run(j); run(8 * NL); run(8 * NL + 1); }
    for (int j = 8 * (l + 1); j < 8 * (l + 2); ++j) run(j);
    if (((l + 1) & 1) == 0) for (int j = 8 * NL + 2 * ((l + 1) >> 1); j < 8 * NL + 2 * ((l + 1) >> 1) + 2; ++j) run(j);
}
__device__ __forceinline__ void gdn_prep_unit(const Ctx& c, int l, int unit, int stop = 0) {
    const int h = unit & 3, n = (unit >> 2) & 63, b = unit >> 8;
    const int t0 = b * SEQ + n * CH;
    LAS bf16_t* Qb = (LAS bf16_t*)c.lds; LAS bf16_t* Kb = Qb + 64 * 136;
    LAS float* AS = (LAS float*)(c.lds + 34816);
    LAS float* KS = AS + 4096; LAS float* VS = KS + 8643; LAS float* QS = VS + 8643;
    LAS float* GS = QS + 8643; LAS float* BE = GS + 64; LAS float* EG = BE + 64;
    const GAS bf16_t* P = WSG(bf16_t, O_PROJ);
    { LAS unsigned char* rawl = c.lds;
#pragma unroll 1
      for (int k = 0; k < 7; ++k) { const int I = c.wave + 8 * k;
          if (I < 51) { const int idx = I * 64 + c.lane; if (idx < 67 * 48) { const int r = idx / 48, pc = idx % 48;
              if (n > 0 || r >= 3) __builtin_amdgcn_global_load_lds((const unsigned*)((const char*)(P + (size_t)(t0 - 3 + r) * NP + (pc >> 4) * 512 + h * 128 + (pc & 15) * 8)), (LAS unsigned*)(rawl + I * 1024), 16, 0, 0); } } }
      asm volatile("s_waitcnt vmcnt(0)" ::: "memory"); LDS_BARRIER(); }
    if (c.tid < 384) {
        const int part = c.tid >> 7, d = c.tid & 127, col = part * 512 + h * 128 + d;
        const GAS float* cw = ING(6) + (size_t)l * 4 * 1536 + col; const float w0 = cw[0], w1 = cw[1536], w2 = cw[2 * 1536], w3 = cw[3 * 1536];
        const LAS bf16_t* src = (const LAS bf16_t*)c.lds + c.tid;
        unsigned short raw[67];
#pragma unroll
        for (int r = 0; r < 67; ++r) raw[r] = (n > 0 || r >= 3) ? src[r * 384] : (unsigned short)0;
        LAS float* A = (part == 0 ? QS : part == 1 ? KS : VS) + 3 * 129 + d;
#pragma unroll
        for (int t = 0; t < 64; ++t) A[t * 129] = siluf_(w0 * bf2f(raw[t]) + w1 * bf2f(raw[t + 1]) + w2 * bf2f(raw[t + 2]) + w3 * bf2f(raw[t + 3]));
    } else if (c.tid < 448) {
        const int t = c.tid - 384; const GAS float* sf = WSG(float, O_SMALLF) + (size_t)(t0 + t) * 16;
        const float a = sf[h], bb = sf[4 + h];
        const float g = -expf(ING(7)[l * 4 + h]) * softplusf_(a + ING(8)[l * 4 + h]);
        float G = g;
#pragma unroll
        for (int o = 1; o < 64; o <<= 1) { const float up = __shfl_up(G, o); if (t >= o) G += up; }
        GS[t] = G; BE[t] = sigmoidf_(bb); EG[t] = expf(G);
    }
    LDS_BARRIER();
    if (stop == 2) return;
    for (int rr = c.wave; rr < 128; rr += NWAVES) { const bool isq = rr < 64; const int t = rr & 63; LAS float* row = (isq ? QS : KS) + (t + 3) * 129;
        const float a = row[c.lane], bq = row[c.lane + 64]; const float ss = wave_sum(a * a + bq * bq); const float sc = rsqrtf(ss + EPS) * (isq ? 0.08838834764831845f : 1.f);
        LAS bf16_t* ob = (isq ? Qb : Kb) + t * 136;
        ob[c.lane] = (bf16_t)f2bf(a * sc); ob[c.lane + 64] = (bf16_t)f2bf(bq * sc);
        if (!isq) { row[c.lane] = a * sc; row[c.lane + 64] = bq * sc; } }
    LDS_BARRIER();
    LAS float* QKs = QS;
    { const int typ = c.wave >> 2, ti = c.wave & 3, lr = c.lane & 15, g = c.lane >> 4;
      const LAS bf16_t* Xb = typ ? Qb : Kb;
#pragma unroll 1
      for (int tj = 0; tj < 4; ++tj) {
          f32x4 acc = {0.f, 0.f, 0.f, 0.f};
          if (tj <= ti) {
#pragma unroll
              for (int ks = 0; ks < 4; ++ks) { const bf16x8 af = *(const LAS bf16x8*)(Xb + (16 * ti + lr) * 136 + 32 * ks + 8 * g); const bf16x8 bf = *(const LAS bf16x8*)(Kb + (16 * tj + lr) * 136 + 32 * ks + 8 * g);
                  acc = __builtin_amdgcn_mfma_f32_16x16x32_bf16(af, bf, acc, 0, 0, 0); } }
          const int j = 16 * tj + lr;
#pragma unroll
          for (int r = 0; r < 4; ++r) { const int i = 16 * ti + 4 * g + r; float v = 0.f;
              if (typ == 0) { if (j < i) v = BE[i] * acc[r] * __expf(GS[i] - GS[j]); AS[i * 64 + j] = v; }
              else { if (j <= i) v = acc[r] * __expf(GS[i] - GS[j]); QKs[i * 65 + j] = v; } } } }
    LDS_BARRIER();
    if (stop == 4) return;
    const int chunk = (b * 4 + h) * 64 + n;
    if (c.tid >= 256) { GAS bf16_t* OPS = WSG(bf16_t, O_GW) + (size_t)chunk * (56 * 512); const float gl = GS[63];
#pragma unroll 1
      for (int q = 1024 + (c.tid - 256); q < 56 * 64; q += 256) { const int f = q >> 6, ln = q & 63, lr = ln & 15, g = ln >> 4; float v[8];
          if (f < 32) { const int ct = (f - 16) >> 2, ks = (f - 16) & 3, i = 16 * ct + lr; const float eg = EG[i]; const LAS bf16_t* qr = Qb + i * 136 + 32 * ks + 4 * g;
#pragma unroll
              for (int j = 0; j < 4; ++j) { v[j] = bf2f(qr[j]) * eg; v[4 + j] = bf2f(qr[16 + j]) * eg; } }
          else if (f < 40) { const int ct = (f - 32) >> 1, ks2 = (f - 32) & 1; const LAS float* qr = QKs + (16 * ct + lr) * 65 + 32 * ks2 + 4 * g;
#pragma unroll
              for (int j = 0; j < 4; ++j) { v[j] = qr[j]; v[4 + j] = qr[16 + j]; } }
          else { const int dt = (f - 40) >> 1, ks2 = (f - 40) & 1, dk = 16 * dt + lr, c0 = 32 * ks2 + 4 * g;
#pragma unroll
              for (int j = 0; j < 4; ++j) { v[j] = bf2f(Kb[(c0 + j) * 136 + dk]) * __expf(gl - GS[c0 + j]); v[4 + j] = bf2f(Kb[(c0 + 16 + j) * 136 + dk]) * __expf(gl - GS[c0 + 16 + j]); } }
          u32x4 o; o.x = pk2(v[0], v[1]); o.y = pk2(v[2], v[3]); o.z = pk2(v[4], v[5]); o.w = pk2(v[6], v[7]);
          *(GAS u32x4*)(OPS + (size_t)q * 8) = o; }
      if (c.tid == 256) WSG(float, O_GL)[chunk] = expf(gl);
    } else {
        const int col = c.tid; LAS float* src = ((col < 128) ? VS + col : KS + (col - 128)) + 3 * 129;
        unsigned asb = (unsigned)(uintptr_t)AS; asm volatile("" : "+v"(asb));
        const LAS float* ASv = (const LAS float*)(uintptr_t)asb; const LAS float* BEv = ASv + 4096 + 3 * 8643 + 64; const LAS float* EGv = BEv + 64;
        const LAS f32x4* A4 = (const LAS f32x4*)ASv;
        f32x2 x2[32]; f32x4 ar[16];
#pragma unroll
        for (int m = 0; m < 32; ++m) { x2[m][0] = src[(2 * m) * 129] * BEv[2 * m] * (col < 128 ? 1.f : EGv[2 * m]); x2[m][1] = src[(2 * m + 1) * 129] * BEv[2 * m + 1] * (col < 128 ? 1.f : EGv[2 * m + 1]); }
        ar[0] = A4[16];
#pragma unroll
        for (int i = 0; i < 64; ++i) {
            f32x2 acc0 = {0.f, 0.f}, acc1 = {0.f, 0.f};
#pragma unroll
            for (int q = 0; 4 * q < i; ++q) { const f32x4 aq = ar[q];
                if (4 * q + 1 < i) acc0 = acc0 + (f32x2){aq[0], aq[1]} * x2[2 * q]; else acc0[0] += aq[0] * x2[2 * q][0];
                if (4 * q + 3 < i) acc1 = acc1 + (f32x2){aq[2], aq[3]} * x2[2 * q + 1]; else if (4 * q + 2 < i) acc1[0] += aq[2] * x2[2 * q + 1][0];
                if (i + 1 < 64) ar[q] = A4[(i + 1) * 16 + q]; }
            if (i >= 1 && (i & 3) == 0 && i + 1 < 64) ar[i >> 2] = A4[(i + 1) * 16 + (i >> 2)];
            const float sx = x2[i >> 1][i & 1] - ((acc0[0] + acc0[1]) + (acc1[0] + acc1[1]));
            x2[i >> 1][i & 1] = sx; src[i * 129] = sx;
        }
    }
    LDS_BARRIER();
    if (stop == 6) return;
    { GAS bf16_t* OPS = WSG(bf16_t, O_GW) + (size_t)chunk * (56 * 512);
#pragma unroll 1
      for (int q = c.tid; q < 1024; q += NTHR) { const int f = q >> 6, ln = q & 63, lr = ln & 15, g = ln >> 4, ct = f >> 2, ks = f & 3; const LAS float* wr = KS + (16 * ct + lr + 3) * 129 + 32 * ks + 4 * g;
          u32x4 o; o.x = pk2(wr[0], wr[1]); o.y = pk2(wr[2], wr[3]); o.z = pk2(wr[16], wr[17]); o.w = pk2(wr[18], wr[19]);
          *(GAS u32x4*)(OPS + (size_t)q * 8) = o; }
      GAS float* UF = WSG(float, O_GU) + (size_t)chunk * 8192;
#pragma unroll 1
      for (int q = c.tid; q < 2048; q += NTHR) { const int es = q >> 8, ct = (q >> 6) & 3, ln = q & 63, lr = ln & 15, g = ln >> 4; const LAS float* ur = VS + (16 * ct + 4 * g + 3) * 129 + 16 * es + lr;
          *(GAS f32x4*)(UF + (size_t)q * 4) = (f32x4){ur[0], ur[129], ur[258], ur[387]}; } }
    LDS_BARRIER();
}

__device__ __forceinline__ void gdn_scan_wave(const Ctx& c, int bh, int es) {
    const int lane = c.lane; const unsigned l16 = (unsigned)lane * 16u;
    const char* ops = (const char*)(WSG(bf16_t, O_GW)) + (size_t)bh * 64 * 57344;
    const char* uf = (const char*)(WSG(float, O_GU)) + (size_t)bh * 64 * 32768 + es * 4096;
    char* sv = (char*)c.ws + O_MF + ((size_t)bh * 64 * 8 + es) * 6144;
    const GAS float* GL = WSG(float, O_GL) + bh * 64;
    LAS unsigned char* lds = c.lds;
#define GS_ISSUE(n_, buf_) do { const char* so_ = ops + (size_t)(n_) * 57344; const char* su_ = uf + (size_t)(n_) * 32768; LAS unsigned char* d_ = lds + (buf_) * 36864; \
        _Pragma("unroll") for (int f_ = 0; f_ < 16; ++f_) __builtin_amdgcn_global_load_lds((const unsigned*)(so_ + f_ * 1024 + l16), (LAS unsigned*)(d_ + f_ * 1024), 16, 0, 0); \
        _Pragma("unroll") for (int f_ = 0; f_ < 16; ++f_) __builtin_amdgcn_global_load_lds((const unsigned*)(so_ + (40 + f_) * 1024 + l16), (LAS unsigned*)(d_ + 16384 + f_ * 1024), 16, 0, 0); \
        _Pragma("unroll") for (int f_ = 0; f_ < 4; ++f_) __builtin_amdgcn_global_load_lds((const unsigned*)(su_ + f_ * 1024 + l16), (LAS unsigned*)(d_ + 32768 + f_ * 1024), 16, 0, 0); } while (0)
#define GS_FRAG(f_) (*(const LAS bf16x8*)(B + (f_) * 1024 + lane * 16))
    f32x4 S[8];
#pragma unroll
    for (int d = 0; d < 8; ++d) S[d] = (f32x4){0.f, 0.f, 0.f, 0.f};
    const float glv = GL[lane];
    asm volatile("s_waitcnt vmcnt(0)" ::: "memory");
    GS_ISSUE(0, 0);
#pragma unroll 1
    for (int n = 0; n < NCH; ++n) {
        const int buf = n & 1;
        if (n + 1 < NCH) { GS_ISSUE(n + 1, buf ^ 1); asm volatile("s_waitcnt vmcnt(36)" ::: "memory"); } else asm volatile("s_waitcnt vmcnt(0)" ::: "memory");
        const LAS unsigned char* B = lds + buf * 36864;
        GAS u32x4* svn = (GAS u32x4*)(sv + (size_t)n * 49152 + l16);
        f32x4 vn[4], acc[4]; bf16x8 Sb[4], vnb[2];
#pragma unroll
        for (int ct = 0; ct < 4; ++ct) { vn[ct] = *(const LAS f32x4*)(B + 32768 + ct * 1024 + lane * 16); acc[ct] = (f32x4){0.f, 0.f, 0.f, 0.f}; }
#pragma unroll
        for (int ks = 0; ks < 4; ++ks) { u32x4 w; w.x = pk2(S[2 * ks][0], S[2 * ks][1]); w.y = pk2(S[2 * ks][2], S[2 * ks][3]); w.z = pk2(S[2 * ks + 1][0], S[2 * ks + 1][1]); w.w = pk2(S[2 * ks + 1][2], S[2 * ks + 1][3]); Sb[ks] = __builtin_bit_cast(bf16x8, w); svn[ks * 64] = w; }
#pragma unroll
        for (int ks = 0; ks < 4; ++ks)
#pragma unroll
            for (int ct = 0; ct < 4; ++ct) acc[ct] = __builtin_amdgcn_mfma_f32_16x16x32_bf16(GS_FRAG(ct * 4 + ks), Sb[ks], acc[ct], 0, 0, 0);
#pragma unroll
        for (int ct = 0; ct < 4; ++ct) vn[ct] = vn[ct] - acc[ct];
#pragma unroll
        for (int k2 = 0; k2 < 2; ++k2) { u32x4 w; w.x = pk2(vn[2 * k2][0], vn[2 * k2][1]); w.y = pk2(vn[2 * k2][2], vn[2 * k2][3]); w.z = pk2(vn[2 * k2 + 1][0], vn[2 * k2 + 1][1]); w.w = pk2(vn[2 * k2 + 1][2], vn[2 * k2 + 1][3]); vnb[k2] = __builtin_bit_cast(bf16x8, w); svn[(4 + k2) * 64] = w; }
        const float gl = __builtin_bit_cast(float, __builtin_amdgcn_readlane(__builtin_bit_cast(int, glv), n));
#pragma unroll
        for (int d = 0; d < 8; ++d) S[d] = S[d] * gl;
#pragma unroll
        for (int k2 = 0; k2 < 2; ++k2)
#pragma unroll
            for (int d = 0; d < 8; ++d) S[d] = __builtin_amdgcn_mfma_f32_16x16x32_bf16(GS_FRAG(16 + d * 2 + k2), vnb[k2], S[d], 0, 0, 0);
    }
#undef GS_ISSUE
#undef GS_FRAG
}
__device__ __forceinline__ void gdn_out_phase(const Ctx& c, int l) {
    const int lane = c.lane, lr = lane & 15, g = lane >> 4, ts = c.wave >> 1, hf = c.wave & 1;
    const GAS bf16_t* P = WSG(bf16_t, O_PROJ); GAS bf16_t* YA = WSG(bf16_t, O_YA);
    LAS unsigned char* R = c.lds + ts * 24576;
    LAS float* SSQ = (LAS float*)(c.lds + 4 * 24576) + ts * 128;
    for (int tbase = 0; tbase < NB * 4 * NCH; tbase += c.G * 4) {
        const int task = tbase + c.wg + c.G * ts; const bool on = task < NB * 4 * NCH;
        const int bh = task >> 6, n = task & 63, b = bh >> 2, h = bh & 3, t0 = b * SEQ + n * CH;
        const char* ops = (const char*)(WSG(bf16_t, O_GW)) + (size_t)task * 57344 + lane * 16;
        const char* sv = (const char*)c.ws + O_MF + (size_t)task * 49152 + lane * 16;
        LDS_BARRIER();
        if (on) {
#pragma unroll
            for (int f = 0; f < 12; ++f) __builtin_amdgcn_global_load_lds((const unsigned*)(ops + (16 + 12 * hf + f) * 1024), (LAS unsigned*)(R + (12 * hf + f) * 1024), 16, 0, 0); }
        asm volatile("s_waitcnt vmcnt(0)" ::: "memory"); LDS_BARRIER();
        f32x4 o[4][4];
        if (on) {
#pragma unroll
            for (int e4 = 0; e4 < 4; ++e4) { const int es = 4 * hf + e4; bf16x8 sb[6];
#pragma unroll
                for (int f = 0; f < 6; ++f) sb[f] = *(const GAS bf16x8*)(sv + (es * 6 + f) * 1024);
#pragma unroll
                for (int ct = 0; ct < 4; ++ct) { f32x4 a = {0.f, 0.f, 0.f, 0.f};
#pragma unroll
                    for (int ks = 0; ks < 4; ++ks) a = __builtin_amdgcn_mfma_f32_16x16x32_bf16(*(const LAS bf16x8*)(R + (ct * 4 + ks) * 1024 + lane * 16), sb[ks], a, 0, 0, 0);
#pragma unroll
                    for (int k2 = 0; k2 < 2; ++k2) a = __builtin_amdgcn_mfma_f32_16x16x32_bf16(*(const LAS bf16x8*)(R + (16 + ct * 2 + k2) * 1024 + lane * 16), sb[4 + k2], a, 0, 0, 0);
                    o[e4][ct] = a; } }
#pragma unroll
            for (int ct = 0; ct < 4; ++ct)
#pragma unroll
                for (int r = 0; r < 4; ++r) { float ss = 0.f;
#pragma unroll
                    for (int e4 = 0; e4 < 4; ++e4) ss += o[e4][ct][r] * o[e4][ct][r];
                    ss = row16_sum(ss); if (lr == 0) SSQ[hf * 64 + 16 * ct + 4 * g + r] = ss; }
        }
        LDS_BARRIER();
        if (on) {
            LAS bf16_t* OT = (LAS bf16_t*)R;
#pragma unroll
            for (int ct = 0; ct < 4; ++ct)
#pragma unroll
                for (int r = 0; r < 4; ++r) { const int row = 16 * ct + 4 * g + r; const float rs = rsqrtf((SSQ[row] + SSQ[64 + row]) * (1.f / 128.f) + EPS);
#pragma unroll
                    for (int e4 = 0; e4 < 4; ++e4) OT[row * 136 + 16 * (4 * hf + e4) + lr] = (bf16_t)f2bf(o[e4][ct][r] * rs); }
        }
        LDS_BARRIER();
        if (on) {
            const LAS bf16_t* OT = (const LAS bf16_t*)R;
#pragma unroll
            for (int k = 0; k < 8; ++k) { const int ch = lane + 64 * k, row = 32 * hf + (ch >> 4), ec = (ch & 15) * 8; const size_t t = (size_t)(t0 + row);
                f32x4 x0, x1, z0, z1; unpk8(*(const LAS u32x4*)(OT + row * 136 + ec), x0, x1); unpk8(*(const GAS u32x4*)(P + t * NP + C_GZ + h * 128 + ec), z0, z1);
                const f32x4 w0 = *(const GAS f32x4*)(ING(9) + l * 128 + ec), w1 = *(const GAS f32x4*)(ING(9) + l * 128 + ec + 4);
#pragma unroll
                for (int i = 0; i < 4; ++i) { x0[i] = x0[i] * w0[i] * siluf_(z0[i]); x1[i] = x1[i] * w1[i] * siluf_(z1[i]); }
                *(GAS u32x4*)(YA + t * 512 + h * 128 + ec) = pk8(x0, x1); }
        }
    }
    LDS_BARRIER();
}

__device__ __forceinline__ void gdn_scan_unit(const Ctx& c, int unit) {
    const int es = unit & 3, h = (unit >> 2) & 3, b = unit >> 4;
    LAS float* SST = (LAS float*)c.lds;
    LAS bf16_t* WL = (LAS bf16_t*)(c.lds + 16896); LAS bf16_t* QDL = WL + 8192; LAS bf16_t* KDL = QDL + 8192; LAS bf16_t* QKL = KDL + 8192;
    LAS float* VN = (LAS float*)(c.lds + 16896 + 3 * 16384 + 8192);
    for (int i = c.tid; i < 128 * 33; i += NTHR) SST[i] = 0.f;
    const GAS bf16_t* W = WSG(bf16_t, O_GW); const GAS bf16_t* QD = WSG(bf16_t, O_GQD); const GAS bf16_t* KD = WSG(bf16_t, O_GKD); const GAS bf16_t* QK = WSG(bf16_t, O_GQK);
    const GAS float* U = WSG(float, O_GU); GAS float* GO = WSG(float, O_GO); const GAS float* GL = WSG(float, O_GL) + (b * 4 + h) * 64;
    const int e = c.tid & 31, cc = c.tid >> 5;
    for (int n = 0; n < NCH; ++n) {
        const int t0 = b * SEQ + n * CH;
        __syncthreads();
#pragma unroll
        for (int k = 0; k < 2; ++k) { const int p = c.tid + k * NTHR, r = p >> 4, q = p & 15; const size_t go = (size_t)(t0 + r) * 512 + h * 128 + q * 8;
            *(LAS u32x4*)(WL + r * 128 + q * 8) = *(const GAS u32x4*)(W + go); *(LAS u32x4*)(QDL + r * 128 + q * 8) = *(const GAS u32x4*)(QD + go); *(LAS u32x4*)(KDL + r * 128 + q * 8) = *(const GAS u32x4*)(KD + go); }
        { const int r = c.tid >> 3, q = c.tid & 7; *(LAS u32x4*)(QKL + r * 64 + q * 8) = *(const GAS u32x4*)(QK + ((size_t)(t0 + r) * 4 + h) * 64 + q * 8); }
        __syncthreads();
#pragma unroll 1
        for (int r = 0; r < 4; ++r) { const int ci = cc + 16 * r; float a = U[(size_t)(t0 + ci) * 512 + h * 128 + es * 32 + e];
            const LAS unsigned* wr = (const LAS unsigned*)(WL + ci * 128);
#pragma unroll 8
            for (int d2 = 0; d2 < 64; ++d2) { const unsigned w2 = wr[d2]; a -= lo16(w2) * SST[(2 * d2) * 33 + e] + hi16(w2) * SST[(2 * d2 + 1) * 33 + e]; }
            VN[ci * 33 + e] = a; }
        __syncthreads();
#pragma unroll 1
        for (int r = 0; r < 4; ++r) { const int ci = cc + 16 * r; float a = 0.f;
            const LAS unsigned* qr = (const LAS unsigned*)(QDL + ci * 128);
#pragma unroll 8
            for (int d2 = 0; d2 < 64; ++d2) { const unsigned w2 = qr[d2]; a += lo16(w2) * SST[(2 * d2) * 33 + e] + hi16(w2) * SST[(2 * d2 + 1) * 33 + e]; }
            const LAS unsigned* kr = (const LAS unsigned*)(QKL + ci * 64);
#pragma unroll 8
            for (int j2 = 0; j2 < 32; ++j2) { const unsigned w2 = kr[j2]; a += lo16(w2) * VN[(2 * j2) * 33 + e] + hi16(w2) * VN[(2 * j2 + 1) * 33 + e]; }
            GO[(size_t)(t0 + ci) * 512 + h * 128 + es * 32 + e] = a; }
        const float gl = GL[n]; float sn[8];
#pragma unroll
        for (int r = 0; r < 8; ++r) { const int dk = cc + 16 * r; float a = SST[dk * 33 + e] * gl;
#pragma unroll 8
            for (int ci = 0; ci < 64; ++ci) a += bf2f(KDL[ci * 128 + dk]) * VN[ci * 33 + e];
            sn[r] = a; }
        __syncthreads();
#pragma unroll
        for (int r = 0; r < 8; ++r) SST[(cc + 16 * r) * 33 + e] = sn[r];
    }
    __syncthreads();
}
__device__ __forceinline__ void gdn_finish_phase(const Ctx& c, int l) {
    const GAS float* GO = WSG(float, O_GO); const GAS bf16_t* P = WSG(bf16_t, O_PROJ); GAS bf16_t* YA = WSG(bf16_t, O_YA);
    const float nw0 = ING(9)[l * 128 + c.lane], nw1 = ING(9)[l * 128 + 64 + c.lane];
    for (int t = c.gw; t < T; t += c.NGW) {
#pragma unroll
        for (int h = 0; h < 4; ++h) { const float o0 = GO[(size_t)t * 512 + h * 128 + c.lane], o1 = GO[(size_t)t * 512 + h * 128 + 64 + c.lane];
            const float r = rsqrtf(wave_sum(o0 * o0 + o1 * o1) * (1.f / 128.f) + EPS);
            const float z0 = bf2f(P[(size_t)t * NP + C_GZ + h * 128 + c.lane]), z1 = bf2f(P[(size_t)t * NP + C_GZ + h * 128 + 64 + c.lane]);
            YA[(size_t)t * 512 + h * 128 + c.lane] = (bf16_t)f2bf(o0 * r * nw0 * siluf_(z0)); YA[(size_t)t * 512 + h * 128 + 64 + c.lane] = (bf16_t)f2bf(o1 * r * nw1 * siluf_(z1)); }
    }
}
__device__ __forceinline__ void ssd_prep_unit(const Ctx& c, int l, int unit) {
    const int grp = unit & 1, n = (unit >> 1) & 63, b = unit >> 7;
    const int t0 = b * SEQ + n * CH;
    LAS bf16_t* XT = (LAS bf16_t*)c.lds; LAS bf16_t* XTS = XT + 256 * 72; LAS bf16_t* BT = XTS + 256 * 72;
    LAS bf16_t* Bm = BT + 128 * 72; LAS bf16_t* Cm = Bm + 64 * 136;
    LAS float* DT = (LAS float*)(Cm + 64 * 136); LAS float* ACS = DT + 256; LAS float* SCV = ACS + 256;
    const GAS bf16_t* P = WSG(bf16_t, O_PROJ);
    if (c.wave < 4) { const int hq = c.wave, hh = grp * 4 + hq, t = c.lane;
        const float dt = softplusf_(WSG(float, O_SMALLF)[(size_t)(t0 + t) * 16 + 8 + hh] + ING(13)[l * 8 + hh]);
        float a = -expf(ING(12)[l * 8 + hh]) * dt;
#pragma unroll
        for (int o = 1; o < 64; o <<= 1) { const float up = __shfl_up(a, o); if (t >= o) a += up; }
        const float alast = __shfl(a, 63);
        DT[hq * 64 + t] = dt; ACS[hq * 64 + t] = a; SCV[hq * 64 + t] = dt * expf(alast - a); const float ea = expf(a); WSG(float, O_EA)[(size_t)(t0 + t) * 8 + hh] = ea;
        if (t == 63) WSG(float, O_DEC)[(b * 8 + hh) * 64 + n] = ea; }
    LDS_BARRIER();
    { const int ch = c.tid < 256 ? grp * 256 + c.tid : c.tid < 384 ? 512 + grp * 128 + (c.tid - 256) : 768 + grp * 128 + (c.tid - 384);
      const GAS float* cw = ING(10) + (size_t)l * 4 * 1024 + ch; const float w0 = cw[0], w1 = cw[1024], w2 = cw[2048], w3 = cw[3072], bias = ING(11)[l * 1024 + ch];
      const GAS bf16_t* src = P + (size_t)(t0 - 3) * NP + C_XBC + ch;
      unsigned short raw[67];
#pragma unroll
      for (int r = 0; r < 67; ++r) raw[r] = (n > 0 || r >= 3) ? src[(size_t)r * NP] : (unsigned short)0;
      const int hq = c.tid >> 6;
#pragma unroll
      for (int t8 = 0; t8 < 8; ++t8) { float y[8];
#pragma unroll
          for (int k = 0; k < 8; ++k) { const int t = t8 * 8 + k; y[k] = siluf_(w0 * bf2f(raw[t]) + w1 * bf2f(raw[t + 1]) + w2 * bf2f(raw[t + 2]) + w3 * bf2f(raw[t + 3]) + bias); }
          u32x4 o; o.x = pk2(y[0], y[1]); o.y = pk2(y[2], y[3]); o.z = pk2(y[4], y[5]); o.w = pk2(y[6], y[7]);
          if (c.tid < 256) { *(LAS u32x4*)(XT + c.tid * 72 + t8 * 8) = o; const LAS float* sv = SCV + hq * 64 + t8 * 8;
              u32x4 q; q.x = pk2(y[0] * sv[0], y[1] * sv[1]); q.y = pk2(y[2] * sv[2], y[3] * sv[3]); q.z = pk2(y[4] * sv[4], y[5] * sv[5]); q.w = pk2(y[6] * sv[6], y[7] * sv[7]);
              *(LAS u32x4*)(XTS + c.tid * 72 + t8 * 8) = q; }
          else if (c.tid < 384) { const int nn = c.tid - 256; *(LAS u32x4*)(BT + nn * 72 + t8 * 8) = o;
#pragma unroll
              for (int k = 0; k < 8; ++k) Bm[(t8 * 8 + k) * 136 + nn] = (bf16_t)f2bf(y[k]); }
          else { const int nn = c.tid - 384; GAS bf16_t* CC = WSG(bf16_t, O_SCC) + (size_t)t0 * 256 + grp * 128 + nn;
#pragma unroll
              for (int k = 0; k < 8; ++k) { const bf16_t v = (bf16_t)f2bf(y[k]); Cm[(t8 * 8 + k) * 136 + nn] = v; CC[(size_t)(t8 * 8 + k) * 256] = v; } } } }
    LDS_BARRIER();
    const int lr = c.lane & 15, g = c.lane >> 4;
    { const int tl = c.wave & 3, hp = c.wave >> 2, lcol = 16 * tl + lr;
      f32x4 cb[4];
#pragma unroll
      for (int ts = 0; ts < 4; ++ts) { cb[ts] = (f32x4){0.f, 0.f, 0.f, 0.f};
          if (ts <= tl) {
#pragma unroll
              for (int ks = 0; ks < 4; ++ks) cb[ts] = __builtin_amdgcn_mfma_f32_16x16x32_bf16(*(const LAS bf16x8*)(Bm + (16 * ts + lr) * 136 + 32 * ks + 8 * g), *(const LAS bf16x8*)(Cm + lcol * 136 + 32 * ks + 8 * g), cb[ts], 0, 0, 0); } }
#pragma unroll 1
      for (int hq = 2 * hp; hq < 2 * hp + 2; ++hq) { const int hh = grp * 4 + hq; const float dsk = ING(14)[l * 8 + hh], al = ACS[hq * 64 + lcol];
          f32x4 mt[4];
#pragma unroll
          for (int ts = 0; ts < 4; ++ts)
#pragma unroll
              for (int r = 0; r < 4; ++r) { const int sx = 16 * ts + 4 * g + r; float v = 0.f; if (sx <= lcol) v = cb[ts][r] * __expf(al - ACS[hq * 64 + sx]) * DT[hq * 64 + sx]; if (sx == lcol) v += dsk; mt[ts][r] = v; }
          bf16x8 mb[2];
#pragma unroll
          for (int k2 = 0; k2 < 2; ++k2) { u32x4 w; w.x = pk2(mt[2 * k2][0], mt[2 * k2][1]); w.y = pk2(mt[2 * k2][2], mt[2 * k2][3]); w.z = pk2(mt[2 * k2 + 1][0], mt[2 * k2 + 1][1]); w.w = pk2(mt[2 * k2 + 1][2], mt[2 * k2 + 1][3]); mb[k2] = __builtin_bit_cast(bf16x8, w); }
          GAS float* YP = WSG(float, O_SYP) + (size_t)(t0 + lcol) * 512 + hh * 64 + 4 * g;
#pragma unroll
          for (int tp = 0; tp < 4; ++tp) { f32x4 acc = {0.f, 0.f, 0.f, 0.f};
#pragma unroll
              for (int k2 = 0; k2 < 2; ++k2) { const LAS bf16_t* xp = XT + (hq * 64 + 16 * tp + lr) * 72 + 32 * k2 + 4 * g; const u32x2 lo = *(const LAS u32x2*)xp, hi = *(const LAS u32x2*)(xp + 16);
                  u32x4 w; w.x = lo.x; w.y = lo.y; w.z = hi.x; w.w = hi.y; acc = __builtin_amdgcn_mfma_f32_16x16x32_bf16(__builtin_bit_cast(bf16x8, w), mb[k2], acc, 0, 0, 0); }
              *(GAS f32x4*)(YP + 16 * tp) = acc; } } }
    { const int hq = c.wave >> 1, hh = grp * 4 + hq; GAS float* ST = WSG(float, O_SST) + ((size_t)((b * 8 + hh) * 64 + n)) * 8192;
#pragma unroll 1
      for (int tq = 0; tq < 4; ++tq) { const int tn = 4 * (c.wave & 1) + tq;
          const bf16x8 a0 = *(const LAS bf16x8*)(BT + (16 * tn + lr) * 72 + 8 * g), a1 = *(const LAS bf16x8*)(BT + (16 * tn + lr) * 72 + 32 + 8 * g);
#pragma unroll
          for (int tp = 0; tp < 4; ++tp) { f32x4 acc = {0.f, 0.f, 0.f, 0.f}; const LAS bf16_t* xp = XTS + (hq * 64 + 16 * tp + lr) * 72 + 8 * g;
              acc = __builtin_amdgcn_mfma_f32_16x16x32_bf16(a0, *(const LAS bf16x8*)xp, acc, 0, 0, 0); acc = __builtin_amdgcn_mfma_f32_16x16x32_bf16(a1, *(const LAS bf16x8*)(xp + 32), acc, 0, 0, 0);
              *(GAS f32x4*)(ST + (size_t)(16 * tp + lr) * 128 + 16 * tn + 4 * g) = acc; } } }
    LDS_BARRIER();
}
__device__ __forceinline__ void ssd_scan_phase(const Ctx& c) {
    GAS float* ST = WSG(float, O_SST); const GAS float* DEC = WSG(float, O_DEC);
    const int nthr = 128 * 448, me = c.wg * 448 + (c.tid - 64);
    for (int idx = me; idx < NB * 8 * 4096; idx += nthr) {
        const int bh = idx >> 12, el = (idx & 4095) * 2; GAS float* p = ST + (size_t)bh * 64 * 8192 + el; const GAS float* dc = DEC + bh * 64;
        float hx = 0.f, hy = 0.f;
#pragma unroll 1
        for (int n0 = 0; n0 < 64; n0 += 32) { f32x2 s[32];
#pragma unroll
            for (int k = 0; k < 32; ++k) s[k] = *(const GAS f32x2*)(p + (size_t)(n0 + k) * 8192);
#pragma unroll
            for (int k = 0; k < 32; ++k) { f32x2 o; o.x = hx; o.y = hy; *(GAS f32x2*)(p + (size_t)(n0 + k) * 8192) = o; const float d = dc[n0 + k]; hx = hx * d + s[k].x; hy = hy * d + s[k].y; } }
    }
}
__device__ __forceinline__ void ssd_finish_unit(const Ctx& c, int l, int unit) {
    const int grp = unit & 1, n = (unit >> 1) & 63, b = unit >> 7;
    const int t0 = b * SEQ + n * CH;
    LAS float* YS = (LAS float*)c.lds;
    const GAS bf16_t* CC = WSG(bf16_t, O_SCC); const GAS float* EA = WSG(float, O_EA); const GAS float* YP = WSG(float, O_SYP);
    const int lr = c.lane & 15, g = c.lane >> 4;
    { const int hq = c.wave >> 1, hh = grp * 4 + hq; const GAS float* ST = WSG(float, O_SST) + ((size_t)((b * 8 + hh) * 64 + n)) * 8192;
      f32x4 acc[4][2];
#pragma unroll
      for (int tp = 0; tp < 4; ++tp) { acc[tp][0] = (f32x4){0.f, 0.f, 0.f, 0.f}; acc[tp][1] = (f32x4){0.f, 0.f, 0.f, 0.f}; }
#pragma unroll
      for (int ks = 0; ks < 4; ++ks) { bf16x8 cf[2];
#pragma unroll
          for (int q = 0; q < 2; ++q) cf[q] = *(const GAS bf16x8*)(CC + (size_t)(t0 + 16 * (2 * (c.wave & 1) + q) + lr) * 256 + grp * 128 + 32 * ks + 8 * g);
#pragma unroll
          for (int tp = 0; tp < 4; ++tp) { const GAS float* pp = ST + (size_t)(16 * tp + lr) * 128 + 32 * ks + 8 * g; const f32x4 p0 = *(const GAS f32x4*)pp, p1 = *(const GAS f32x4*)(pp + 4);
              const bf16x8 pf = __builtin_bit_cast(bf16x8, pk8(p0, p1));
              acc[tp][0] = __builtin_amdgcn_mfma_f32_16x16x32_bf16(pf, cf[0], acc[tp][0], 0, 0, 0); acc[tp][1] = __builtin_amdgcn_mfma_f32_16x16x32_bf16(pf, cf[1], acc[tp][1], 0, 0, 0); } }
#pragma unroll
      for (int q = 0; q < 2; ++q) { const int li = 16 * (2 * (c.wave & 1) + q) + lr; const float ea = EA[(size_t)(t0 + li) * 8 + hh];
#pragma unroll
          for (int tp = 0; tp < 4; ++tp) { const f32x4 yp = *(const GAS f32x4*)(YP + (size_t)(t0 + li) * 512 + hh * 64 + 16 * tp + 4 * g); const f32x4 y = yp + acc[tp][q] * ea;
              LAS float* d = YS + li * 260 + hq * 64 + 16 * tp + 4 * g; d[0] = y[0]; d[1] = y[1]; d[2] = y[2]; d[3] = y[3]; } } }
    LDS_BARRIER();
    const GAS bf16_t* P = WSG(bf16_t, O_PROJ); GAS bf16_t* YB = WSG(bf16_t, O_YB); const GAS float* nw = ING(15) + l * 512 + grp * 256;
    for (int li = c.wave; li < 64; li += NWAVES) { const int t = t0 + li; float y[4]; float ss = 0.f;
#pragma unroll
        for (int q = 0; q < 4; ++q) { const int ch = c.lane + 64 * q; const float z = bf2f(P[(size_t)t * NP + C_SZ + grp * 256 + ch]); y[q] = YS[li * 260 + ch] * siluf_(z); ss += y[q] * y[q]; }
        const float r = rsqrtf(wave_sum(ss) * (1.f / 256.f) + EPS);
#pragma unroll
        for (int q = 0; q < 4; ++q) { const int ch = c.lane + 64 * q; YB[(size_t)t * 512 + grp * 256 + ch] = (bf16_t)f2bf(y[q] * r * nw[ch]); } }
    LDS_BARRIER();
}

__device__ __forceinline__ void mla_rows_phase(const Ctx& c) {
    const GAS bf16_t* P = WSG(bf16_t, O_PROJ); const GAS float* ROPE = WSG(float, O_ROPE); GAS bf16_t* KR = WSG(bf16_t, O_KR);
    for (int t = c.gw; t < T; t += c.NGW) {
        const GAS bf16_t* pr = P + (size_t)t * NP;
        const u32x4 a = *(const GAS u32x4*)(pr + C_CQ + 8 * c.lane); const u32x2 k2 = *(const GAS u32x2*)(pr + C_CKV + 4 * c.lane);
        f32x4 a0, a1; unpk8(a, a0, a1);
        float sq = (a0[0] * a0[0] + a0[1] * a0[1]) + (a0[2] * a0[2] + a0[3] * a0[3]) + (a1[0] * a1[0] + a1[1] * a1[1]) + (a1[2] * a1[2] + a1[3] * a1[3]);
        const float k0 = lo16(k2.x), k1 = hi16(k2.x), k2f = lo16(k2.y), k3 = hi16(k2.y); float sk = (k0 * k0 + k1 * k1) + (k2f * k2f + k3 * k3);
        sq = wave_sum(sq); sk = wave_sum(sk);
        const float x = bf2f(pr[C_KR + c.lane]); const float xo = __shfl_xor(x, 32);
        if (c.lane == 0) { WSG(float, O_RQ)[t] = rsqrtf(sq * (1.f / 512.f) + EPS); WSG(float, O_RKV)[t] = rsqrtf(sk * (1.f / 256.f) + EPS); }
        if (c.lane < 32) { const float cs = ROPE[((size_t)t * 32 + c.lane) * 2], sn = ROPE[((size_t)t * 32 + c.lane) * 2 + 1];
            *(GAS unsigned*)(KR + (size_t)t * 64 + 2 * c.lane) = pk2(x * cs - xo * sn, xo * cs + x * sn); }
    }
}
__device__ __forceinline__ float xmax16(float v) { const auto r = __builtin_amdgcn_permlane16_swap(__float_as_uint(v), __float_as_uint(v), false, false); return fmaxf(__uint_as_float(r[0]), __uint_as_float(r[1])); }
__device__ __forceinline__ float xmax32(float v) { const auto r = __builtin_amdgcn_permlane32_swap(__float_as_uint(v), __float_as_uint(v), false, false); return fmaxf(__uint_as_float(r[0]), __uint_as_float(r[1])); }
__device__ __forceinline__ float xsum16(float v) { const auto r = __builtin_amdgcn_permlane16_swap(__float_as_uint(v), __float_as_uint(v), false, false); return __uint_as_float(r[0]) + __uint_as_float(r[1]); }
__device__ __forceinline__ float xsum32(float v) { const auto r = __builtin_amdgcn_permlane32_swap(__float_as_uint(v), __float_as_uint(v), false, false); return __uint_as_float(r[0]) + __uint_as_float(r[1]); }
__device__ __forceinline__ void attn_item(const Ctx& c, int item) {
    const int bh = item >> 4, qi = item & 15, b = bh >> 2, h = bh & 3;
    const GAS bf16_t* Q = WSG(bf16_t, O_Q); const GAS bf16_t* KN = WSG(bf16_t, O_KN); const GAS bf16_t* KR = WSG(bf16_t, O_KR); const GAS bf16_t* VT = WSG(bf16_t, O_VT); GAS bf16_t* YC = WSG(bf16_t, O_YC);
    const int lr = c.lane & 15, g = c.lane >> 4, sw = lr >> 1, swk = 2 * (lr >> 2) + ((lr >> 1) & 1), keyl = 8 * (lr >> 2) + (lr & 3);
    constexpr int KT_BYTES = 64 * 384, BUF_BYTES = KT_BYTES + 128 * 128;
    const char* kp[3]; int kstr[3]; const char* vp[2];
#pragma unroll
    for (int i = 0; i < 3; ++i) { const int ch = (3 * c.wave + i) * 64 + c.lane, key = ch / 24, pq = ch % 24, part = pq ^ (2 * ((key >> 3) & 3) + ((key >> 1) & 1)); const size_t tk = (size_t)(b * SEQ + key);
        if (part < 16) { kp[i] = (const char*)(KN + tk * 512 + h * 128 + part * 8); kstr[i] = 1024; } else { kp[i] = (const char*)(KR + tk * 64 + (part - 16) * 8); kstr[i] = 128; } }
#pragma unroll
    for (int i = 0; i < 2; ++i) { const int ch = (2 * c.wave + i) * 64 + c.lane, dv = ch >> 3, q8 = (ch & 7) ^ ((dv >> 1) & 7); vp[i] = (const char*)(VT + (size_t)(h * 128 + dv) * T + b * SEQ + q8 * 8); }
#define AT_DMA(kb_, buf_) do { LAS unsigned char* d_ = c.lds + (buf_) * BUF_BYTES; \
        _Pragma("unroll") for (int i_ = 0; i_ < 3; ++i_) __builtin_amdgcn_global_load_lds((const unsigned*)(kp[i_] + (size_t)(kb_) * kstr[i_]), (LAS unsigned*)(d_ + (3 * c.wave + i_) * 1024), 16, 0, 0); \
        _Pragma("unroll") for (int i_ = 0; i_ < 2; ++i_) __builtin_amdgcn_global_load_lds((const unsigned*)(vp[i_] + (size_t)(kb_) * 2), (LAS unsigned*)(d_ + KT_BYTES + (2 * c.wave + i_) * 1024), 16, 0, 0); } while (0)
    int koff[6], voff[2];
#pragma unroll
    for (int ks = 0; ks < 6; ++ks) koff[ks] = keyl * 384 + (((4 * ks + g) ^ swk) * 16);
#pragma unroll
    for (int pp = 0; pp < 2; ++pp) voff[pp] = lr * 128 + (((4 * pp + g) ^ sw) * 16);
#define AT_QK(dst_, buf_) do { const LAS unsigned char* Kt_ = c.lds + (buf_) * BUF_BYTES; \
        _Pragma("unroll") for (int a_ = 0; a_ < 4; ++a_) { dst_[a_] = (f32x4){0.f, 0.f, 0.f, 0.f}; \
            _Pragma("unroll") for (int ks_ = 0; ks_ < 6; ++ks_) dst_[a_] = __builtin_amdgcn_mfma_f32_16x16x32_bf16(*(const LAS bf16x8*)(Kt_ + ((a_ >> 1) * 32 + (a_ & 1) * 4) * 384 + koff[ks_]), qf[ks_], dst_[a_], 0, 0, 0); } } while (0)
#pragma unroll 1
    for (int half = 0; half < 2; ++half) {
        const int qb = half ? 31 - qi : qi; const int q0 = qb * 128 + c.wave * 16; const int tq = b * SEQ + q0 + lr;
        bf16x8 qf[6];
#pragma unroll
        for (int ks = 0; ks < 6; ++ks) qf[ks] = *(const GAS bf16x8*)(Q + (size_t)tq * 768 + h * 192 + 32 * ks + 8 * g);
        f32x4 o[8];
#pragma unroll
        for (int d = 0; d < 8; ++d) o[d] = (f32x4){0.f, 0.f, 0.f, 0.f};
        float mrow = -3.0e38f, lsum = 0.f;
        const int nkt = 2 * qb + 2;
        asm volatile("s_waitcnt vmcnt(0)" ::: "memory");
        LDS_BARRIER();
        AT_DMA(0, 0); AT_DMA(64, 1);
        asm volatile("s_waitcnt vmcnt(0)" ::: "memory"); LDS_BARRIER();
        f32x4 s[4], sn[4];
        AT_QK(s, 0);
#pragma unroll 1
        for (int kt = 0; kt < nkt; ++kt) {
            const int kbase = kt * 64; const int b0 = kt % 3, b1 = (kt + 1) % 3, b2 = (kt + 2) % 3;
            if (kt + 2 < nkt) AT_DMA(kbase + 128, b2);
            const bool act = kbase <= q0 + 15, actn = (kt + 1 < nkt) && (kbase + 64 <= q0 + 15);
            if (actn) AT_QK(sn, b1);
            if (act) {
                const LAS unsigned char* Vt = c.lds + b0 * BUF_BYTES + KT_BYTES;
                const int qpos = q0 + lr; float mx = -3.0e38f;
                if (kbase + 63 > q0) {
#pragma unroll
                    for (int a = 0; a < 4; ++a)
#pragma unroll
                        for (int r = 0; r < 4; ++r) { const int key = kbase + 32 * (a >> 1) + 8 * g + 4 * (a & 1) + r; if (key > qpos) s[a][r] = -3.0e38f; } }
#pragma unroll
                for (int a = 0; a < 4; ++a)
#pragma unroll
                    for (int r = 0; r < 4; ++r) mx = fmaxf(mx, s[a][r]);
                mx = xmax32(xmax16(mx));
                if (!__all(mx - mrow <= 8.f)) {
                    const float mnew = fmaxf(mrow, mx), alpha = __builtin_amdgcn_exp2f(mrow - mnew); mrow = mnew; lsum *= alpha;
#pragma unroll
                    for (int d = 0; d < 8; ++d) o[d] = o[d] * alpha; }
                float ps = 0.f;
#pragma unroll
                for (int a = 0; a < 4; ++a)
#pragma unroll
                    for (int r = 0; r < 4; ++r) { const float p = __builtin_amdgcn_exp2f(s[a][r] - mrow); s[a][r] = p; ps += p; }
                lsum += ps;
#pragma unroll
                for (int pp = 0; pp < 2; ++pp) { u32x4 pw; pw.x = pk2(s[2 * pp][0], s[2 * pp][1]); pw.y = pk2(s[2 * pp][2], s[2 * pp][3]); pw.z = pk2(s[2 * pp + 1][0], s[2 * pp + 1][1]); pw.w = pk2(s[2 * pp + 1][2], s[2 * pp + 1][3]);
                    const bf16x8 pf = __builtin_bit_cast(bf16x8, pw);
#pragma unroll
                    for (int d = 0; d < 8; ++d) o[d] = __builtin_amdgcn_mfma_f32_16x16x32_bf16(*(const LAS bf16x8*)(Vt + d * 2048 + voff[pp]), pf, o[d], 0, 0, 0); }
            }
            asm volatile("s_waitcnt vmcnt(0)" ::: "memory");
            LDS_BARRIER();
#pragma unroll
            for (int a = 0; a < 4; ++a) s[a] = sn[a];
        }
        lsum = xsum32(xsum16(lsum));
        const float inv = 1.f / lsum;
#pragma unroll
        for (int d = 0; d < 8; ++d) { u32x2 w; w.x = pk2(o[d][0] * inv, o[d][1] * inv); w.y = pk2(o[d][2] * inv, o[d][3] * inv);
            *(GAS u32x2*)(YC + (size_t)tq * 512 + h * 128 + 16 * d + 4 * g) = w; }
    }
#undef AT_DMA
#undef AT_QK
}
struct FProj { bf16_t* P; float* sf;
    __device__ __forceinline__ void oct(const pg8::Unit&, int row, int col, f32x4 v0, f32x4 v1) const {
        *(u32x4*)(P + (size_t)row * NP + col) = pk8(v0, v1);
        if (col >= C_SMALL && col < C_SMALL + 16) { float* d = sf + (size_t)row * 16 + (col - C_SMALL); *(f32x4*)d = v0; *(f32x4*)(d + 4) = v1; } } };
struct FQ { bf16_t* Q; const float* rq; const float* rope;
    __device__ __forceinline__ void oct(const pg8::Unit&, int row, int col, f32x4 v0, f32x4 v1) const {
        const float r = rq[row] * (0.07216878364870322f * 1.4426950408889634f); v0 = v0 * r; v1 = v1 * r;
        const int j = col % 192;
        if (j >= 128) { const float* cs = rope + ((size_t)row * 32 + ((j - 128) >> 1)) * 2; const f32x4 c0 = *(const f32x4*)cs, c1 = *(const f32x4*)(cs + 4);
            const f32x4 a = v0, bq = v1;
            v0[0] = a[0] * c0[0] - a[1] * c0[1]; v0[1] = a[1] * c0[0] + a[0] * c0[1]; v0[2] = a[2] * c0[2] - a[3] * c0[3]; v0[3] = a[3] * c0[2] + a[2] * c0[3];
            v1[0] = bq[0] * c1[0] - bq[1] * c1[1]; v1[1] = bq[1] * c1[0] + bq[0] * c1[1]; v1[2] = bq[2] * c1[2] - bq[3] * c1[3]; v1[3] = bq[3] * c1[2] + bq[2] * c1[3]; }
        *(u32x4*)(Q + (size_t)row * 768 + col) = pk8(v0, v1); } };
struct FKN { bf16_t* KN; const float* rkv;
    __device__ __forceinline__ void oct(const pg8::Unit&, int row, int col, f32x4 v0, f32x4 v1) const { const float r = rkv[row]; *(u32x4*)(KN + (size_t)row * 512 + col) = pk8(v0 * r, v1 * r); } };
struct FVT { bf16_t* VT; const float* rkv;
    __device__ __forceinline__ void oct(const pg8::Unit&, int row, int col, f32x4 v0, f32x4 v1) const { const f32x4 r0 = *(const f32x4*)(rkv + col), r1 = *(const f32x4*)(rkv + col + 4); *(u32x4*)(VT + (size_t)row * T + col) = pk8(v0 * r0, v1 * r1); } };
struct FMergeAll { const bf16_t* P; bf16_t* MB;
    __device__ __forceinline__ void oct(const pg8::Unit& u, int row, int col, f32x4 v0, f32x4 v1) const {
        f32x4 g0, g1; unpk8(*(const u32x4*)(P + (size_t)row * NP + C_GATE + u.kb * 1024 + col), g0, g1);
#pragma unroll
        for (int i = 0; i < 4; ++i) { v0[i] *= sigmoidf_(g0[i]); v1[i] *= sigmoidf_(g1[i]); }
        bf16_t* m = MB + (size_t)row * D + col;
        if (u.kb > 0) { f32x4 p0, p1; unpk8(*(const u32x4*)m, p0, p1); v0 = v0 + p0; v1 = v1 + p1; }
        *(u32x4*)m = pk8(v0, v1); } };
struct FRes { float* X; const float* Xs; const float* gate;
    __device__ __forceinline__ void oct(const pg8::Unit&, int row, int col, f32x4 v0, f32x4 v1) const {
        const float* g = gate + (size_t)(row >> 12) * 6144 + col; float* x = X + (size_t)row * D + col; const float* xs = Xs + (size_t)row * D + col;
        *(f32x4*)x = *(const f32x4*)xs + *(const f32x4*)g * v0; *(f32x4*)(x + 4) = *(const f32x4*)(xs + 4) + *(const f32x4*)(g + 4) * v1; } };
struct FGU { bf16_t* Hd; int ld;
    __device__ __forceinline__ void gu(const pg8::Unit&, int row, int fcol, f32x4 g0, f32x4 g1, f32x4 u0, f32x4 u1) const {
#pragma unroll
        for (int i = 0; i < 4; ++i) { g0[i] = siluf_(g0[i]) * u0[i]; g1[i] = siluf_(g1[i]) * u1[i]; }
        *(u32x4*)(Hd + (size_t)row * ld + fcol) = pk8(g0, g1); } };
struct FYT { float* YT; int row0;
    __device__ __forceinline__ void oct(const pg8::Unit& u, int row, int col, f32x4 v0, f32x4 v1) const { float* d = YT + (size_t)u.kb * (8 * 256 * 1024) + (size_t)(row - row0) * D + col;
        *(f32x4*)d = v0; *(f32x4*)(d + 4) = v1; } };
struct FY { bf16_t* Y;
    __device__ __forceinline__ void oct(const pg8::Unit&, int row, int col, f32x4 v0, f32x4 v1) const { *(u32x4*)(Y + (size_t)row * D + col) = pk8(v0, v1); } };

template <int SITE, class F, class Sched> __device__ __forceinline__ void run_gemm_oct(const Ctx& c, const pg8::Gemm& g, const Sched& S, const F& f) {
    if constexpr ((FASTMASK >> SITE) & 1u) { pg8::EpiOct<F> E{f}; pg8::gemm_phase<pg8::EpiOct<F>, Sched, true>(c.lds, g, S, E); }
    else pg8::gemm_simple_oct(g, S, f);
}
template <int SITE, class F, class Sched> __device__ __forceinline__ void run_gemm_gu(const Ctx& c, const pg8::Gemm& g, const Sched& S, const F& f) {
    if constexpr ((FASTMASK >> SITE) & 1u) { pg8::EpiGU<F> E{f}; pg8::gemm_phase<pg8::EpiGU<F>, Sched, true>(c.lds, g, S, E); }
    else pg8::gemm_simple_gu(g, S, f);
}

#ifndef PHMASK
#define PHMASK 0xFFFFFFFFu
#endif
#define ON(k) (((PHMASK) >> (k)) & 1u)
#ifndef REPMASK
#define REPMASK 0u
#endif
#define NREP(k) ((((REPMASK) >> (k)) & 1u) ? 2 : 1)
template <class P> __device__ __forceinline__ P* launder_ptr(P* p) {
    unsigned long long v = (unsigned long long)p; unsigned lo = (unsigned)v, hi = (unsigned)(v >> 32);
    asm volatile("" : "+v"(lo), "+v"(hi));
    lo = __builtin_amdgcn_readfirstlane(lo); hi = __builtin_amdgcn_readfirstlane(hi);
    return (P*)(((unsigned long long)hi << 32) | lo);
}
__device__ __forceinline__ LAS unsigned char* launder_lds(LAS unsigned char* p) { unsigned v = (unsigned)(uintptr_t)p; asm volatile("" : "+v"(v)); v = __builtin_amdgcn_readfirstlane(v); return (LAS unsigned char*)(uintptr_t)v; }
typedef const float* const __attribute__((address_space(4)))* kargp_t;
__device__ __forceinline__ kargp_t launder_kptr(kargp_t p) { unsigned long long v = (unsigned long long)p; unsigned lo = (unsigned)v, hi = (unsigned)(v >> 32);
    asm volatile("" : "+v"(lo), "+v"(hi)); lo = __builtin_amdgcn_readfirstlane(lo); hi = __builtin_amdgcn_readfirstlane(hi); return (kargp_t)(((unsigned long long)hi << 32) | lo); }
struct Args { const float* in[33]; float* out; unsigned char* ws; int ph_lo, ph_hi; };
constexpr int N_PHASES = 1 + NL * 10 + 2 + 1;

#define PHASE_BEGIN if (pc >= lo && pc < hi) { { int t_ = threadIdx.x; asm volatile("" : "+v"(t_) :: "memory"); c.tid = t_; c.lane = t_ & 63; c.wave = __builtin_amdgcn_readfirstlane(t_ >> 6); { unsigned g_ = gridDim.x, w_ = blockIdx.x; asm volatile("" : "+v"(g_), "+v"(w_)); c.G = __builtin_amdgcn_readfirstlane(g_); c.wg = __builtin_amdgcn_readfirstlane(w_); } c.gw = c.wg * NWAVES + c.wave; c.NGW = c.G * NWAVES; c.lds = launder_lds(c.lds); c.ws = launder_ptr(c.ws); c.in = launder_kptr(c.in); c.X = launder_ptr(c.X); }
#ifdef PROBE_BAR2
#define PHASE_END   if (pc + 1 < hi) { XcdBarrier b2_ = bar; b2_.bar = launder_ptr(bar.bar); xcd_barrier(b2_); xcd_barrier(b2_); } } ++pc;
#else
#define PHASE_END   if (pc + 1 < hi) { XcdBarrier b2_ = bar; b2_.bar = launder_ptr(bar.bar); xcd_barrier(b2_); } } ++pc;
#endif
template <int L> __device__ __forceinline__ void layer_body(Ctx& c, const int lo, const int hi, int& pc, const XcdBarrier& bar) {
        constexpr int l = L; constexpr bool moe = (L & 1) != 0; constexpr int fi = L >> 1;
        const float* MODL = WSP(float, O_MOD) + (size_t)l * 4 * 6144;
        PHASE_BEGIN if constexpr (ON(1)) { if (NREP(16) > 1) norm_phase(c, l, 0, -1, l == 0 ? c.in[0] : nullptr); norm_phase(c, l, 0, (l > 0 && ((l - 1) & 1)) ? l - 1 : -1, l == 0 ? c.in[0] : nullptr); } PHASE_END
        PHASE_BEGIN if constexpr (ON(2)) { pg8::Gemm g{WSP(bf16_t, O_H), WSP(bf16_t, O_WIN) + (size_t)l * NP * 1024, 1024, 1024, 1024}; pg8::StaticOrder S; S.init(T / 256, NP / 256, c.G, c.wg);
            for (int rep_ = 0; rep_ < NREP(27); ++rep_) run_gemm_oct<0>(c, g, S, FProj{WSP(bf16_t, O_PROJ), WSP(float, O_SMALLF)}); } PHASE_END
        PHASE_BEGIN
#ifdef GDNPREP_STOP
            for (int u = c.wg; u < NB * NCH * 4; u += c.G) gdn_prep_unit(c, l, u, GDNPREP_STOP);
#endif
            for (int rep_ = 0; rep_ < NREP(24); ++rep_) for (int u = c.wg; u < NB * NCH * 4; u += c.G) gdn_prep_unit(c, l, u);
            for (int rep_ = 0; rep_ < NREP(25); ++rep_) for (int u = c.wg; u < NB * NCH * 2; u += c.G) ssd_prep_unit(c, l, u);
            if constexpr (ON(3)) mla_rows_phase(c);
        PHASE_END
        PHASE_BEGIN
            if (c.wg < 128) {
                if (c.wave == 0) { for (int rep_ = 0; rep_ < NREP(20); ++rep_) gdn_scan_wave(c, (c.wg & 7) * 2 + (c.wg >> 6), (c.wg >> 3) & 7); }
                else { ssd_scan_phase(c);
                    { LAS float* scr = (LAS float*)(c.lds + 73728 + (c.wave - 1) * 8448); const int rank = c.wg * 7 + (c.wave - 1), count = 896 + (c.G - 128) * 8;
                      for (int r2_ = 0; r2_ < NREP(15); ++r2_) { if (moe) moe_convert_queue(c, l, scr); next_layer_convert_queue(c, l, scr); } } }
            } else {
                const int G2 = c.G - 128, w2 = c.wg - 128;
                for (int rep_ = 0; rep_ < NREP(18); ++rep_) {
                { pg8::Gemm g{WSP(bf16_t, O_PROJ) + C_CQ, WSP(bf16_t, O_WUQ) + (size_t)l * 768 * 512, 512, NP, 512}; pg8::StaticOrder S; S.init(T / 256, 3, G2, w2);
                  run_gemm_oct<1>(c, g, S, FQ{WSP(bf16_t, O_Q), WSP(float, O_RQ), WSP(float, O_ROPE)}); }
                { pg8::Gemm g{WSP(bf16_t, O_PROJ) + C_CKV, WSP(bf16_t, O_WUK) + (size_t)l * 512 * 256, 256, NP, 256}; pg8::StaticOrder S; S.init(T / 256, 2, G2, w2);
                  run_gemm_oct<2>(c, g, S, FKN{WSP(bf16_t, O_KN), WSP(float, O_RKV)}); }
                { pg8::Gemm g{WSP(bf16_t, O_WUV) + (size_t)l * 512 * 256, WSP(bf16_t, O_PROJ) + C_CKV, 256, 256, NP}; pg8::StaticOrder S; S.init(2, T / 256, G2, w2);
                  run_gemm_oct<3>(c, g, S, FVT{WSP(bf16_t, O_VT), WSP(float, O_RKV)}); } }
                { LAS float* scr = (LAS float*)(c.lds + c.wave * 8448); const int rank = 896 + w2 * 8 + c.wave, count = 896 + G2 * 8;
                  for (int r2_ = 0; r2_ < NREP(15); ++r2_) { if (moe) moe_convert_queue(c, l, scr); next_layer_convert_queue(c, l, scr); } }
            }
        PHASE_END
        PHASE_BEGIN
            for (int rep_ = 0; rep_ < NREP(21); ++rep_) for (int it = c.wg; it < 256; it += c.G) attn_item(c, (it & 7) * 32 + (it >> 3));
            for (int rep_ = 0; rep_ < NREP(22); ++rep_) gdn_out_phase(c, l);
            for (int rep_ = 0; rep_ < NREP(23); ++rep_) for (int u = c.wg; u < NB * NCH * 2; u += c.G) ssd_finish_unit(c, l, u);
        PHASE_END
        PHASE_BEGIN for (int rep_ = 0; rep_ < NREP(19); ++rep_) { pg8::BranchOrder S; S.base.init(T / 256, 4, c.G, c.wg); S.nbr = 3; S.astride = (long)(O_YB - O_YA) / 2; S.bstride = (long)1024 * 512;
            pg8::Gemm g{WSP(bf16_t, O_YA), WSP(bf16_t, O_WBR) + (size_t)l * 3 * 1024 * 512, 512, 512, 512};
            run_gemm_oct<4>(c, g, S, FMergeAll{WSP(bf16_t, O_PROJ), WSP(bf16_t, O_MB)}); } PHASE_END
        PHASE_BEGIN if constexpr (ON(7)) { pg8::Gemm g{WSP(bf16_t, O_MB), WSP(bf16_t, O_WOUT) + (size_t)l * 1024 * 1024, 1024, 1024, 1024}; pg8::StaticOrder S; S.init(T / 256, 4, c.G, c.wg);
            if (NREP(17) > 1) run_gemm_oct<7>(c, g, S, FRes{WSP(float, O_MF), l == 0 ? c.in[0] : c.X, MODL + 2048}); run_gemm_oct<7>(c, g, S, FRes{c.X, l == 0 ? c.in[0] : c.X, MODL + 2048}); } PHASE_END
        PHASE_BEGIN if constexpr (ON(8)) { for (int rep_ = 0; rep_ < NREP(16); ++rep_) { if (moe) norm2_moe_phase(c, l); else norm_phase(c, l, 1, -1); } } PHASE_END
        if (moe) { PHASE_BEGIN for (int rep_ = 0; rep_ < NREP(28); ++rep_) moe_assign_phase(c, l); PHASE_END }
        PHASE_BEGIN if constexpr (ON(10)) {
            if (!moe) { pg8::Gemm g{WSP(bf16_t, O_H), WSP(bf16_t, O_WGU) + (size_t)fi * 2 * FF * 1024, 1024, 1024, 1024}; pg8::StaticOrder S; S.init(T / 256, 2 * FF / 256, c.G, c.wg);
                for (int rep_ = 0; rep_ < NREP(29); ++rep_) run_gemm_gu<8>(c, g, S, FGU{WSP(bf16_t, O_PROJ), FF}); }
            else { pg8::Gemm g{WSP(bf16_t, O_XS), WSP(bf16_t, O_WEGU), 1024, 1024, 1024}; pg8::MoeOrder S{WSP(int, O_BLKE), *WSP(int, O_NBLK), 2 * EF / 256, c.G, c.wg, (long)2 * EF * 1024};
                for (int rep_ = 0; rep_ < NREP(30); ++rep_) run_gemm_gu<10>(c, g, S, FGU{WSP(bf16_t, O_PROJ), EF}); }
        } PHASE_END
        PHASE_BEGIN if constexpr (ON(11)) {
            if (!moe) { pg8::Gemm g{WSP(bf16_t, O_PROJ), WSP(bf16_t, O_WDN) + (size_t)fi * 1024 * FF, FF, FF, FF}; pg8::StaticOrder S; S.init(T / 256, 4, c.G, c.wg);
                if (NREP(17) > 1) run_gemm_oct<9>(c, g, S, FRes{WSP(float, O_MF), c.X, MODL + 5120}); run_gemm_oct<9>(c, g, S, FRes{c.X, c.X, MODL + 5120}); }
            else { const int nblk = *WSP(int, O_NBLK), nmainb = WSP(int, O_NBLK)[1];
                { pg8::Gemm g{WSP(bf16_t, O_PROJ), WSP(bf16_t, O_WEDN), EF, EF, EF}; pg8::MoeOrder S{WSP(int, O_BLKE), nmainb, 4, c.G, c.wg, (long)1024 * EF};
                  for (int rep_ = 0; rep_ < NREP(31); ++rep_) run_gemm_oct<11>(c, g, S, FY{WSP(bf16_t, O_YS)}); }
                { pg8::Gemm g{WSP(bf16_t, O_PROJ), WSP(bf16_t, O_WEDN), 512, EF, EF}; pg8::MoeTailOrder S{WSP(int, O_BLKE), nmainb, nblk - nmainb, 7, 512, c.G, c.wg, (long)1024 * EF};
                  run_gemm_oct<12>(c, g, S, FYT{WSP(float, O_MF), nmainb * 256}); } }
        } PHASE_END
    }

__global__ void __launch_bounds__(NTHR, 2) mk_fwd(Args args) {
    extern __shared__ __attribute__((aligned(16))) unsigned char lds_raw[];
    Ctx c;
    c.lds = (LAS unsigned char*)lds_raw;
    c.tid = threadIdx.x; c.lane = c.tid & 63; c.wave = __builtin_amdgcn_readfirstlane(c.tid >> 6);
    c.G = gridDim.x; c.wg = blockIdx.x; c.gw = c.wg * NWAVES + c.wave; c.NGW = c.G * NWAVES;
    c.in = (const float* const __attribute__((address_space(4)))*)__builtin_amdgcn_kernarg_segment_ptr(); c.X = args.out; c.ws = args.ws;
    volatile LAS unsigned* MISC = (volatile LAS unsigned*)(c.lds + LDSCTL_OFF);
    for (int u = c.tid; u < 128; u += NTHR) MISC[u] = 0u;
    __syncthreads();
    const int lo = args.ph_lo, hi = args.ph_hi;
    XcdBarrier bar; bar.bar = (unsigned*)(c.ws + O_CTL) + 1024 + (size_t)(lo & 63) * XCD_BAR_WORDS; bar.x = 0; bar.st = MISC + 8;
    if (hi - lo > 1) bar = xcd_barrier_post(bar.bar, MISC + 8);
    int pc = 0;

    PHASE_BEGIN for (int rep_ = 0; rep_ < NREP(26); ++rep_) p0_prologue(c); PHASE_END

    layer_body<0>(c, lo, hi, pc, bar); layer_body<1>(c, lo, hi, pc, bar); layer_body<2>(c, lo, hi, pc, bar); layer_body<3>(c, lo, hi, pc, bar);
    PHASE_BEGIN if constexpr (ON(12)) final_phase(c, NL - 1); PHASE_END
#undef PHASE_BEGIN
#undef PHASE_END
}

extern "C" void kernel_launch(void* const* d_in, const int* in_sizes, int n_in, void* d_out, int out_size, void* d_ws, size_t ws_size, hipStream_t stream) {
    static int grid = 0;
    if (grid == 0) {
        if (n_in != 33 || out_size != T * D || ws_size < WS_END) { fprintf(stderr, "kernel_launch: unexpected shapes (n_in %d out %d ws %zu need %zu)\n", n_in, out_size, ws_size, (size_t)WS_END); grid = -1; return; }
        int dev = 0, cus = 0, per_cu = 0;
        if (hipGetDevice(&dev) != hipSuccess || hipDeviceGetAttribute(&cus, hipDeviceAttributeMultiprocessorCount, dev) != hipSuccess) { grid = -1; return; }
        if (hipFuncSetAttribute((const void*)mk_fwd, hipFuncAttributeMaxDynamicSharedMemorySize, LDS_BYTES) != hipSuccess) { fprintf(stderr, "kernel_launch: hipFuncSetAttribute failed\n"); grid = -1; return; }
        if (hipOccupancyMaxActiveBlocksPerMultiprocessor(&per_cu, (const void*)mk_fwd, NTHR, LDS_BYTES) != hipSuccess || per_cu < 1) fprintf(stderr, "kernel_launch: occupancy query reports %d\n", per_cu);
        (void)hipGetLastError();
        grid = cus < 256 ? cus : 256;
        while (T % grid) --grid;
    }
    if (grid < 0) return;
    (void)hipMemsetAsync((char*)d_ws + O_CTL, 0, CTL_BYTES, stream);
    Args a{};
    for (int i = 0; i < 33; ++i) a.in[i] = (const float*)d_in[i];
    a.out = (float*)d_out; a.ws = (unsigned char*)d_ws;
#if N_LAUNCH_MODE == 1
    a.ph_lo = 0; a.ph_hi = N_PHASES;
    hipLaunchKernelGGL(mk_fwd, dim3(grid), dim3(NTHR), LDS_BYTES, stream, a);
#else
    for (int p = 0; p < N_PHASES; ++p) { a.ph_lo = p; a.ph_hi = p + 1; hipLaunchKernelGGL(mk_fwd, dim3(grid), dim3(NTHR), LDS_BYTES, stream, a); }
#endif
}
```

```cpp
#include <hip/hip_runtime.h>
#include <cstdio>
#include <cstdint>

#define GAS __attribute__((address_space(1)))
#define LAS __attribute__((address_space(3)))
typedef unsigned short bf16_t;
typedef short bf16x8 __attribute__((ext_vector_type(8)));
typedef short bf16x4 __attribute__((ext_vector_type(4)));
typedef float f32x4 __attribute__((ext_vector_type(4)));
typedef float f32x2 __attribute__((ext_vector_type(2)));
typedef unsigned u32x4 __attribute__((ext_vector_type(4)));
typedef unsigned u32x2 __attribute__((ext_vector_type(2)));

#ifndef FASTMASK
#define FASTMASK 0xFFFFFFFFu
#endif
#ifndef N_LAUNCH_MODE
#define N_LAUNCH_MODE 1
#endif

constexpr int T = 16384, D = 1024, NB = 4, SEQ = 4096, NL = 4, NCH = 64, CH = 64;
constexpr int NP = 7680;
constexpr int C_QKV = 0, C_GZ = 1536, C_SZ = 2048, C_XBC = 2560, C_CQ = 3584, C_CKV = 4096, C_KR = 4352, C_SMALL = 4416, C_GATE = 4608;
constexpr int FF = 2816, EF = 3584, NE = 8, NSLOT = 34560  ;
constexpr float EPS = 1e-6f;
constexpr int NWAVES = 8, NTHR = 512;

constexpr size_t MiB = 1u << 20;
constexpr size_t O_CTL = 0, CTL_BYTES = 1 * MiB;
constexpr size_t O_MOD = 1 * MiB;
constexpr size_t O_ROPE = 2 * MiB;
constexpr size_t O_RQ = 6 * MiB, O_RKV = O_RQ + 65536;
constexpr size_t O_SMALLF = 7 * MiB;
constexpr size_t O_TOPE = 8 * MiB, O_TOPW = O_TOPE + 65536, O_WGCNT = O_TOPW + 131072, O_TOKSLOT = O_WGCNT + 8192, O_BLKE = O_TOKSLOT + 131072, O_NBLK = O_BLKE + 1024;
constexpr size_t O_GL = 9 * MiB, O_DEC = O_GL + 4096, O_EA = O_DEC + 8192;
constexpr size_t O_WIN = 10 * MiB, O_WUQ = 70 * MiB, O_WUK = 73 * MiB, O_WUV = 74 * MiB, O_WBR = 75 * MiB, O_WOUT = 87 * MiB, O_WGU = 95 * MiB, O_WDN = 117 * MiB,
                 O_WEGU = 128 * MiB, O_WEDN = 240 * MiB;
constexpr size_t O_H = 296 * MiB;
constexpr size_t O_PROJ = 328 * MiB;
constexpr size_t O_KR = 568 * MiB, O_Q = 570 * MiB, O_KN = 594 * MiB, O_VT = 610 * MiB;
constexpr size_t O_YA = 626 * MiB, O_YB = 642 * MiB, O_YC = 658 * MiB;
constexpr size_t O_GU = 674 * MiB, O_GW = 706 * MiB, O_GQD = 722 * MiB, O_GKD = 738 * MiB, O_GQK = 754 * MiB, O_GO = 762 * MiB;
constexpr size_t O_YS = O_GU;
constexpr size_t O_SYP = 794 * MiB, O_SST = 826 * MiB, O_SCC = 890 * MiB;
constexpr size_t O_XS = O_SYP;
constexpr size_t O_MF = 898 * MiB, O_MB = 962 * MiB, WS_END = 994 * MiB;
static_assert((size_t)NSLOT * EF * 2 <= 240 * MiB && (size_t)NSLOT * 1024 * 2 <= 96 * MiB, "overlays");

constexpr int SCR_BYTES = 159744;
constexpr int LDSCTL_OFF = SCR_BYTES, LDS_BYTES = SCR_BYTES + 512;

#define LDS_WAIT() asm volatile("s_waitcnt lgkmcnt(0)" ::: "memory")
#define VM_WAIT() asm volatile("s_waitcnt vmcnt(0)" ::: "memory")
#define LDS_BARRIER() do { asm volatile("s_waitcnt lgkmcnt(0)" ::: "memory"); __builtin_amdgcn_s_barrier(); asm volatile("" ::: "memory"); } while (0)

__device__ __forceinline__ float bf2f(unsigned b) { return __uint_as_float(b << 16); }
__device__ __forceinline__ unsigned f2bf(float f) { unsigned r; asm("v_cvt_pk_bf16_f32 %0, %1, %1" : "=v"(r) : "v"(f)); return r & 0xffffu; }
__device__ __forceinline__ unsigned pk2(float lo, float hi) { unsigned r; asm("v_cvt_pk_bf16_f32 %0, %1, %2" : "=v"(r) : "v"(lo), "v"(hi)); return r; }
__device__ __forceinline__ float lo16(unsigned w) { return __uint_as_float(w << 16); }
__device__ __forceinline__ float hi16(unsigned w) { return __uint_as_float(w & 0xffff0000u); }
__device__ __forceinline__ u32x4 pk8(f32x4 a, f32x4 b) { u32x4 w; w.x = pk2(a[0], a[1]); w.y = pk2(a[2], a[3]); w.z = pk2(b[0], b[1]); w.w = pk2(b[2], b[3]); return w; }
__device__ __forceinline__ void unpk8(u32x4 w, f32x4& a, f32x4& b) { a = (f32x4){lo16(w.x), hi16(w.x), lo16(w.y), hi16(w.y)}; b = (f32x4){lo16(w.z), hi16(w.z), lo16(w.w), hi16(w.w)}; }
__device__ __forceinline__ float sigmoidf_(float x) { return __builtin_amdgcn_rcpf(1.f + __builtin_amdgcn_exp2f(x * -1.4426950408889634f)); }
__device__ __forceinline__ float siluf_(float x) { return x * __builtin_amdgcn_rcpf(1.f + __builtin_amdgcn_exp2f(x * -1.4426950408889634f)); }
__device__ __forceinline__ float softplusf_(float x) { return x > 20.f ? x : log1pf(expf(x)); }
#define DPP_ADD(v_, ctrl_) ((v_) + __builtin_bit_cast(float, __builtin_amdgcn_update_dpp(0, __builtin_bit_cast(int, (v_)), (ctrl_), 0xF, 0xF, true)))
__device__ __forceinline__ float row16_sum(float v) {
    v = DPP_ADD(v, 0xB1); v = DPP_ADD(v, 0x4E); v = DPP_ADD(v, 0x141); v = DPP_ADD(v, 0x140); return v;
}
__device__ __forceinline__ float wave_sum(float v) {
    v = row16_sum(v);
    { const auto r = __builtin_amdgcn_permlane16_swap(__float_as_uint(v), __float_as_uint(v), false, false); v = __uint_as_float(r[0]) + __uint_as_float(r[1]); }
    { const auto r = __builtin_amdgcn_permlane32_swap(__float_as_uint(v), __float_as_uint(v), false, false); v = __uint_as_float(r[0]) + __uint_as_float(r[1]); }
    return v;
}
namespace pg8 {
constexpr int BM = 256, BK = 64, HALF = 128, HTB = HALF * BK * 2, STAGE_BYTES = 8 * HTB, NXCD = 8, WGM = 8;
__host__ __device__ __forceinline__ int lds_byte(int r, int c) { const int st = (r >> 4) * 2 + (c >> 5), rr = r & 15, cc = c & 31, ob = rr * 64 + cc * 2; return st * 1024 + (ob ^ (((ob >> 9) & 1) << 5)); }
__host__ __device__ __forceinline__ void stage_rc(int b, int& R, int& C) { const int st = b / 1024, sb = b % 1024, swz = sb ^ (((sb >> 9) & 1) << 5); R = (st >> 1) * 16 + swz / 64; C = (st & 1) * 32 + (swz % 64) / 2; }
__host__ __device__ __forceinline__ int perm32(int rho) { const int n = rho >> 4, i = rho & 15; return 8 * (i >> 2) + 4 * n + (i & 3); }

struct Unit { int pm, pn; long boff, aoff; int kb; };
struct Gemm { const bf16_t* A; const bf16_t* Bt; int K, lda, ldb; };

struct StaticOrder {
    int nM, nN, nwg, G, c;
    __device__ void init(int nM_, int nN_, int G_, int c_) { nM = nM_; nN = nN_; nwg = nM * nN; G = G_; c = c_; }
    __device__ bool next(int i, Unit& u) const {
        const long L = (long)i * G + c; if (L >= nwg) return false;
        int wgid = (int)L; { const int q = nwg / NXCD, r = nwg % NXCD, xcd = wgid % NXCD, off = wgid / NXCD; wgid = (xcd < r ? xcd * (q + 1) : r * (q + 1) + (xcd - r) * q) + off; }
        const int nig = WGM * nN, gid = wgid / nig, fm = gid * WGM, gsz = (nM - fm) < WGM ? (nM - fm) : WGM;
        u.pm = fm + ((wgid % nig) % gsz); u.pn = (wgid % nig) / gsz; u.boff = 0; u.aoff = 0; u.kb = 0; return true;
    }
};
struct MoeOrder {
    const int* blke; int nblk, nN, G, c; long estride;
    __device__ bool next(int i, Unit& u) const {
        const long L = (long)i * G + c; if (L >= (long)nblk * nN) return false;
        const int j = (int)(L / nN); u.pm = j; u.pn = (int)(L % nN); u.boff = (long)blke[j] * estride; u.aoff = 0; u.kb = 0; return true;
    }
};

struct MoeTailOrder {
    const int* blke; int j0, ntail, nks, kslice, G, c; long estride;
    __device__ bool next(int i, Unit& u) const {
        const int L = i * G + c; if (L >= ntail * 4 * nks) return false;
        const int ks = L % nks, t = L / nks; u.pm = j0 + (t >> 2); u.pn = t & 3; u.kb = ks; u.aoff = (long)ks * kslice; u.boff = (long)blke[u.pm] * estride + (long)ks * kslice; return true;
    }
};
struct BranchOrder {
    StaticOrder base; int nbr; long astride, bstride;
    __device__ bool next(int i, Unit& u) const { const int rd = i / nbr, br = i - rd * nbr; if (!base.next(rd, u)) return false; u.kb = br; u.aoff = (long)br * astride; u.boff = (long)br * bstride; return true; }
};

template <class Epi, class Sched, bool ALIGN_EPI>
__device__ __forceinline__ void gemm_phase(LAS unsigned char* lds, const Gemm g, const Sched& S, const Epi& E) {
    int tid_ = threadIdx.x; asm volatile("" : "+v"(tid_) :: "memory");
    const int tid = tid_, wid = __builtin_amdgcn_readfirstlane(tid >> 6), lane = tid & 63, wr = wid >> 2, wc = wid & 3, fr = lane & 15, fq = lane >> 4;
    const int K = g.K, nt = K / BK;
    unsigned voffA[2], voffB[2];
#pragma unroll
    for (int i = 0; i < 2; ++i) { int R, C; stage_rc(tid * 16 + i * 8192, R, C); const int Rb = Epi::PERM ? ((R & ~31) + perm32(R & 31)) : R;
        voffA[i] = (unsigned)(R * g.lda + C) * 2u; voffB[i] = (unsigned)(Rb * g.ldb + C) * 2u; }
    const size_t kstep = (size_t)(BK * 2);
    const size_t hstepA = (size_t)HALF * g.lda * 2, hstepB = (size_t)HALF * g.ldb * 2;
    const size_t tstepA = 2 * hstepA, tstepB = 2 * hstepB;
    const unsigned ldsw = (unsigned)wid * 1024u;
    const int aoff = lds_byte(wr * 64 + fr, fq * 8), boff = lds_byte(wc * 32 + fr, fq * 8);
#define PG8_SA(b, h) (((b) * 2 + (h)) * HTB)
#define PG8_SB(b, h) ((4 + (b) * 2 + (h)) * HTB)
#define PG8_STAGE(bufoff, gbase, voff) do { _Pragma("unroll") for (int _i = 0; _i < 2; ++_i) \
        __builtin_amdgcn_global_load_lds((const unsigned*)((const char*)(gbase) + (voff)[_i]), (LAS unsigned*)(lds + (bufoff) + ldsw + _i * 8192), 16, 0, 0); } while (0)
#define PG8_LDA(dst, b, h) do { _Pragma("unroll") for (int m = 0; m < 4; ++m) _Pragma("unroll") for (int k = 0; k < 2; ++k) dst[m][k] = *(const LAS bf16x8*)(lds + PG8_SA(b, h) + aoff + m * 2048 + k * 1024); } while (0)
#define PG8_LDB(dst, b, h) do { _Pragma("unroll") for (int n = 0; n < 2; ++n) _Pragma("unroll") for (int k = 0; k < 2; ++k) dst[n][k] = *(const LAS bf16x8*)(lds + PG8_SB(b, h) + boff + n * 2048 + k * 1024); } while (0)
#define PG8_MMA(ai, bj, At, Bt) do { __builtin_amdgcn_s_setprio(1); _Pragma("unroll") for (int m = 0; m < 4; ++m) _Pragma("unroll") for (int n = 0; n < 2; ++n) _Pragma("unroll") for (int k = 0; k < 2; ++k) \
        acc[ai][bj][m][n] = __builtin_amdgcn_mfma_f32_16x16x32_bf16(Bt[n][k], At[m][k], acc[ai][bj][m][n], 0, 0, 0); __builtin_amdgcn_s_setprio(0); } while (0)
#define PG8_WAIT_V(n) asm volatile("s_waitcnt vmcnt(" #n ")" ::: "memory")
#define PG8_WAIT_L(n) asm volatile("s_waitcnt lgkmcnt(" #n ")" ::: "memory")
#define PG8_BAR __builtin_amdgcn_s_barrier()
#define PG8_SCHED __builtin_amdgcn_sched_barrier(0)
    Unit cur, nxt; int ui = 0;
    if (!S.next(0, cur)) return;
    f32x4 acc[2][2][4][2];
#pragma unroll
    for (int a = 0; a < 2; ++a)
#pragma unroll
        for (int b = 0; b < 2; ++b)
#pragma unroll
            for (int m = 0; m < 4; ++m)
#pragma unroll
                for (int n = 0; n < 2; ++n) acc[a][b][m][n] = (f32x4){0.f, 0.f, 0.f, 0.f};
    bf16x8 At[4][2], B0[2][2], B1[2][2];
    const char* cA = (const char*)(g.A + cur.aoff) + (size_t)cur.pm * tstepA; const char* cB = (const char*)(g.Bt + cur.boff) + (size_t)cur.pn * tstepB;
    PG8_STAGE(PG8_SB(0, 0), cB, voffB); PG8_STAGE(PG8_SB(0, 1), cB + hstepB, voffB); PG8_STAGE(PG8_SA(0, 0), cA, voffA); PG8_STAGE(PG8_SA(0, 1), cA + hstepA, voffA);
    if (wr == 1) PG8_BAR;
    PG8_WAIT_V(2); PG8_BAR;
    PG8_STAGE(PG8_SB(1, 0), cB + kstep, voffB); PG8_STAGE(PG8_SA(1, 0), cA + kstep, voffA); PG8_STAGE(PG8_SB(1, 1), cB + hstepB + kstep, voffB);
    PG8_WAIT_V(6); PG8_BAR;
    for (;;) {
        const bool has_next = S.next(ui + 1, nxt);
        const char* nA = has_next ? (const char*)(g.A + nxt.aoff) + (size_t)nxt.pm * tstepA : cA; const char* nB = has_next ? (const char*)(g.Bt + nxt.boff) + (size_t)nxt.pn * tstepB : cB;
        for (int t = 0; t < nt; t += 2) {
            const bool last = (t == nt - 2);
            const char* a1 = cA + (size_t)(t + 1) * kstep;
            const char* a2 = last ? nA : cA + (size_t)(t + 2) * kstep; const char* b2 = last ? nB : cB + (size_t)(t + 2) * kstep;
            const char* a3 = a2 + kstep; const char* b3 = b2 + kstep;
            PG8_LDB(B0, 0, 0); PG8_LDB(B1, 0, 1); PG8_SCHED; PG8_LDA(At, 0, 0); PG8_STAGE(PG8_SA(1, 1), a1 + hstepA, voffA);
            PG8_WAIT_V(8); PG8_WAIT_L(0); PG8_BAR; PG8_MMA(0, 0, At, B0); PG8_MMA(0, 1, At, B1); PG8_BAR; PG8_SCHED;
            PG8_LDA(At, 0, 1); PG8_STAGE(PG8_SB(0, 0), b2, voffB); PG8_STAGE(PG8_SB(0, 1), b2 + hstepB, voffB); PG8_STAGE(PG8_SA(0, 0), a2, voffA);
            PG8_WAIT_V(8); PG8_WAIT_L(0); PG8_BAR; PG8_MMA(1, 0, At, B0); PG8_MMA(1, 1, At, B1); PG8_BAR; PG8_SCHED;
            PG8_LDB(B0, 1, 0); PG8_LDB(B1, 1, 1); PG8_SCHED; PG8_LDA(At, 1, 0); PG8_STAGE(PG8_SA(0, 1), a2 + hstepA, voffA);
            PG8_WAIT_V(8); PG8_WAIT_L(0); PG8_BAR; PG8_MMA(0, 0, At, B0); PG8_MMA(0, 1, At, B1); PG8_BAR; PG8_SCHED;
            PG8_LDA(At, 1, 1); PG8_STAGE(PG8_SB(1, 0), b3, voffB); PG8_STAGE(PG8_SB(1, 1), b3 + hstepB, voffB); PG8_STAGE(PG8_SA(1, 0), a3, voffA);
            PG8_WAIT_V(8); PG8_WAIT_L(0); PG8_BAR; PG8_MMA(1, 0, At, B0); PG8_MMA(1, 1, At, B1); PG8_BAR; PG8_SCHED;
        }
        if constexpr (ALIGN_EPI) { if (wr == 0) PG8_BAR; }
        E(acc, cur, wr, wc, fr, fq);
        if (!has_next) break;
#pragma unroll
        for (int a = 0; a < 2; ++a)
#pragma unroll
            for (int b = 0; b < 2; ++b)
#pragma unroll
                for (int m = 0; m < 4; ++m)
#pragma unroll
                    for (int n = 0; n < 2; ++n) acc[a][b][m][n] = (f32x4){0.f, 0.f, 0.f, 0.f};
        cur = nxt; cA = nA; cB = nB; ++ui;
        if constexpr (ALIGN_EPI) { if (wr == 1) PG8_BAR; }
    }
    PG8_WAIT_V(0);
    if constexpr (!ALIGN_EPI) { if (wr == 0) PG8_BAR; }
    PG8_BAR;
#undef PG8_SA
#undef PG8_SB
#undef PG8_STAGE
#undef PG8_LDA
#undef PG8_LDB
#undef PG8_MMA
#undef PG8_WAIT_V
#undef PG8_WAIT_L
#undef PG8_BAR
#undef PG8_SCHED
}

template <class F> struct EpiOct {
    static constexpr bool PERM = true; F f;
    __device__ __forceinline__ void operator()(const f32x4 (&acc)[2][2][4][2], const Unit& u, int wr, int wc, int fr, int fq) const {
#pragma unroll
        for (int ai = 0; ai < 2; ++ai)
#pragma unroll
            for (int m = 0; m < 4; ++m) { const int row = u.pm * BM + ai * HALF + wr * 64 + m * 16 + fr;
#pragma unroll
                for (int bj = 0; bj < 2; ++bj) f.oct(u, row, u.pn * BM + bj * HALF + wc * 32 + 8 * fq, acc[ai][bj][m][0], acc[ai][bj][m][1]);
                if (m & 1) asm volatile("" ::: "memory"); }
    }
};
template <class F> struct EpiGU {
    static constexpr bool PERM = true; F f;
    __device__ __forceinline__ void operator()(const f32x4 (&acc)[2][2][4][2], const Unit& u, int wr, int wc, int fr, int fq) const {
#pragma unroll
        for (int ai = 0; ai < 2; ++ai)
#pragma unroll
            for (int m = 0; m < 4; ++m) { const int row = u.pm * BM + ai * HALF + wr * 64 + m * 16 + fr;
                f.gu(u, row, u.pn * HALF + wc * 32 + 8 * fq, acc[ai][0][m][0], acc[ai][0][m][1], acc[ai][1][m][0], acc[ai][1][m][1]);
                asm volatile("" ::: "memory"); }
    }
};

__device__ __forceinline__ float dot8(const float (&a)[8], u32x4 b) {
    return a[0] * lo16(b.x) + a[1] * hi16(b.x) + a[2] * lo16(b.y) + a[3] * hi16(b.y) + a[4] * lo16(b.z) + a[5] * hi16(b.z) + a[6] * lo16(b.w) + a[7] * hi16(b.w);
}
template <class F, class Sched>
__device__ __forceinline__ void gemm_simple_oct(const Gemm g, const Sched& S, const F& f) {
    Unit u;
    for (int i = 0; S.next(i, u); ++i) {
        const bf16_t* A = g.A + u.aoff + (size_t)u.pm * BM * g.lda; const bf16_t* B = g.Bt + u.boff + (size_t)u.pn * BM * g.ldb;
        for (int it = threadIdx.x; it < 256 * 32; it += NTHR) {
            const int r = it >> 5, cg = it & 31; float acc[8];
#pragma unroll
            for (int c = 0; c < 8; ++c) acc[c] = 0.f;
            const bf16_t* ar = A + (size_t)r * g.lda; const bf16_t* br = B + (size_t)(cg * 8) * g.ldb;
            for (int k = 0; k < g.K; k += 8) {
                const u32x4 a = *(const u32x4*)(ar + k); float af[8] = {lo16(a.x), hi16(a.x), lo16(a.y), hi16(a.y), lo16(a.z), hi16(a.z), lo16(a.w), hi16(a.w)};
#pragma unroll
                for (int c = 0; c < 8; ++c) acc[c] += dot8(af, *(const u32x4*)(br + (size_t)c * g.ldb + k));
            }
            f.oct(u, u.pm * BM + r, u.pn * BM + cg * 8, (f32x4){acc[0], acc[1], acc[2], acc[3]}, (f32x4){acc[4], acc[5], acc[6], acc[7]});
        }
    }
}
template <class F, class Sched>
__device__ __forceinline__ void gemm_simple_gu(const Gemm g, const Sched& S, const F& f) {
    Unit u;
    for (int i = 0; S.next(i, u); ++i) {
        const bf16_t* A = g.A + u.aoff + (size_t)u.pm * BM * g.lda; const bf16_t* B = g.Bt + u.boff + (size_t)u.pn * BM * g.ldb;
        for (int it = threadIdx.x; it < 256 * 16; it += NTHR) {
            const int r = it >> 4, cg = it & 15; float ag[8], au[8];
#pragma unroll
            for (int c = 0; c < 8; ++c) { ag[c] = 0.f; au[c] = 0.f; }
            const bf16_t* ar = A + (size_t)r * g.lda; const bf16_t* bg = B + (size_t)(cg * 8) * g.ldb; const bf16_t* bu = bg + (size_t)HALF * g.ldb;
            for (int k = 0; k < g.K; k += 8) {
                const u32x4 a = *(const u32x4*)(ar + k); float af[8] = {lo16(a.x), hi16(a.x), lo16(a.y), hi16(a.y), lo16(a.z), hi16(a.z), lo16(a.w), hi16(a.w)};
#pragma unroll
                for (int c = 0; c < 8; ++c) { ag[c] += dot8(af, *(const u32x4*)(bg + (size_t)c * g.ldb + k)); au[c] += dot8(af, *(const u32x4*)(bu + (size_t)c * g.ldb + k)); }
            }
            f.gu(u, u.pm * BM + r, u.pn * HALF + cg * 8, (f32x4){ag[0], ag[1], ag[2], ag[3]}, (f32x4){ag[4], ag[5], ag[6], ag[7]}, (f32x4){au[0], au[1], au[2], au[3]}, (f32x4){au[4], au[5], au[6], au[7]});
        }
    }
}
}
#define XB_TMO      128
#define XB_XCNT(j)  (256  + 64 * (j))
#define XB_XSUB(j)  (1280 + 64 * (j))
#define XB_XGEN(j)  (2304 + 64 * (j))
#define XB_TOP      3328
#define XB_TOPGEN   3392
#define XCD_BAR_WORDS 3456
#define XB_SPIN_CAP (1u << 22)

__device__ __forceinline__ unsigned xb_ld(unsigned* p)              { return __hip_atomic_load(p, __ATOMIC_RELAXED, __HIP_MEMORY_SCOPE_AGENT); }
__device__ __forceinline__ unsigned xb_add(unsigned* p, unsigned v) { return __hip_atomic_fetch_add(p, v, __ATOMIC_RELAXED, __HIP_MEMORY_SCOPE_AGENT); }
__device__ __forceinline__ unsigned xb_xcc_id() { return (unsigned)__builtin_amdgcn_s_getreg((3 << 11) | 20) & 0xFu; }
#define XB_SPIN(cond, bar) do { unsigned _sp = 0; while (cond) { __builtin_amdgcn_s_sleep(1); \
    if ((++_sp & 255u) == 0u) { if (xb_ld(&(bar)[XB_TMO])) break; if (_sp > XB_SPIN_CAP) { atomicAdd(&(bar)[XB_TMO], 1u); break; } } } } while (0)

struct XcdBarrier {
    unsigned* bar; unsigned x;
    volatile LAS unsigned* st;
};

__device__ __forceinline__ XcdBarrier xcd_barrier_post(unsigned* bar, volatile LAS unsigned* st) {
    XcdBarrier b; b.bar = bar; b.x = xb_xcc_id(); b.st = st;
    if (threadIdx.x == 0) (void)xb_add(&bar[XB_XCNT(b.x)], 1u);
    return b;
}
__device__ __forceinline__ void xcd_barrier_complete(unsigned* bar, unsigned x, unsigned& nloc, unsigned& nx) {
    const unsigned G = gridDim.x * gridDim.y * gridDim.z;
    unsigned sum, cnt, mine, sp = 0u;
    for (;;) {
        sum = 0u; cnt = 0u; mine = 0u;
#pragma unroll
        for (unsigned j = 0; j < 16; ++j) { const unsigned c = xb_ld(&bar[XB_XCNT(j)]); sum += c; cnt += (c > 0u) ? 1u : 0u; mine = (j == x) ? c : mine; }
        if (sum == G) break;
        __builtin_amdgcn_s_sleep(1);
        if ((++sp & 255u) == 0u) { if (xb_ld(&bar[XB_TMO])) break; if (sp > XB_SPIN_CAP) { atomicAdd(&bar[XB_TMO], 1u); break; } }
    }
    nloc = mine > 0u ? mine : 1u; nx = cnt > 0u ? cnt : 1u;
}

__device__ __forceinline__ void xcd_barrier(const XcdBarrier& b) {
    asm volatile("s_waitcnt vmcnt(0)" ::: "memory");
    __syncthreads();
    if (threadIdx.x == 0) {
        unsigned* bar = b.bar;
        __builtin_amdgcn_s_waitcnt(0);
        unsigned nloc = b.st[0], nx = b.st[1];
        if (nloc == 0u) { xcd_barrier_complete(bar, b.x, nloc, nx); b.st[0] = nloc; b.st[1] = nx; }
        const unsigned old = xb_add(&bar[XB_XSUB(b.x)], 1u);
        const unsigned gen = old / nloc;
        if (old + 1u == (gen + 1u) * nloc) {
            __builtin_amdgcn_fence(__ATOMIC_RELEASE, "agent");
            asm volatile("s_waitcnt vmcnt(0)" ::: "memory");
            const unsigned og = xb_add(&bar[XB_TOP], 1u);
            const unsigned tg = og / nx;
            if (og + 1u == (tg + 1u) * nx) xb_add(&bar[XB_TOPGEN], 1u);
            else XB_SPIN(xb_ld(&bar[XB_TOPGEN]) == tg, bar);
            __builtin_amdgcn_fence(__ATOMIC_ACQUIRE, "agent");
            xb_add(&bar[XB_XGEN(b.x)], 1u);
            asm volatile("s_waitcnt vmcnt(0)" ::: "memory");
        } else {
            XB_SPIN(xb_ld(&bar[XB_XGEN(b.x)]) == gen, bar);
            __builtin_amdgcn_fence(__ATOMIC_ACQUIRE, "agent");
            asm volatile("s_waitcnt vmcnt(0)" ::: "memory");
        }
    }
    __syncthreads();
}

struct Ctx {
    LAS unsigned char* lds; int tid, lane, wave, G, wg, gw, NGW;
    const float* const __attribute__((address_space(4)))* in; float* X; unsigned char* ws;
};
#define WSP(type, off) ((type*)(c.ws + (off)))
#define WSG(type, off) ((GAS type*)(c.ws + (off)))
#define ING(i) ((const GAS float*)c.in[i])

struct CvtJob { const float* W0; const float* W1; const float* kscale; bf16_t* WT; int ldw, K, Ndst, kind; };
__device__ __forceinline__ int cvt_src_col(int kind, int n, int& which) {
    which = 0;
    if (kind == 0) return n;
    if (kind == 1) {
        if (n < 2048) return n; if (n < 3584) return n + 8; if (n < 4416) return n + 16;
        if (n < 4420) return 2048 + (n - 4416); if (n < 4424) return 2052 + (n - 4420); if (n < 4432) return 3592 + (n - 4424);
        if (n < 4608) return -1; return 4432 + (n - 4608);
    }
    if (kind == 2) { const int h = n / 192, j = n % 192; if (j < 128) return n; const int jj = j - 128; return h * 192 + 128 + (jj & 1) * 32 + (jj >> 1); }
    const int uu = n >> 8, r = n & 255; which = r >> 7; return uu * 128 + (r & 127);
}
__device__ __forceinline__ void cvt_item(const CvtJob& jb, int item, LAS float* scr, int lane) {
    const int nblk = jb.Ndst / 32, kb = item / nblk, nb = item % nblk, k0 = 64 * kb, n0 = 32 * nb;
    int which; const int sc = cvt_src_col(jb.kind, n0 + (lane & 31), which);
    const float* W = (const float*)((uintptr_t)jb.W0 + (uintptr_t)which * ((uintptr_t)jb.W1 - (uintptr_t)jb.W0));
    float v[32];
#pragma unroll
    for (int i = 0; i < 32; ++i) { const int kk = 2 * i + (lane >> 5); v[i] = (sc >= 0) ? W[(size_t)(k0 + kk) * jb.ldw + sc] : 0.f; }
    if (jb.kscale) {
#pragma unroll
        for (int i = 0; i < 32; ++i) v[i] *= jb.kscale[k0 + 2 * i + (lane >> 5)]; }
#pragma unroll
    for (int i = 0; i < 32; ++i) scr[(2 * i + (lane >> 5)) * 33 + (lane & 31)] = v[i];
    LDS_WAIT(); asm volatile("" ::: "memory");
    const int cc = lane & 7;
#pragma unroll
    for (int j = 0; j < 4; ++j) { const int n = (lane >> 3) + 8 * j; const LAS float* s = scr + (8 * cc) * 33 + n;
        u32x4 o; o.x = pk2(s[0 * 33], s[1 * 33]); o.y = pk2(s[2 * 33], s[3 * 33]); o.z = pk2(s[4 * 33], s[5 * 33]); o.w = pk2(s[6 * 33], s[7 * 33]);
        *(u32x4*)(jb.WT + (size_t)(n0 + n) * jb.K + k0 + 8 * cc) = o; }
    LDS_WAIT(); asm volatile("" ::: "memory");
}
__device__ __forceinline__ void cvt_run(const Ctx& c, const CvtJob& jb, LAS float* scr) {
    const int nitems = (jb.K / 64) * (jb.Ndst / 32);
    for (int it = c.gw; it < nitems; it += c.NGW) cvt_item(jb, it, scr, c.lane);
}
__device__ __forceinline__ void cvt_run_ranked(const Ctx& c, const CvtJob& jb, LAS float* scr, int rank, int count) {
    const int nitems = (jb.K / 64) * (jb.Ndst / 32);
    for (int it = rank; it < nitems; it += count) cvt_item(jb, it, scr, c.lane);
}
__device__ __forceinline__ CvtJob make_job(const Ctx& c, int j) {
    CvtJob jb; jb.W0 = nullptr; jb.W1 = nullptr; jb.kscale = nullptr; jb.kind = 0;
    if (j < 8 * NL) {
        const int l = j >> 3, k = j & 7;
        if (k == 0) { jb.W0 = c.in[5] + (size_t)l * 1024 * 7504; jb.ldw = 7504; jb.K = 1024; jb.Ndst = NP; jb.kind = 1; jb.WT = WSP(bf16_t, O_WIN) + (size_t)l * NP * 1024; }
        else if (k == 1) { jb.W0 = c.in[17] + (size_t)l * 512 * 768; jb.ldw = 768; jb.K = 512; jb.Ndst = 768; jb.kind = 2; jb.kscale = c.in[16] + l * 512; jb.WT = WSP(bf16_t, O_WUQ) + (size_t)l * 768 * 512; }
        else if (k == 2) { jb.W0 = c.in[19] + (size_t)l * 256 * 512; jb.ldw = 512; jb.K = 256; jb.Ndst = 512; jb.kscale = c.in[18] + l * 256; jb.WT = WSP(bf16_t, O_WUK) + (size_t)l * 512 * 256; }
        else if (k == 3) { jb.W0 = c.in[20] + (size_t)l * 256 * 512; jb.ldw = 512; jb.K = 256; jb.Ndst = 512; jb.kscale = c.in[18] + l * 256; jb.WT = WSP(bf16_t, O_WUV) + (size_t)l * 512 * 256; }
        else if (k < 7) { jb.W0 = (k == 4 ? c.in[21] : k == 5 ? c.in[22] : c.in[23]) + (size_t)l * 512 * 1024; jb.ldw = 1024; jb.K = 512; jb.Ndst = 1024; jb.WT = WSP(bf16_t, O_WBR) + (size_t)(l * 3 + (k - 4)) * 1024 * 512; }
        else { jb.W0 = c.in[24] + (size_t)l * 1024 * 1024; jb.ldw = 1024; jb.K = 1024; jb.Ndst = 1024; jb.WT = WSP(bf16_t, O_WOUT) + (size_t)l * 1024 * 1024; }
    } else {
        const int i = (j - 8 * NL) >> 1, k = (j - 8 * NL) & 1;
        if (k == 0) { jb.W0 = c.in[25] + (size_t)i * 1024 * FF; jb.W1 = c.in[26] + (size_t)i * 1024 * FF; jb.ldw = FF; jb.K = 1024; jb.Ndst = 2 * FF; jb.kind = 3; jb.WT = WSP(bf16_t, O_WGU) + (size_t)i * 2 * FF * 1024; }
        else { jb.W0 = c.in[27] + (size_t)i * FF * 1024; jb.ldw = 1024; jb.K = FF; jb.Ndst = 1024; jb.WT = WSP(bf16_t, O_WDN) + (size_t)i * 1024 * FF; }
    }
    return jb;
}
__device__ __forceinline__ CvtJob make_moe_job(const Ctx& c, int i, int j) {
    CvtJob jb; jb.W0 = nullptr; jb.W1 = nullptr; jb.kscale = nullptr; jb.kind = 0;
    if (j < 8) { const size_t eo = (size_t)(i * 8 + j) * 1024 * EF; jb.W0 = c.in[29] + eo; jb.W1 = c.in[30] + eo; jb.ldw = EF; jb.K = 1024; jb.Ndst = 2 * EF; jb.kind = 3; jb.WT = WSP(bf16_t, O_WEGU) + (size_t)j * 2 * EF * 1024; }
    else { const int e = j - 8; jb.W0 = c.in[31] + (size_t)(i * 8 + e) * EF * 1024; jb.ldw = 1024; jb.K = EF; jb.Ndst = 1024; jb.WT = WSP(bf16_t, O_WEDN) + (size_t)e * 1024 * EF; }
    return jb;
}

__device__ __forceinline__ void cvt_item(const CvtJob& jb, int item, LAS float* scr, int lane);
struct CvtQueue { unsigned* ctr; unsigned base, off; int lane;
    __device__ __forceinline__ unsigned grab() { unsigned b = 0; if (lane == 0) b = __hip_atomic_fetch_add(ctr, 8u, __ATOMIC_RELAXED, __HIP_MEMORY_SCOPE_AGENT); return (unsigned)__builtin_amdgcn_readfirstlane(b); }
    __device__ __forceinline__ void init(unsigned* c_, int lane_) { ctr = c_; lane = lane_; off = 0; base = grab(); }
    __device__ __forceinline__ void run(const CvtJob& jb, LAS float* scr) { const unsigned n = (unsigned)(jb.K / 64) * (unsigned)(jb.Ndst / 32);
        while (base - off < n) {
#pragma unroll 1
            for (unsigned k = 0; k < 8; ++k) cvt_item(jb, (int)(base - off + k), scr, lane);
            base = grab(); }
        off += n; }
};
__device__ __forceinline__ void p0_prologue(const Ctx& c) {
    LAS float* sil = (LAS float*)c.lds;
    LAS float* red = sil + 4096;
    LAS float* scr = (LAS float*)(c.lds + 32768 + c.wave * 8704);
    for (int i = c.tid; i < 4096; i += NTHR) sil[i] = siluf_(c.in[1][i]);
    __syncthreads();
    float* MOD = WSP(float, O_MOD);
    for (int it = c.wg; it < NL * 96; it += c.G) {
        const int l = it / 96, cg = it % 96, col = cg * 64 + c.lane;
        float a0 = 0.f, a1 = 0.f, a2 = 0.f, a3 = 0.f;
        const float* w = c.in[3] + (size_t)l * 1024 * 6144 + col;
#pragma unroll 32
        for (int k = c.wave * 128; k < c.wave * 128 + 128; ++k) { const float wv = w[(size_t)k * 6144]; a0 += sil[k] * wv; a1 += sil[1024 + k] * wv; a2 += sil[2048 + k] * wv; a3 += sil[3072 + k] * wv; }
        red[(c.wave * 4 + 0) * 64 + c.lane] = a0; red[(c.wave * 4 + 1) * 64 + c.lane] = a1; red[(c.wave * 4 + 2) * 64 + c.lane] = a2; red[(c.wave * 4 + 3) * 64 + c.lane] = a3;
        __syncthreads();
        if (c.tid < 256) { const int b = c.tid >> 6, ln = c.tid & 63; float s = 0.f;
#pragma unroll
            for (int w8 = 0; w8 < 8; ++w8) s += red[(w8 * 4 + b) * 64 + ln];
            MOD[(size_t)(l * 4 + b) * 6144 + cg * 64 + ln] = s + c.in[4][l * 6144 + cg * 64 + ln]; }
        __syncthreads();
    }
    { float* ROPE = WSP(float, O_ROPE); const int* pos = (const int*)c.in[2];
      for (int idx = c.wg * NTHR + c.tid; idx < T * 32; idx += c.G * NTHR) { const int t = idx >> 5, i = idx & 31;
          const float inv = expf(-(float)(2 * i) * (1.f / 64.f) * 9.210340371976184f); const float ang = (float)pos[t] * inv; float sn, cs; sincosf(ang, &sn, &cs);
          ROPE[(size_t)idx * 2] = cs; ROPE[(size_t)idx * 2 + 1] = sn; } }
    { CvtQueue q; q.init((unsigned*)(c.ws + O_CTL) + 256 + 64 * 8, c.lane);
      for (int j = 0; j < 4; ++j) { const CvtJob jb = make_job(c, j); q.run(jb, scr); } }
}

__device__ __forceinline__ void load_row(const Ctx& c, int row, int combine_l, f32x4 (&v)[4], const float* xsrc = nullptr) {
    float* xr = c.X + (size_t)row * D + 4 * c.lane; const float* xs = (xsrc ? xsrc : c.X) + (size_t)row * D + 4 * c.lane;
#pragma unroll
    for (int j = 0; j < 4; ++j) v[j] = *(const f32x4*)(xs + 256 * j);
    if (combine_l >= 0) {
        const int b = row >> 12; const int* ts = WSP(int, O_TOKSLOT) + row * 2; const float* tw = WSP(float, O_TOPW) + row * 2;
        const int s0 = ts[0], s1 = ts[1]; const float w0 = tw[0], w1 = tw[1];
        const float* g2 = WSP(float, O_MOD) + (size_t)(combine_l * 4 + b) * 6144 + 5120 + 4 * c.lane;
        const int nmain = WSP(int, O_NBLK)[1] * 256;
        const bf16_t* y0 = WSP(bf16_t, O_YS) + (size_t)s0 * D + 4 * c.lane; const bf16_t* y1 = WSP(bf16_t, O_YS) + (size_t)s1 * D + 4 * c.lane;
        const float* z0 = WSP(float, O_MF) + (size_t)(s0 - nmain) * D + 4 * c.lane; const float* z1 = WSP(float, O_MF) + (size_t)(s1 - nmain) * D + 4 * c.lane;
#pragma unroll
        for (int j = 0; j < 4; ++j) { const f32x4 g = *(const f32x4*)(g2 + 256 * j); f32x4 ya, yb;
            if (s0 >= nmain) { ya = *(const f32x4*)(z0 + 256 * j);
#pragma unroll
                for (int k = 1; k < 7; ++k) ya = ya + *(const f32x4*)(z0 + (size_t)k * (8 * 256 * 1024) + 256 * j); }
            else { const u32x2 a = *(const u32x2*)(y0 + 256 * j); ya = (f32x4){lo16(a.x), hi16(a.x), lo16(a.y), hi16(a.y)}; }
            if (s1 >= nmain) { yb = *(const f32x4*)(z1 + 256 * j);
#pragma unroll
                for (int k = 1; k < 7; ++k) yb = yb + *(const f32x4*)(z1 + (size_t)k * (8 * 256 * 1024) + 256 * j); }
            else { const u32x2 bb = *(const u32x2*)(y1 + 256 * j); yb = (f32x4){lo16(bb.x), hi16(bb.x), lo16(bb.y), hi16(bb.y)}; }
            v[j] = v[j] + g * (ya * w0 + yb * w1); *(f32x4*)(xr + 256 * j) = v[j]; }
    }
}
__device__ __forceinline__ float row_rstd(const f32x4 (&v)[4]) {
    float ss = 0.f;
#pragma unroll
    for (int j = 0; j < 4; ++j) ss += (v[j][0] * v[j][0] + v[j][1] * v[j][1]) + (v[j][2] * v[j][2] + v[j][3] * v[j][3]);
    return rsqrtf(wave_sum(ss) * (1.f / D) + EPS);
}
__device__ __forceinline__ void norm_phase(const Ctx& c, int l, int which, int combine_l, const float* xsrc = nullptr) {
    bf16_t* H = WSP(bf16_t, O_H);
    for (int row0 = c.gw * 2; row0 < T; row0 += c.NGW * 2) {
        f32x4 v[2][4]; load_row(c, row0, combine_l, v[0], xsrc); load_row(c, row0 + 1, combine_l, v[1], xsrc);
#pragma unroll
        for (int q = 0; q < 2; ++q) { const int row = row0 + q;
            const float r = row_rstd(v[q]); const int b = row >> 12;
            const float* sh = WSP(float, O_MOD) + (size_t)(l * 4 + b) * 6144 + (which ? 3072 : 0) + 4 * c.lane; const float* sc = sh + 1024;
#pragma unroll
            for (int j = 0; j < 4; ++j) { const f32x4 s1 = *(const f32x4*)(sc + 256 * j), s0 = *(const f32x4*)(sh + 256 * j); const f32x4 h = v[q][j] * r * (s1 + 1.f) + s0;
                u32x2 o; o.x = pk2(h[0], h[1]); o.y = pk2(h[2], h[3]); *(u32x2*)(H + (size_t)row * D + 4 * c.lane + 256 * j) = o; } }
    }
}
__device__ __forceinline__ void final_phase(const Ctx& c, int combine_l) {
    for (int row = c.gw; row < T; row += c.NGW) {
        f32x4 v[4]; load_row(c, row, combine_l, v);
        const float r = row_rstd(v); const float* fw = c.in[32] + 4 * c.lane;
#pragma unroll
        for (int j = 0; j < 4; ++j) { const f32x4 w = *(const f32x4*)(fw + 256 * j); *(f32x4*)(c.X + (size_t)row * D + 4 * c.lane + 256 * j) = v[j] * r * w; }
    }
}
__device__ __forceinline__ void norm2_moe_phase(const Ctx& c, int l) {
    bf16_t* H = WSP(bf16_t, O_H);
    LAS float* rt = (LAS float*)c.lds;
    LAS int* hist = (LAS int*)(c.lds + 32768);
    const float* router = c.in[28] + (size_t)(l >> 1) * 1024 * 8;
    for (int i = c.tid; i < 8192; i += NTHR) rt[i] = router[i];
    if (c.tid < 8) hist[c.tid] = 0;
    __syncthreads();
    const int rpw = T / c.G, r0 = c.wg * rpw;
    for (int rr = c.wave; rr < rpw; rr += NWAVES) {
        const int row = r0 + rr;
        f32x4 v[4]; load_row(c, row, -1, v);
        const float r = row_rstd(v); const int b = row >> 12;
        const float* sh = WSP(float, O_MOD) + (size_t)(l * 4 + b) * 6144 + 3072 + 4 * c.lane; const float* sc = sh + 1024;
        float lg[8];
#pragma unroll
        for (int e = 0; e < 8; ++e) lg[e] = 0.f;
#pragma unroll
        for (int j = 0; j < 4; ++j) { const f32x4 s1 = *(const f32x4*)(sc + 256 * j), s0 = *(const f32x4*)(sh + 256 * j); const f32x4 h = v[j] * r * (s1 + 1.f) + s0;
            u32x2 o; o.x = pk2(h[0], h[1]); o.y = pk2(h[2], h[3]); *(u32x2*)(H + (size_t)row * D + 4 * c.lane + 256 * j) = o;
#pragma unroll
            for (int q = 0; q < 4; ++q) { const LAS f32x4* rp = (const LAS f32x4*)(rt + (4 * c.lane + 256 * j + q) * 8); const f32x4 ra = rp[0], rb = rp[1];
                lg[0] += h[q] * ra[0]; lg[1] += h[q] * ra[1]; lg[2] += h[q] * ra[2]; lg[3] += h[q] * ra[3]; lg[4] += h[q] * rb[0]; lg[5] += h[q] * rb[1]; lg[6] += h[q] * rb[2]; lg[7] += h[q] * rb[3]; } }
#pragma unroll
        for (int e = 0; e < 8; ++e) lg[e] = wave_sum(lg[e]);
        if (c.lane == 0) {
            int e0 = 0; float m0 = lg[0];
#pragma unroll
            for (int e = 1; e < 8; ++e) if (lg[e] > m0) { m0 = lg[e]; e0 = e; }
            int e1 = -1; float m1 = -3.0e38f;
#pragma unroll
            for (int e = 0; e < 8; ++e) if (e != e0 && lg[e] > m1) { m1 = lg[e]; e1 = e; }
            const float ex = __expf(m1 - m0), w0 = 1.f / (1.f + ex);
            WSP(int, O_TOPE)[row] = e0 | (e1 << 8); WSP(float, O_TOPW)[row * 2] = w0; WSP(float, O_TOPW)[row * 2 + 1] = ex * w0;
            __hip_atomic_fetch_add(&hist[e0], 1, __ATOMIC_RELAXED, __HIP_MEMORY_SCOPE_WORKGROUP); __hip_atomic_fetch_add(&hist[e1], 1, __ATOMIC_RELAXED, __HIP_MEMORY_SCOPE_WORKGROUP);
        }
    }
    __syncthreads();
    if (c.tid < 8) WSP(int, O_WGCNT)[c.wg * 8 + c.tid] = hist[c.tid];
    __syncthreads();
}
__device__ __forceinline__ void moe_assign_phase(const Ctx& c, int l) {
    LAS int* cnt = (LAS int*)c.lds;
    LAS int* tot = cnt + 2048; LAS int* base = tot + 8; LAS int* spad = base + 8; LAS int* pairs = spad + 16;
    const int rpw = T / c.G, r0 = c.wg * rpw;
    LAS int* tl = pairs + 4 * rpw;
    const int* WGC = WSP(int, O_WGCNT);
    for (int i = c.tid; i < c.G * 8; i += NTHR) cnt[i] = WGC[i];
    if (c.tid < rpw) tl[c.tid] = WSP(int, O_TOPE)[r0 + c.tid];
    __syncthreads();
    if (c.tid < 8) { int t = 0, bs = 0; for (int w = 0; w < c.G; ++w) { if (w == c.wg) bs = t; t += cnt[w * 8 + c.tid]; } tot[c.tid] = t; base[c.tid] = bs; }
    __syncthreads();
    if (c.tid == 0) {
        int sp = 0; for (int e = 0; e < 8; ++e) { spad[e] = sp; sp += (tot[e] + 255) / 256 * 256; } spad[8] = sp;
        if (c.wg == 0) { int* blke = WSP(int, O_BLKE); int nb = 0; for (int e = 0; e < 8; ++e) { const int n = (tot[e] + 255) / 256; for (int k = 0; k < n; ++k) blke[nb++] = e; } *WSP(int, O_NBLK) = nb; WSP(int, O_NBLK)[1] = ((nb * 4) / c.G) * c.G / 4; }
    }
    __syncthreads();
    if (c.wave == 0) {
        int* tokslot = WSP(int, O_TOKSLOT); int runq[8];
#pragma unroll
        for (int q = 0; q < 8; ++q) runq[q] = spad[q] + base[q];
        const unsigned long long lt = (1ull << c.lane) - 1ull;
        for (int a0 = 0; a0 < 2 * rpw; a0 += 64) { const int a = a0 + c.lane, rr = a >> 1, k = a & 1; const bool on = a < 2 * rpw; const int e = on ? ((tl[rr] >> (8 * k)) & 255) : -1; int sl = 0;
#pragma unroll
            for (int q = 0; q < 8; ++q) { const unsigned long long m = __ballot(e == q); if (e == q) sl = runq[q] + __popcll(m & lt); runq[q] += __popcll(m); }
            if (on) { tokslot[(r0 + rr) * 2 + k] = sl; pairs[a * 2] = sl; pairs[a * 2 + 1] = r0 + rr; } }
    }
    __syncthreads();
    { const bf16_t* H = WSP(bf16_t, O_H); bf16_t* XS = WSP(bf16_t, O_XS);
      for (int p = c.wave; p < rpw * 2; p += NWAVES) { const int s = pairs[p * 2], tk = pairs[p * 2 + 1];
          const u32x4* src = (const u32x4*)(H + (size_t)tk * D) + c.lane; u32x4* dst = (u32x4*)(XS + (size_t)s * D) + c.lane; dst[0] = src[0]; dst[64] = src[64]; }
      if (c.wg < 8) { const int e = c.wg, p0 = spad[e] + tot[e], p1 = spad[e + 1];
          for (int s = p0 + c.wave; s < p1; s += NWAVES) { u32x4* dst = (u32x4*)(XS + (size_t)s * D) + c.lane; dst[0] = (u32x4){0u, 0u, 0u, 0u}; dst[64] = (u32x4){0u, 0u, 0u, 0u}; } } }
    __syncthreads();
}
__device__ __forceinline__ void next_layer_convert(const Ctx& c, int l, LAS float* scr, int rank, int count) {
    if (l + 1 >= NL) return;
    for (int j = 8 * (l + 1); j < 8 * (l + 2); ++j) { const CvtJob jb = make_job(c, j); cvt_run_ranked(c, jb, scr, rank, count); }
    if (((l + 1) & 1) == 0) for (int j = 8 * NL + 2 * ((l + 1) >> 1); j < 8 * NL + 2 * ((l + 1) >> 1) + 2; ++j) { const CvtJob jb = make_job(c, j); cvt_run_ranked(c, jb, scr, rank, count); }
}
__device__ __forceinline__ void moe_convert(const Ctx& c, int l, LAS float* scr, int rank, int count) {
    for (int j = 0; j < 16; ++j) { const CvtJob jb = make_moe_job(c, l >> 1, j); cvt_run_ranked(c, jb, scr, rank, count); }
}
__device__ __forceinline__ void moe_convert_queue(const Ctx& c, int l, LAS float* scr) {
    unsigned* ctr = (unsigned*)(c.ws + O_CTL) + 256 + 64 * (l >> 1);
    constexpr unsigned NGU = 8u * 16u * (2 * EF / 32), NDN = 8u * (EF / 64) * 32u;
    for (;;) {
        unsigned base = 0; if (c.lane == 0) base = __hip_atomic_fetch_add(ctr, 8u, __ATOMIC_RELAXED, __HIP_MEMORY_SCOPE_AGENT);
        base = __builtin_amdgcn_readfirstlane(base);
        if (base >= NGU + NDN) break;
#pragma unroll 1
        for (unsigned k = 0; k < 8; ++k) { const unsigned idx = base + k; int j, item;
            if (idx < NGU) { j = idx / (NGU / 8); item = idx % (NGU / 8); } else { const unsigned r = idx - NGU; j = 8 + r / (NDN / 8); item = r % (NDN / 8); }
            const CvtJob jb = make_moe_job(c, l >> 1, j); cvt_item(jb, item, scr, c.lane); }
    }
}
__device__ __forceinline__ void next_layer_convert_queue(const Ctx& c, int l, LAS float* scr) {
    if (l + 1 >= NL) return;
    unsigned* ctr = (unsigned*)(c.ws + O_CTL) + 256 + 64 * (4 + l);
    auto grab = [&]() { unsigned b = 0; if (c.lane == 0) b = __hip_atomic_fetch_add(ctr, 8u, __ATOMIC_RELAXED, __HIP_MEMORY_SCOPE_AGENT); return (unsigned)__builtin_amdgcn_readfirstlane(b); };
    unsigned base = grab(), off = 0;
    auto run = [&](int j) { const CvtJob jb = make_job(c, j); const unsigned n = (unsigned)(jb.K / 64) * (unsigned)(jb.Ndst / 32);
        while (base - off < n) {
#pragma unroll 1
            for (unsigned k = 0; k < 8; ++k) cvt_item(jb, (int)(base - off + k), scr, c.lane);
            base = grab(); }
        off += n; };
    if (l == 0) { for (int j = 4; j < 8; ++j) run(j); run(8 * NL); run(8 * NL + 1); }
    for (int j = 8 * (l + 1); j < 8 * (l + 2); ++j) run(j);
    if (((l + 1) & 1) == 0) for (int j = 8 * NL + 2 * ((l + 1) >> 1); j < 8 * NL + 2 * ((l + 1) >> 1) + 2; ++j) run(j);
}
__device__ __forceinline__ void gdn_prep_unit(const Ctx& c, int l, int unit, int stop = 0) {
    const int h = unit & 3, n = (unit >> 2) & 63, b = unit >> 8;
    const int t0 = b * SEQ + n * CH;
    LAS bf16_t* Qb = (LAS bf16_t*)c.lds; LAS bf16_t* Kb = Qb + 64 * 136;
    LAS float* AS = (LAS float*)(c.lds + 34816);
    LAS float* KS = AS + 4096; LAS float* VS = KS + 8643; LAS float* QS = VS + 8643;
    LAS float* GS = QS + 8643; LAS float* BE = GS + 64; LAS float* EG = BE + 64;
    const GAS bf16_t* P = WSG(bf16_t, O_PROJ);
    { LAS unsigned char* rawl = c.lds;
#pragma unroll 1
      for (int k = 0; k < 7; ++k) { const int I = c.wave + 8 * k;
          if (I < 51) { const int idx = I * 64 + c.lane; if (idx < 67 * 48) { const int r = idx / 48, pc = idx % 48;
              if (n > 0 || r >= 3) __builtin_amdgcn_global_load_lds((const unsigned*)((const char*)(P + (size_t)(t0 - 3 + r) * NP + (pc >> 4) * 512 + h * 128 + (pc & 15) * 8)), (LAS unsigned*)(rawl + I * 1024), 16, 0, 0); } } }
      asm volatile("s_waitcnt vmcnt(0)" ::: "memory"); LDS_BARRIER(); }
    if (c.tid < 384) {
        const int part = c.tid >> 7, d = c.tid & 127, col = part * 512 + h * 128 + d;
        const GAS float* cw = ING(6) + (size_t)l * 4 * 1536 + col; const float w0 = cw[0], w1 = cw[1536], w2 = cw[2 * 1536], w3 = cw[3 * 1536];
        const LAS bf16_t* src = (const LAS bf16_t*)c.lds + c.tid;
        unsigned short raw[67];
#pragma unroll
        for (int r = 0; r < 67; ++r) raw[r] = (n > 0 || r >= 3) ? src[r * 384] : (unsigned short)0;
        LAS float* A = (part == 0 ? QS : part == 1 ? KS : VS) + 3 * 129 + d;
#pragma unroll
        for (int t = 0; t < 64; ++t) A[t * 129] = siluf_(w0 * bf2f(raw[t]) + w1 * bf2f(raw[t + 1]) + w2 * bf2f(raw[t + 2]) + w3 * bf2f(raw[t + 3]));
    } else if (c.tid < 448) {
        const int t = c.tid - 384; const GAS float* sf = WSG(float, O_SMALLF) + (size_t)(t0 + t) * 16;
        const float a = sf[h], bb = sf[4 + h];
        const float g = -expf(ING(7)[l * 4 + h]) * softplusf_(a + ING(8)[l * 4 + h]);
        float G = g;
#pragma unroll
        for (int o = 1; o < 64; o <<= 1) { const float up = __shfl_up(G, o); if (t >= o) G += up; }
        GS[t] = G; BE[t] = sigmoidf_(bb); EG[t] = expf(G);
    }
    LDS_BARRIER();
    if (stop == 2) return;
    for (int rr = c.wave; rr < 128; rr += NWAVES) { const bool isq = rr < 64; const int t = rr & 63; LAS float* row = (isq ? QS : KS) + (t + 3) * 129;
        const float a = row[c.lane], bq = row[c.lane + 64]; const float ss = wave_sum(a * a + bq * bq); const float sc = rsqrtf(ss + EPS) * (isq ? 0.08838834764831845f : 1.f);
        LAS bf16_t* ob = (isq ? Qb : Kb) + t * 136;
        ob[c.lane] = (bf16_t)f2bf(a * sc); ob[c.lane + 64] = (bf16_t)f2bf(bq * sc);
        if (!isq) { row[c.lane] = a * sc; row[c.lane + 64] = bq * sc; } }
    LDS_BARRIER();
    LAS float* QKs = QS;
    { const int typ = c.wave >> 2, ti = c.wave & 3, lr = c.lane & 15, g = c.lane >> 4;
      const LAS bf16_t* Xb = typ ? Qb : Kb;
#pragma unroll 1
      for (int tj = 0; tj < 4; ++tj) {
          f32x4 acc = {0.f, 0.f, 0.f, 0.f};
          if (tj <= ti) {
#pragma unroll
              for (int ks = 0; ks < 4; ++ks) { const bf16x8 af = *(const LAS bf16x8*)(Xb + (16 * ti + lr) * 136 + 32 * ks + 8 * g); const bf16x8 bf = *(const LAS bf16x8*)(Kb + (16 * tj + lr) * 136 + 32 * ks + 8 * g);
                  acc = __builtin_amdgcn_mfma_f32_16x16x32_bf16(af, bf, acc, 0, 0, 0); } }
          const int j = 16 * tj + lr;
#pragma unroll
          for (int r = 0; r < 4; ++r) { const int i = 16 * ti + 4 * g + r; float v = 0.f;
              if (typ == 0) { if (j < i) v = BE[i] * acc[r] * __expf(GS[i] - GS[j]); AS[i * 64 + j] = v; }
              else { if (j <= i) v = acc[r] * __expf(GS[i] - GS[j]); QKs[i * 65 + j] = v; } } } }
    LDS_BARRIER();
    if (stop == 4) return;
    const int chunk = (b * 4 + h) * 64 + n;
    if (c.tid >= 256) { GAS bf16_t* OPS = WSG(bf16_t, O_GW) + (size_t)chunk * (56 * 512); const float gl = GS[63];
#pragma unroll 1
      for (int q = 1024 + (c.tid - 256); q < 56 * 64; q += 256) { const int f = q >> 6, ln = q & 63, lr = ln & 15, g = ln >> 4; float v[8];
          if (f < 32) { const int ct = (f - 16) >> 2, ks = (f - 16) & 3, i = 16 * ct + lr; const float eg = EG[i]; const LAS bf16_t* qr = Qb + i * 136 + 32 * ks + 4 * g;
#pragma unroll
              for (int j = 0; j < 4; ++j) { v[j] = bf2f(qr[j]) * eg; v[4 + j] = bf2f(qr[16 + j]) * eg; } }
          else if (f < 40) { const int ct = (f - 32) >> 1, ks2 = (f - 32) & 1; const LAS float* qr = QKs + (16 * ct + lr) * 65 + 32 * ks2 + 4 * g;
#pragma unroll
              for (int j = 0; j < 4; ++j) { v[j] = qr[j]; v[4 + j] = qr[16 + j]; } }
          else { const int dt = (f - 40) >> 1, ks2 = (f - 40) & 1, dk = 16 * dt + lr, c0 = 32 * ks2 + 4 * g;
#pragma unroll
              for (int j = 0; j < 4; ++j) { v[j] = bf2f(Kb[(c0 + j) * 136 + dk]) * __expf(gl - GS[c0 + j]); v[4 + j] = bf2f(Kb[(c0 + 16 + j) * 136 + dk]) * __expf(gl - GS[c0 + 16 + j]); } }
          u32x4 o; o.x = pk2(v[0], v[1]); o.y = pk2(v[2], v[3]); o.z = pk2(v[4], v[5]); o.w = pk2(v[6], v[7]);
          *(GAS u32x4*)(OPS + (size_t)q * 8) = o; }
      if (c.tid == 256) WSG(float, O_GL)[chunk] = expf(gl);
    } else {
        const int col = c.tid; LAS float* src = ((col < 128) ? VS + col : KS + (col - 128)) + 3 * 129;
        unsigned asb = (unsigned)(uintptr_t)AS; asm volatile("" : "+v"(asb));
        const LAS float* ASv = (const LAS float*)(uintptr_t)asb; const LAS float* BEv = ASv + 4096 + 3 * 8643 + 64; const LAS float* EGv = BEv + 64;
        const LAS f32x4* A4 = (const LAS f32x4*)ASv;
        f32x2 x2[32]; f32x4 ar[16];
#pragma unroll
        for (int m = 0; m < 32; ++m) { x2[m][0] = src[(2 * m) * 129] * BEv[2 * m] * (col < 128 ? 1.f : EGv[2 * m]); x2[m][1] = src[(2 * m + 1) * 129] * BEv[2 * m + 1] * (col < 128 ? 1.f : EGv[2 * m + 1]); }
        ar[0] = A4[16];
#pragma unroll
        for (int i = 0; i < 64; ++i) {
            f32x2 acc0 = {0.f, 0.f}, acc1 = {0.f, 0.f};
#pragma unroll
            for (int q = 0; 4 * q < i; ++q) { const f32x4 aq = ar[q];
                if (4 * q + 1 < i) acc0 = acc0 + (f32x2){aq[0], aq[1]} * x2[2 * q]; else acc0[0] += aq[0] * x2[2 * q][0];
                if (4 * q + 3 < i) acc1 = acc1 + (f32x2){aq[2], aq[3]} * x2[2 * q + 1]; else if (4 * q + 2 < i) acc1[0] += aq[2] * x2[2 * q + 1][0];
                if (i + 1 < 64) ar[q] = A4[(i + 1) * 16 + q]; }
            if (i >= 1 && (i & 3) == 0 && i + 1 < 64) ar[i >> 2] = A4[(i + 1) * 16 + (i >> 2)];
            const float sx = x2[i >> 1][i & 1] - ((acc0[0] + acc0[1]) + (acc1[0] + acc1[1]));
            x2[i >> 1][i & 1] = sx; src[i * 129] = sx;
        }
    }
    LDS_BARRIER();
    if (stop == 6) return;
    { GAS bf16_t* OPS = WSG(bf16_t, O_GW) + (size_t)chunk * (56 * 512);
#pragma unroll 1
      for (int q = c.tid; q < 1024; q += NTHR) { const int f = q >> 6, ln = q & 63, lr = ln & 15, g = ln >> 4, ct = f >> 2, ks = f & 3; const LAS float* wr = KS + (16 * ct + lr + 3) * 129 + 32 * ks + 4 * g;
          u32x4 o; o.x = pk2(wr[0], wr[1]); o.y = pk2(wr[2], wr[3]); o.z = pk2(wr[16], wr[17]); o.w = pk2(wr[18], wr[19]);
          *(GAS u32x4*)(OPS + (size_t)q * 8) = o; }
      GAS float* UF = WSG(float, O_GU) + (size_t)chunk * 8192;
#pragma unroll 1
      for (int q = c.tid; q < 2048; q += NTHR) { const int es = q >> 8, ct = (q >> 6) & 3, ln = q & 63, lr = ln & 15, g = ln >> 4; const LAS float* ur = VS + (16 * ct + 4 * g + 3) * 129 + 16 * es + lr;
          *(GAS f32x4*)(UF + (size_t)q * 4) = (f32x4){ur[0], ur[129], ur[258], ur[387]}; } }
    LDS_BARRIER();
}

__device__ __forceinline__ void gdn_scan_wave(const Ctx& c, int bh, int es) {
    const int lane = c.lane; const unsigned l16 = (unsigned)lane * 16u;
    const char* ops = (const char*)(WSG(bf16_t, O_GW)) + (size_t)bh * 64 * 57344;
    const char* uf = (const char*)(WSG(float, O_GU)) + (size_t)bh * 64 * 32768 + es * 4096;
    char* sv = (char*)c.ws + O_MF + ((size_t)bh * 64 * 8 + es) * 6144;
    const GAS float* GL = WSG(float, O_GL) + bh * 64;
    LAS unsigned char* lds = c.lds;
#define GS_ISSUE(n_, buf_) do { const char* so_ = ops + (size_t)(n_) * 57344; const char* su_ = uf + (size_t)(n_) * 32768; LAS unsigned char* d_ = lds + (buf_) * 36864; \
        _Pragma("unroll") for (int f_ = 0; f_ < 16; ++f_) __builtin_amdgcn_global_load_lds((const unsigned*)(so_ + f_ * 1024 + l16), (LAS unsigned*)(d_ + f_ * 1024), 16, 0, 0); \
        _Pragma("unroll") for (int f_ = 0; f_ < 16; ++f_) __builtin_amdgcn_global_load_lds((const unsigned*)(so_ + (40 + f_) * 1024 + l16), (LAS unsigned*)(d_ + 16384 + f_ * 1024), 16, 0, 0); \
        _Pragma("unroll") for (int f_ = 0; f_ < 4; ++f_) __builtin_amdgcn_global_load_lds((const unsigned*)(su_ + f_ * 1024 + l16), (LAS unsigned*)(d_ + 32768 + f_ * 1024), 16, 0, 0); } while (0)
#define GS_FRAG(f_) (*(const LAS bf16x8*)(B + (f_) * 1024 + lane * 16))
    f32x4 S[8];
#pragma unroll
    for (int d = 0; d < 8; ++d) S[d] = (f32x4){0.f, 0.f, 0.f, 0.f};
    const float glv = GL[lane];
    asm volatile("s_waitcnt vmcnt(0)" ::: "memory");
    GS_ISSUE(0, 0);
#pragma unroll 1
    for (int n = 0; n < NCH; ++n) {
        const int buf = n & 1;
        if (n + 1 < NCH) { GS_ISSUE(n + 1, buf ^ 1); asm volatile("s_waitcnt vmcnt(36)" ::: "memory"); } else asm volatile("s_waitcnt vmcnt(0)" ::: "memory");
        const LAS unsigned char* B = lds + buf * 36864;
        GAS u32x4* svn = (GAS u32x4*)(sv + (size_t)n * 49152 + l16);
        f32x4 vn[4], acc[4]; bf16x8 Sb[4], vnb[2];
#pragma unroll
        for (int ct = 0; ct < 4; ++ct) { vn[ct] = *(const LAS f32x4*)(B + 32768 + ct * 1024 + lane * 16); acc[ct] = (f32x4){0.f, 0.f, 0.f, 0.f}; }
#pragma unroll
        for (int ks = 0; ks < 4; ++ks) { u32x4 w; w.x = pk2(S[2 * ks][0], S[2 * ks][1]); w.y = pk2(S[2 * ks][2], S[2 * ks][3]); w.z = pk2(S[2 * ks + 1][0], S[2 * ks + 1][1]); w.w = pk2(S[2 * ks + 1][2], S[2 * ks + 1][3]); Sb[ks] = __builtin_bit_cast(bf16x8, w); svn[ks * 64] = w; }
#pragma unroll
        for (int ks = 0; ks < 4; ++ks)
#pragma unroll
            for (int ct = 0; ct < 4; ++ct) acc[ct] = __builtin_amdgcn_mfma_f32_16x16x32_bf16(GS_FRAG(ct * 4 + ks), Sb[ks], acc[ct], 0, 0, 0);
#pragma unroll
        for (int ct = 0; ct < 4; ++ct) vn[ct] = vn[ct] - acc[ct];
#pragma unroll
        for (int k2 = 0; k2 < 2; ++k2) { u32x4 w; w.x = pk2(vn[2 * k2][0], vn[2 * k2][1]); w.y = pk2(vn[2 * k2][2], vn[2 * k2][3]); w.z = pk2(vn[2 * k2 + 1][0], vn[2 * k2 + 1][1]); w.w = pk2(vn[2 * k2 + 1][2], vn[2 * k2 + 1][3]); vnb[k2] = __builtin_bit_cast(bf16x8, w); svn[(4 + k2) * 64] = w; }
        const float gl = __builtin_bit_cast(float, __builtin_amdgcn_readlane(__builtin_bit_cast(int, glv), n));
#pragma unroll
        for (int d = 0; d < 8; ++d) S[d] = S[d] * gl;
#pragma unroll
        for (int k2 = 0; k2 < 2; ++k2)
#pragma unroll
            for (int d = 0; d < 8; ++d) S[d] = __builtin_amdgcn_mfma_f32_16x16x32_bf16(GS_FRAG(16 + d * 2 + k2), vnb[k2], S[d], 0, 0, 0);
    }
#undef GS_ISSUE
#undef GS_FRAG
}
__device__ __forceinline__ void gdn_out_phase(const Ctx& c, int l) {
    const int lane = c.lane, lr = lane & 15, g = lane >> 4, ts = c.wave >> 1, hf = c.wave & 1;
    const GAS bf16_t* P = WSG(bf16_t, O_PROJ); GAS bf16_t* YA = WSG(bf16_t, O_YA);
    LAS unsigned char* R = c.lds + ts * 24576;
    LAS float* SSQ = (LAS float*)(c.lds + 4 * 24576) + ts * 128;
    for (int tbase = 0; tbase < NB * 4 * NCH; tbase += c.G * 4) {
        const int task = tbase + c.wg + c.G * ts; const bool on = task < NB * 4 * NCH;
        const int bh = task >> 6, n = task & 63, b = bh >> 2, h = bh & 3, t0 = b * SEQ + n * CH;
        const char* ops = (const char*)(WSG(bf16_t, O_GW)) + (size_t)task * 57344 + lane * 16;
        const char* sv = (const char*)c.ws + O_MF + (size_t)task * 49152 + lane * 16;
        LDS_BARRIER();
        if (on) {
#pragma unroll
            for (int f = 0; f < 12; ++f) __builtin_amdgcn_global_load_lds((const unsigned*)(ops + (16 + 12 * hf + f) * 1024), (LAS unsigned*)(R + (12 * hf + f) * 1024), 16, 0, 0); }
        asm volatile("s_waitcnt vmcnt(0)" ::: "memory"); LDS_BARRIER();
        f32x4 o[4][4];
        if (on) {
#pragma unroll
            for (int e4 = 0; e4 < 4; ++e4) { const int es = 4 * hf + e4; bf16x8 sb[6];
#pragma unroll
                for (int f = 0; f < 6; ++f) sb[f] = *(const GAS bf16x8*)(sv + (es * 6 + f) * 1024);
#pragma unroll
                for (int ct = 0; ct < 4; ++ct) { f32x4 a = {0.f, 0.f, 0.f, 0.f};
#pragma unroll
                    for (int ks = 0; ks < 4; ++ks) a = __builtin_amdgcn_mfma_f32_16x16x32_bf16(*(const LAS bf16x8*)(R + (ct * 4 + ks) * 1024 + lane * 16), sb[ks], a, 0, 0, 0);
#pragma unroll
                    for (int k2 = 0; k2 < 2; ++k2) a = __builtin_amdgcn_mfma_f32_16x16x32_bf16(*(const LAS bf16x8*)(R + (16 + ct * 2 + k2) * 1024 + lane * 16), sb[4 + k2], a, 0, 0, 0);
                    o[e4][ct] = a; } }
#pragma unroll
            for (int ct = 0; ct < 4; ++ct)
#pragma unroll
                for (int r = 0; r < 4; ++r) { float ss = 0.f;
#pragma unroll
                    for (int e4 = 0; e4 < 4; ++e4) ss += o[e4][ct][r] * o[e4][ct][r];
                    ss = row16_sum(ss); if (lr == 0) SSQ[hf * 64 + 16 * ct + 4 * g + r] = ss; }
        }
        LDS_BARRIER();
        if (on) {
            LAS bf16_t* OT = (LAS bf16_t*)R;
#pragma unroll
            for (int ct = 0; ct < 4; ++ct)
#pragma unroll
                for (int r = 0; r < 4; ++r) { const int row = 16 * ct + 4 * g + r; const float rs = rsqrtf((SSQ[row] + SSQ[64 + row]) * (1.f / 128.f) + EPS);
#pragma unroll
                    for (int e4 = 0; e4 < 4; ++e4) OT[row * 136 + 16 * (4 * hf + e4) + lr] = (bf16_t)f2bf(o[e4][ct][r] * rs); }
        }
        LDS_BARRIER();
        if (on) {
            const LAS bf16_t* OT = (const LAS bf16_t*)R;
#pragma unroll
            for (int k = 0; k < 8; ++k) { const int ch = lane + 64 * k, row = 32 * hf + (ch >> 4), ec = (ch & 15) * 8; const size_t t = (size_t)(t0 + row);
                f32x4 x0, x1, z0, z1; unpk8(*(const LAS u32x4*)(OT + row * 136 + ec), x0, x1); unpk8(*(const GAS u32x4*)(P + t * NP + C_GZ + h * 128 + ec), z0, z1);
                const f32x4 w0 = *(const GAS f32x4*)(ING(9) + l * 128 + ec), w1 = *(const GAS f32x4*)(ING(9) + l * 128 + ec + 4);
#pragma unroll
                for (int i = 0; i < 4; ++i) { x0[i] = x0[i] * w0[i] * siluf_(z0[i]); x1[i] = x1[i] * w1[i] * siluf_(z1[i]); }
                *(GAS u32x4*)(YA + t * 512 + h * 128 + ec) = pk8(x0, x1); }
        }
    }
    LDS_BARRIER();
}

__device__ __forceinline__ void gdn_scan_unit(const Ctx& c, int unit) {
    const int es = unit & 3, h = (unit >> 2) & 3, b = unit >> 4;
    LAS float* SST = (LAS float*)c.lds;
    LAS bf16_t* WL = (LAS bf16_t*)(c.lds + 16896); LAS bf16_t* QDL = WL + 8192; LAS bf16_t* KDL = QDL + 8192; LAS bf16_t* QKL = KDL + 8192;
    LAS float* VN = (LAS float*)(c.lds + 16896 + 3 * 16384 + 8192);
    for (int i = c.tid; i < 128 * 33; i += NTHR) SST[i] = 0.f;
    const GAS bf16_t* W = WSG(bf16_t, O_GW); const GAS bf16_t* QD = WSG(bf16_t, O_GQD); const GAS bf16_t* KD = WSG(bf16_t, O_GKD); const GAS bf16_t* QK = WSG(bf16_t, O_GQK);
    const GAS float* U = WSG(float, O_GU); GAS float* GO = WSG(float, O_GO); const GAS float* GL = WSG(float, O_GL) + (b * 4 + h) * 64;
    const int e = c.tid & 31, cc = c.tid >> 5;
    for (int n = 0; n < NCH; ++n) {
        const int t0 = b * SEQ + n * CH;
        __syncthreads();
#pragma unroll
        for (int k = 0; k < 2; ++k) { const int p = c.tid + k * NTHR, r = p >> 4, q = p & 15; const size_t go = (size_t)(t0 + r) * 512 + h * 128 + q * 8;
            *(LAS u32x4*)(WL + r * 128 + q * 8) = *(const GAS u32x4*)(W + go); *(LAS u32x4*)(QDL + r * 128 + q * 8) = *(const GAS u32x4*)(QD + go); *(LAS u32x4*)(KDL + r * 128 + q * 8) = *(const GAS u32x4*)(KD + go); }
        { const int r = c.tid >> 3, q = c.tid & 7; *(LAS u32x4*)(QKL + r * 64 + q * 8) = *(const GAS u32x4*)(QK + ((size_t)(t0 + r) * 4 + h) * 64 + q * 8); }
        __syncthreads();
#pragma unroll 1
        for (int r = 0; r < 4; ++r) { const int ci = cc + 16 * r; float a = U[(size_t)(t0 + ci) * 512 + h * 128 + es * 32 + e];
            const LAS unsigned* wr = (const LAS unsigned*)(WL + ci * 128);
#pragma unroll 8
            for (int d2 = 0; d2 < 64; ++d2) { const unsigned w2 = wr[d2]; a -= lo16(w2) * SST[(2 * d2) * 33 + e] + hi16(w2) * SST[(2 * d2 + 1) * 33 + e]; }
            VN[ci * 33 + e] = a; }
        __syncthreads();
#pragma unroll 1
        for (int r = 0; r < 4; ++r) { const int ci = cc + 16 * r; float a = 0.f;
            const LAS unsigned* qr = (const LAS unsigned*)(QDL + ci * 128);
#pragma unroll 8
            for (int d2 = 0; d2 < 64; ++d2) { const unsigned w2 = qr[d2]; a += lo16(w2) * SST[(2 * d2) * 33 + e] + hi16(w2) * SST[(2 * d2 + 1) * 33 + e]; }
            const LAS unsigned* kr = (const LAS unsigned*)(QKL + ci * 64);
#pragma unroll 8
            for (int j2 = 0; j2 < 32; ++j2) { const unsigned w2 = kr[j2]; a += lo16(w2) * VN[(2 * j2) * 33 + e] + hi16(w2) * VN[(2 * j2 + 1) * 33 + e]; }
            GO[(size_t)(t0 + ci) * 512 + h * 128 + es * 32 + e] = a; }
        const float gl = GL[n]; float sn[8];
#pragma unroll
        for (int r = 0; r < 8; ++r) { const int dk = cc + 16 * r; float a = SST[dk * 33 + e] * gl;
#pragma unroll 8
            for (int ci = 0; ci < 64; ++ci) a += bf2f(KDL[ci * 128 + dk]) * VN[ci * 33 + e];
            sn[r] = a; }
        __syncthreads();
#pragma unroll
        for (int r = 0; r < 8; ++r) SST[(cc + 16 * r) * 33 + e] = sn[r];
    }
    __syncthreads();
}
__device__ __forceinline__ void gdn_finish_phase(const Ctx& c, int l) {
    const GAS float* GO = WSG(float, O_GO); const GAS bf16_t* P = WSG(bf16_t, O_PROJ); GAS bf16_t* YA = WSG(bf16_t, O_YA);
    const float nw0 = ING(9)[l * 128 + c.lane], nw1 = ING(9)[l * 128 + 64 + c.lane];
    for (int t = c.gw; t < T; t += c.NGW) {
#pragma unroll
        for (int h = 0; h < 4; ++h) { const float o0 = GO[(size_t)t * 512 + h * 128 + c.lane], o1 = GO[(size_t)t * 512 + h * 128 + 64 + c.lane];
            const float r = rsqrtf(wave_sum(o0 * o0 + o1 * o1) * (1.f / 128.f) + EPS);
            const float z0 = bf2f(P[(size_t)t * NP + C_GZ + h * 128 + c.lane]), z1 = bf2f(P[(size_t)t * NP + C_GZ + h * 128 + 64 + c.lane]);
            YA[(size_t)t * 512 + h * 128 + c.lane] = (bf16_t)f2bf(o0 * r * nw0 * siluf_(z0)); YA[(size_t)t * 512 + h * 128 + 64 + c.lane] = (bf16_t)f2bf(o1 * r * nw1 * siluf_(z1)); }
    }
}
__device__ __forceinline__ void ssd_prep_unit(const Ctx& c, int l, int unit) {
    const int grp = unit & 1, n = (unit >> 1) & 63, b = unit >> 7;
    const int t0 = b * SEQ + n * CH;
    LAS bf16_t* XT = (LAS bf16_t*)c.lds; LAS bf16_t* XTS = XT + 256 * 72; LAS bf16_t* BT = XTS + 256 * 72;
    LAS bf16_t* Bm = BT + 128 * 72; LAS bf16_t* Cm = Bm + 64 * 136;
    LAS float* DT = (LAS float*)(Cm + 64 * 136); LAS float* ACS = DT + 256; LAS float* SCV = ACS + 256;
    const GAS bf16_t* P = WSG(bf16_t, O_PROJ);
    if (c.wave < 4) { const int hq = c.wave, hh = grp * 4 + hq, t = c.lane;
        const float dt = softplusf_(WSG(float, O_SMALLF)[(size_t)(t0 + t) * 16 + 8 + hh] + ING(13)[l * 8 + hh]);
        float a = -expf(ING(12)[l * 8 + hh]) * dt;
#pragma unroll
        for (int o = 1; o < 64; o <<= 1) { const float up = __shfl_up(a, o); if (t >= o) a += up; }
        const float alast = __shfl(a, 63);
        DT[hq * 64 + t] = dt; ACS[hq * 64 + t] = a; SCV[hq * 64 + t] = dt * expf(alast - a); const float ea = expf(a); WSG(float, O_EA)[(size_t)(t0 + t) * 8 + hh] = ea;
        if (t == 63) WSG(float, O_DEC)[(b * 8 + hh) * 64 + n] = ea; }
    LDS_BARRIER();
    { const int ch = c.tid < 256 ? grp * 256 + c.tid : c.tid < 384 ? 512 + grp * 128 + (c.tid - 256) : 768 + grp * 128 + (c.tid - 384);
      const GAS float* cw = ING(10) + (size_t)l * 4 * 1024 + ch; const float w0 = cw[0], w1 = cw[1024], w2 = cw[2048], w3 = cw[3072], bias = ING(11)[l * 1024 + ch];
      const GAS bf16_t* src = P + (size_t)(t0 - 3) * NP + C_XBC + ch;
      unsigned short raw[67];
#pragma unroll
      for (int r = 0; r < 67; ++r) raw[r] = (n > 0 || r >= 3) ? src[(size_t)r * NP] : (unsigned short)0;
      const int hq = c.tid >> 6;
#pragma unroll
      for (int t8 = 0; t8 < 8; ++t8) { float y[8];
#pragma unroll
          for (int k = 0; k < 8; ++k) { const int t = t8 * 8 + k; y[k] = siluf_(w0 * bf2f(raw[t]) + w1 * bf2f(raw[t + 1]) + w2 * bf2f(raw[t + 2]) + w3 * bf2f(raw[t + 3]) + bias); }
          u32x4 o; o.x = pk2(y[0], y[1]); o.y = pk2(y[2], y[3]); o.z = pk2(y[4], y[5]); o.w = pk2(y[6], y[7]);
          if (c.tid < 256) { *(LAS u32x4*)(XT + c.tid * 72 + t8 * 8) = o; const LAS float* sv = SCV + hq * 64 + t8 * 8;
              u32x4 q; q.x = pk2(y[0] * sv[0], y[1] * sv[1]); q.y = pk2(y[2] * sv[2], y[3] * sv[3]); q.z = pk2(y[4] * sv[4], y[5] * sv[5]); q.w = pk2(y[6] * sv[6], y[7] * sv[7]);
              *(LAS u32x4*)(XTS + c.tid * 72 + t8 * 8) = q; }
          else if (c.tid < 384) { const int nn = c.tid - 256; *(LAS u32x4*)(BT + nn * 72 + t8 * 8) = o;
#pragma unroll
              for (int k = 0; k < 8; ++k) Bm[(t8 * 8 + k) * 136 + nn] = (bf16_t)f2bf(y[k]); }
          else { const int nn = c.tid - 384; GAS bf16_t* CC = WSG(bf16_t, O_SCC) + (size_t)t0 * 256 + grp * 128 + nn;
#pragma unroll
              for (int k = 0; k < 8; ++k) { const bf16_t v = (bf16_t)f2bf(y[k]); Cm[(t8 * 8 + k) * 136 + nn] = v; CC[(size_t)(t8 * 8 + k) * 256] = v; } } } }
    LDS_BARRIER();
    const int lr = c.lane & 15, g = c.lane >> 4;
    { const int tl = c.wave & 3, hp = c.wave >> 2, lcol = 16 * tl + lr;
      f32x4 cb[4];
#pragma unroll
      for (int ts = 0; ts < 4; ++ts) { cb[ts] = (f32x4){0.f, 0.f, 0.f, 0.f};
          if (ts <= tl) {
#pragma unroll
              for (int ks = 0; ks < 4; ++ks) cb[ts] = __builtin_amdgcn_mfma_f32_16x16x32_bf16(*(const LAS bf16x8*)(Bm + (16 * ts + lr) * 136 + 32 * ks + 8 * g), *(const LAS bf16x8*)(Cm + lcol * 136 + 32 * ks + 8 * g), cb[ts], 0, 0, 0); } }
#pragma unroll 1
      for (int hq = 2 * hp; hq < 2 * hp + 2; ++hq) { const int hh = grp * 4 + hq; const float dsk = ING(14)[l * 8 + hh], al = ACS[hq * 64 + lcol];
          f32x4 mt[4];
#pragma unroll
          for (int ts = 0; ts < 4; ++ts)
#pragma unroll
              for (int r = 0; r < 4; ++r) { const int sx = 16 * ts + 4 * g + r; float v = 0.f; if (sx <= lcol) v = cb[ts][r] * __expf(al - ACS[hq * 64 + sx]) * DT[hq * 64 + sx]; if (sx == lcol) v += dsk; mt[ts][r] = v; }
          bf16x8 mb[2];
#pragma unroll
          for (int k2 = 0; k2 < 2; ++k2) { u32x4 w; w.x = pk2(mt[2 * k2][0], mt[2 * k2][1]); w.y = pk2(mt[2 * k2][2], mt[2 * k2][3]); w.z = pk2(mt[2 * k2 + 1][0], mt[2 * k2 + 1][1]); w.w = pk2(mt[2 * k2 + 1][2], mt[2 * k2 + 1][3]); mb[k2] = __builtin_bit_cast(bf16x8, w); }
          GAS float* YP = WSG(float, O_SYP) + (size_t)(t0 + lcol) * 512 + hh * 64 + 4 * g;
#pragma unroll
          for (int tp = 0; tp < 4; ++tp) { f32x4 acc = {0.f, 0.f, 0.f, 0.f};
#pragma unroll
              for (int k2 = 0; k2 < 2; ++k2) { const LAS bf16_t* xp = XT + (hq * 64 + 16 * tp + lr) * 72 + 32 * k2 + 4 * g; const u32x2 lo = *(const LAS u32x2*)xp, hi = *(const LAS u32x2*)(xp + 16);
                  u32x4 w; w.x = lo.x; w.y = lo.y; w.z = hi.x; w.w = hi.y; acc = __builtin_amdgcn_mfma_f32_16x16x32_bf16(__builtin_bit_cast(bf16x8, w), mb[k2], acc, 0, 0, 0); }
              *(GAS f32x4*)(YP + 16 * tp) = acc; } } }
    { const int hq = c.wave >> 1, hh = grp * 4 + hq; GAS float* ST = WSG(float, O_SST) + ((size_t)((b * 8 + hh) * 64 + n)) * 8192;
#pragma unroll 1
      for (int tq = 0; tq < 4; ++tq) { const int tn = 4 * (c.wave & 1) + tq;
          const bf16x8 a0 = *(const LAS bf16x8*)(BT + (16 * tn + lr) * 72 + 8 * g), a1 = *(const LAS bf16x8*)(BT + (16 * tn + lr) * 72 + 32 + 8 * g);
#pragma unroll
          for (int tp = 0; tp < 4; ++tp) { f32x4 acc = {0.f, 0.f, 0.f, 0.f}; const LAS bf16_t* xp = XTS + (hq * 64 + 16 * tp + lr) * 72 + 8 * g;
              acc = __builtin_amdgcn_mfma_f32_16x16x32_bf16(a0, *(const LAS bf16x8*)xp, acc, 0, 0, 0); acc = __builtin_amdgcn_mfma_f32_16x16x32_bf16(a1, *(const LAS bf16x8*)(xp + 32), acc, 0, 0, 0);
              *(GAS f32x4*)(ST + (size_t)(16 * tp + lr) * 128 + 16 * tn + 4 * g) = acc; } } }
    LDS_BARRIER();
}
__device__ __forceinline__ void ssd_scan_phase(const Ctx& c) {
    GAS float* ST = WSG(float, O_SST); const GAS float* DEC = WSG(float, O_DEC);
    const int nthr = 128 * 448, me = c.wg * 448 + (c.tid - 64);
    for (int idx = me; idx < NB * 8 * 8192; idx += nthr) {
        const int bh = idx >> 13, el = idx & 8191; GAS float* p = ST + (size_t)bh * 64 * 8192 + el; const GAS float* dc = DEC + bh * 64;
        float hcur = 0.f;
        { float s[64];
#pragma unroll
            for (int k = 0; k < 64; ++k) s[k] = p[(size_t)k * 8192];
#pragma unroll
            for (int k = 0; k < 64; ++k) { p[(size_t)k * 8192] = hcur; hcur = hcur * dc[k] + s[k]; } }
    }
}
__device__ __forceinline__ void ssd_finish_unit(const Ctx& c, int l, int unit) {
    const int grp = unit & 1, n = (unit >> 1) & 63, b = unit >> 7;
    const int t0 = b * SEQ + n * CH;
    LAS float* YS = (LAS float*)c.lds;
    const GAS bf16_t* CC = WSG(bf16_t, O_SCC); const GAS float* EA = WSG(float, O_EA); const GAS float* YP = WSG(float, O_SYP);
    const int lr = c.lane & 15, g = c.lane >> 4;
    { const int hq = c.wave >> 1, hh = grp * 4 + hq; const GAS float* ST = WSG(float, O_SST) + ((size_t)((b * 8 + hh) * 64 + n)) * 8192;
      f32x4 acc[4][2];
#pragma unroll
      for (int tp = 0; tp < 4; ++tp) { acc[tp][0] = (f32x4){0.f, 0.f, 0.f, 0.f}; acc[tp][1] = (f32x4){0.f, 0.f, 0.f, 0.f}; }
#pragma unroll
      for (int ks = 0; ks < 4; ++ks) { bf16x8 cf[2];
#pragma unroll
          for (int q = 0; q < 2; ++q) cf[q] = *(const GAS bf16x8*)(CC + (size_t)(t0 + 16 * (2 * (c.wave & 1) + q) + lr) * 256 + grp * 128 + 32 * ks + 8 * g);
#pragma unroll
          for (int tp = 0; tp < 4; ++tp) { const GAS float* pp = ST + (size_t)(16 * tp + lr) * 128 + 32 * ks + 8 * g; const f32x4 p0 = *(const GAS f32x4*)pp, p1 = *(const GAS f32x4*)(pp + 4);
              const bf16x8 pf = __builtin_bit_cast(bf16x8, pk8(p0, p1));
              acc[tp][0] = __builtin_amdgcn_mfma_f32_16x16x32_bf16(pf, cf[0], acc[tp][0], 0, 0, 0); acc[tp][1] = __builtin_amdgcn_mfma_f32_16x16x32_bf16(pf, cf[1], acc[tp][1], 0, 0, 0); } }
#pragma unroll
      for (int q = 0; q < 2; ++q) { const int li = 16 * (2 * (c.wave & 1) + q) + lr; const float ea = EA[(size_t)(t0 + li) * 8 + hh];
#pragma unroll
          for (int tp = 0; tp < 4; ++tp) { const f32x4 yp = *(const GAS f32x4*)(YP + (size_t)(t0 + li) * 512 + hh * 64 + 16 * tp + 4 * g); const f32x4 y = yp + acc[tp][q] * ea;
              LAS float* d = YS + li * 260 + hq * 64 + 16 * tp + 4 * g; d[0] = y[0]; d[1] = y[1]; d[2] = y[2]; d[3] = y[3]; } } }
    LDS_BARRIER();
    const GAS bf16_t* P = WSG(bf16_t, O_PROJ); GAS bf16_t* YB = WSG(bf16_t, O_YB); const GAS float* nw = ING(15) + l * 512 + grp * 256;
    for (int li = c.wave; li < 64; li += NWAVES) { const int t = t0 + li; float y[4]; float ss = 0.f;
#pragma unroll
        for (int q = 0; q < 4; ++q) { const int ch = c.lane + 64 * q; const float z = bf2f(P[(size_t)t * NP + C_SZ + grp * 256 + ch]); y[q] = YS[li * 260 + ch] * siluf_(z); ss += y[q] * y[q]; }
        const float r = rsqrtf(wave_sum(ss) * (1.f / 256.f) + EPS);
#pragma unroll
        for (int q = 0; q < 4; ++q) { const int ch = c.lane + 64 * q; YB[(size_t)t * 512 + grp * 256 + ch] = (bf16_t)f2bf(y[q] * r * nw[ch]); } }
    LDS_BARRIER();
}

__device__ __forceinline__ void mla_rows_phase(const Ctx& c) {
    const GAS bf16_t* P = WSG(bf16_t, O_PROJ); const GAS float* ROPE = WSG(float, O_ROPE); GAS bf16_t* KR = WSG(bf16_t, O_KR);
    for (int t = c.gw; t < T; t += c.NGW) {
        const GAS bf16_t* pr = P + (size_t)t * NP;
        const u32x4 a = *(const GAS u32x4*)(pr + C_CQ + 8 * c.lane); const u32x2 k2 = *(const GAS u32x2*)(pr + C_CKV + 4 * c.lane);
        f32x4 a0, a1; unpk8(a, a0, a1);
        float sq = (a0[0] * a0[0] + a0[1] * a0[1]) + (a0[2] * a0[2] + a0[3] * a0[3]) + (a1[0] * a1[0] + a1[1] * a1[1]) + (a1[2] * a1[2] + a1[3] * a1[3]);
        const float k0 = lo16(k2.x), k1 = hi16(k2.x), k2f = lo16(k2.y), k3 = hi16(k2.y); float sk = (k0 * k0 + k1 * k1) + (k2f * k2f + k3 * k3);
        sq = wave_sum(sq); sk = wave_sum(sk);
        const float x = bf2f(pr[C_KR + c.lane]); const float xo = __shfl_xor(x, 32);
        if (c.lane == 0) { WSG(float, O_RQ)[t] = rsqrtf(sq * (1.f / 512.f) + EPS); WSG(float, O_RKV)[t] = rsqrtf(sk * (1.f / 256.f) + EPS); }
        if (c.lane < 32) { const float cs = ROPE[((size_t)t * 32 + c.lane) * 2], sn = ROPE[((size_t)t * 32 + c.lane) * 2 + 1];
            *(GAS unsigned*)(KR + (size_t)t * 64 + 2 * c.lane) = pk2(x * cs - xo * sn, xo * cs + x * sn); }
    }
}
__device__ __forceinline__ float xmax16(float v) { const auto r = __builtin_amdgcn_permlane16_swap(__float_as_uint(v), __float_as_uint(v), false, false); return fmaxf(__uint_as_float(r[0]), __uint_as_float(r[1])); }
__device__ __forceinline__ float xmax32(float v) { const auto r = __builtin_amdgcn_permlane32_swap(__float_as_uint(v), __float_as_uint(v), false, false); return fmaxf(__uint_as_float(r[0]), __uint_as_float(r[1])); }
__device__ __forceinline__ float xsum16(float v) { const auto r = __builtin_amdgcn_permlane16_swap(__float_as_uint(v), __float_as_uint(v), false, false); return __uint_as_float(r[0]) + __uint_as_float(r[1]); }
__device__ __forceinline__ float xsum32(float v) { const auto r = __builtin_amdgcn_permlane32_swap(__float_as_uint(v), __float_as_uint(v), false, false); return __uint_as_float(r[0]) + __uint_as_float(r[1]); }
__device__ __forceinline__ void attn_item(const Ctx& c, int item) {
    const int bh = item >> 4, qi = item & 15, b = bh >> 2, h = bh & 3;
    const GAS bf16_t* Q = WSG(bf16_t, O_Q); const GAS bf16_t* KN = WSG(bf16_t, O_KN); const GAS bf16_t* KR = WSG(bf16_t, O_KR); const GAS bf16_t* VT = WSG(bf16_t, O_VT); GAS bf16_t* YC = WSG(bf16_t, O_YC);
    const int lr = c.lane & 15, g = c.lane >> 4, sw = lr >> 1, swk = 2 * (lr >> 2) + ((lr >> 1) & 1), keyl = 8 * (lr >> 2) + (lr & 3);
    constexpr int KT_BYTES = 64 * 384, BUF_BYTES = KT_BYTES + 128 * 128;
    const char* kp[3]; int kstr[3]; const char* vp[2];
#pragma unroll
    for (int i = 0; i < 3; ++i) { const int ch = (3 * c.wave + i) * 64 + c.lane, key = ch / 24, pq = ch % 24, part = pq ^ (2 * ((key >> 3) & 3) + ((key >> 1) & 1)); const size_t tk = (size_t)(b * SEQ + key);
        if (part < 16) { kp[i] = (const char*)(KN + tk * 512 + h * 128 + part * 8); kstr[i] = 1024; } else { kp[i] = (const char*)(KR + tk * 64 + (part - 16) * 8); kstr[i] = 128; } }
#pragma unroll
    for (int i = 0; i < 2; ++i) { const int ch = (2 * c.wave + i) * 64 + c.lane, dv = ch >> 3, q8 = (ch & 7) ^ ((dv >> 1) & 7); vp[i] = (const char*)(VT + (size_t)(h * 128 + dv) * T + b * SEQ + q8 * 8); }
#define AT_DMA(kb_, buf_) do { LAS unsigned char* d_ = c.lds + (buf_) * BUF_BYTES; \
        _Pragma("unroll") for (int i_ = 0; i_ < 3; ++i_) __builtin_amdgcn_global_load_lds((const unsigned*)(kp[i_] + (size_t)(kb_) * kstr[i_]), (LAS unsigned*)(d_ + (3 * c.wave + i_) * 1024), 16, 0, 0); \
        _Pragma("unroll") for (int i_ = 0; i_ < 2; ++i_) __builtin_amdgcn_global_load_lds((const unsigned*)(vp[i_] + (size_t)(kb_) * 2), (LAS unsigned*)(d_ + KT_BYTES + (2 * c.wave + i_) * 1024), 16, 0, 0); } while (0)
    int koff[6], voff[2];
#pragma unroll
    for (int ks = 0; ks < 6; ++ks) koff[ks] = keyl * 384 + (((4 * ks + g) ^ swk) * 16);
#pragma unroll
    for (int pp = 0; pp < 2; ++pp) voff[pp] = lr * 128 + (((4 * pp + g) ^ sw) * 16);
#define AT_QK(dst_, buf_) do { const LAS unsigned char* Kt_ = c.lds + (buf_) * BUF_BYTES; \
        _Pragma("unroll") for (int a_ = 0; a_ < 4; ++a_) { dst_[a_] = (f32x4){0.f, 0.f, 0.f, 0.f}; \
            _Pragma("unroll") for (int ks_ = 0; ks_ < 6; ++ks_) dst_[a_] = __builtin_amdgcn_mfma_f32_16x16x32_bf16(*(const LAS bf16x8*)(Kt_ + ((a_ >> 1) * 32 + (a_ & 1) * 4) * 384 + koff[ks_]), qf[ks_], dst_[a_], 0, 0, 0); } } while (0)
#pragma unroll 1
    for (int half = 0; half < 2; ++half) {
        const int qb = half ? 31 - qi : qi; const int q0 = qb * 128 + c.wave * 16; const int tq = b * SEQ + q0 + lr;
        bf16x8 qf[6];
#pragma unroll
        for (int ks = 0; ks < 6; ++ks) qf[ks] = *(const GAS bf16x8*)(Q + (size_t)tq * 768 + h * 192 + 32 * ks + 8 * g);
        f32x4 o[8];
#pragma unroll
        for (int d = 0; d < 8; ++d) o[d] = (f32x4){0.f, 0.f, 0.f, 0.f};
        float mrow = -3.0e38f, lsum = 0.f;
        const int nkt = 2 * qb + 2;
        asm volatile("s_waitcnt vmcnt(0)" ::: "memory");
        LDS_BARRIER();
        AT_DMA(0, 0); AT_DMA(64, 1);
        asm volatile("s_waitcnt vmcnt(0)" ::: "memory"); LDS_BARRIER();
        f32x4 s[4], sn[4];
        AT_QK(s, 0);
#pragma unroll 1
        for (int kt = 0; kt < nkt; ++kt) {
            const int kbase = kt * 64; const int b0 = kt % 3, b1 = (kt + 1) % 3, b2 = (kt + 2) % 3;
            if (kt + 2 < nkt) AT_DMA(kbase + 128, b2);
            const bool act = kbase <= q0 + 15, actn = (kt + 1 < nkt) && (kbase + 64 <= q0 + 15);
            if (actn) AT_QK(sn, b1);
            if (act) {
                const LAS unsigned char* Vt = c.lds + b0 * BUF_BYTES + KT_BYTES;
                const int qpos = q0 + lr; float mx = -3.0e38f;
                if (kbase + 63 > q0) {
#pragma unroll
                    for (int a = 0; a < 4; ++a)
#pragma unroll
                        for (int r = 0; r < 4; ++r) { const int key = kbase + 32 * (a >> 1) + 8 * g + 4 * (a & 1) + r; if (key > qpos) s[a][r] = -3.0e38f; } }
#pragma unroll
                for (int a = 0; a < 4; ++a)
#pragma unroll
                    for (int r = 0; r < 4; ++r) mx = fmaxf(mx, s[a][r]);
                mx = xmax32(xmax16(mx));
                if (!__all(mx - mrow <= 8.f)) {
                    const float mnew = fmaxf(mrow, mx), alpha = __builtin_amdgcn_exp2f(mrow - mnew); mrow = mnew; lsum *= alpha;
#pragma unroll
                    for (int d = 0; d < 8; ++d) o[d] = o[d] * alpha; }
                float ps = 0.f;
#pragma unroll
                for (int a = 0; a < 4; ++a)
#pragma unroll
                    for (int r = 0; r < 4; ++r) { const float p = __builtin_amdgcn_exp2f(s[a][r] - mrow); s[a][r] = p; ps += p; }
                lsum += ps;
#pragma unroll
                for (int pp = 0; pp < 2; ++pp) { u32x4 pw; pw.x = pk2(s[2 * pp][0], s[2 * pp][1]); pw.y = pk2(s[2 * pp][2], s[2 * pp][3]); pw.z = pk2(s[2 * pp + 1][0], s[2 * pp + 1][1]); pw.w = pk2(s[2 * pp + 1][2], s[2 * pp + 1][3]);
                    const bf16x8 pf = __builtin_bit_cast(bf16x8, pw);
#pragma unroll
                    for (int d = 0; d < 8; ++d) o[d] = __builtin_amdgcn_mfma_f32_16x16x32_bf16(*(const LAS bf16x8*)(Vt + d * 2048 + voff[pp]), pf, o[d], 0, 0, 0); }
            }
            asm volatile("s_waitcnt vmcnt(0)" ::: "memory");
            LDS_BARRIER();
#pragma unroll
            for (int a = 0; a < 4; ++a) s[a] = sn[a];
        }
        lsum = xsum32(xsum16(lsum));
        const float inv = 1.f / lsum;
#pragma unroll
        for (int d = 0; d < 8; ++d) { u32x2 w; w.x = pk2(o[d][0] * inv, o[d][1] * inv); w.y = pk2(o[d][2] * inv, o[d][3] * inv);
            *(GAS u32x2*)(YC + (size_t)tq * 512 + h * 128 + 16 * d + 4 * g) = w; }
    }
#undef AT_DMA
#undef AT_QK
}
struct FProj { bf16_t* P; float* sf;
    __device__ __forceinline__ void oct(const pg8::Unit&, int row, int col, f32x4 v0, f32x4 v1) const {
        *(u32x4*)(P + (size_t)row * NP + col) = pk8(v0, v1);
        if (col >= C_SMALL && col < C_SMALL + 16) { float* d = sf + (size_t)row * 16 + (col - C_SMALL); *(f32x4*)d = v0; *(f32x4*)(d + 4) = v1; } } };
struct FQ { bf16_t* Q; const float* rq; const float* rope;
    __device__ __forceinline__ void oct(const pg8::Unit&, int row, int col, f32x4 v0, f32x4 v1) const {
        const float r = rq[row] * (0.07216878364870322f * 1.4426950408889634f); v0 = v0 * r; v1 = v1 * r;
        const int j = col % 192;
        if (j >= 128) { const float* cs = rope + ((size_t)row * 32 + ((j - 128) >> 1)) * 2; const f32x4 c0 = *(const f32x4*)cs, c1 = *(const f32x4*)(cs + 4);
            const f32x4 a = v0, bq = v1;
            v0[0] = a[0] * c0[0] - a[1] * c0[1]; v0[1] = a[1] * c0[0] + a[0] * c0[1]; v0[2] = a[2] * c0[2] - a[3] * c0[3]; v0[3] = a[3] * c0[2] + a[2] * c0[3];
            v1[0] = bq[0] * c1[0] - bq[1] * c1[1]; v1[1] = bq[1] * c1[0] + bq[0] * c1[1]; v1[2] = bq[2] * c1[2] - bq[3] * c1[3]; v1[3] = bq[3] * c1[2] + bq[2] * c1[3]; }
        *(u32x4*)(Q + (size_t)row * 768 + col) = pk8(v0, v1); } };
struct FKN { bf16_t* KN; const float* rkv;
    __device__ __forceinline__ void oct(const pg8::Unit&, int row, int col, f32x4 v0, f32x4 v1) const { const float r = rkv[row]; *(u32x4*)(KN + (size_t)row * 512 + col) = pk8(v0 * r, v1 * r); } };
struct FVT { bf16_t* VT; const float* rkv;
    __device__ __forceinline__ void oct(const pg8::Unit&, int row, int col, f32x4 v0, f32x4 v1) const { const f32x4 r0 = *(const f32x4*)(rkv + col), r1 = *(const f32x4*)(rkv + col + 4); *(u32x4*)(VT + (size_t)row * T + col) = pk8(v0 * r0, v1 * r1); } };
struct FMergeAll { const bf16_t* P; bf16_t* MB;
    __device__ __forceinline__ void oct(const pg8::Unit& u, int row, int col, f32x4 v0, f32x4 v1) const {
        f32x4 g0, g1; unpk8(*(const u32x4*)(P + (size_t)row * NP + C_GATE + u.kb * 1024 + col), g0, g1);
#pragma unroll
        for (int i = 0; i < 4; ++i) { v0[i] *= sigmoidf_(g0[i]); v1[i] *= sigmoidf_(g1[i]); }
        bf16_t* m = MB + (size_t)row * D + col;
        if (u.kb > 0) { f32x4 p0, p1; unpk8(*(const u32x4*)m, p0, p1); v0 = v0 + p0; v1 = v1 + p1; }
        *(u32x4*)m = pk8(v0, v1); } };
struct FRes { float* X; const float* Xs; const float* gate;
    __device__ __forceinline__ void oct(const pg8::Unit&, int row, int col, f32x4 v0, f32x4 v1) const {
        const float* g = gate + (size_t)(row >> 12) * 6144 + col; float* x = X + (size_t)row * D + col; const float* xs = Xs + (size_t)row * D + col;
        *(f32x4*)x = *(const f32x4*)xs + *(const f32x4*)g * v0; *(f32x4*)(x + 4) = *(const f32x4*)(xs + 4) + *(const f32x4*)(g + 4) * v1; } };
struct FGU { bf16_t* Hd; int ld;
    __device__ __forceinline__ void gu(const pg8::Unit&, int row, int fcol, f32x4 g0, f32x4 g1, f32x4 u0, f32x4 u1) const {
#pragma unroll
        for (int i = 0; i < 4; ++i) { g0[i] = siluf_(g0[i]) * u0[i]; g1[i] = siluf_(g1[i]) * u1[i]; }
        *(u32x4*)(Hd + (size_t)row * ld + fcol) = pk8(g0, g1); } };
struct FYT { float* YT; int row0;
    __device__ __forceinline__ void oct(const pg8::Unit& u, int row, int col, f32x4 v0, f32x4 v1) const { float* d = YT + (size_t)u.kb * (8 * 256 * 1024) + (size_t)(row - row0) * D + col;
        *(f32x4*)d = v0; *(f32x4*)(d + 4) = v1; } };
struct FY { bf16_t* Y;
    __device__ __forceinline__ void oct(const pg8::Unit&, int row, int col, f32x4 v0, f32x4 v1) const { *(u32x4*)(Y + (size_t)row * D + col) = pk8(v0, v1); } };

template <int SITE, class F, class Sched> __device__ __forceinline__ void run_gemm_oct(const Ctx& c, const pg8::Gemm& g, const Sched& S, const F& f) {
    if constexpr ((FASTMASK >> SITE) & 1u) { pg8::EpiOct<F> E{f}; pg8::gemm_phase<pg8::EpiOct<F>, Sched, true>(c.lds, g, S, E); }
    else pg8::gemm_simple_oct(g, S, f);
}
template <int SITE, class F, class Sched> __device__ __forceinline__ void run_gemm_gu(const Ctx& c, const pg8::Gemm& g, const Sched& S, const F& f) {
    if constexpr ((FASTMASK >> SITE) & 1u) { pg8::EpiGU<F> E{f}; pg8::gemm_phase<pg8::EpiGU<F>, Sched, true>(c.lds, g, S, E); }
    else pg8::gemm_simple_gu(g, S, f);
}

#ifndef PHMASK
#define PHMASK 0xFFFFFFFFu
#endif
#define ON(k) (((PHMASK) >> (k)) & 1u)
#ifndef REPMASK
#define REPMASK 0u
#endif
#define NREP(k) ((((REPMASK) >> (k)) & 1u) ? 2 : 1)
template <class P> __device__ __forceinline__ P* launder_ptr(P* p) {
    unsigned long long v = (unsigned long long)p; unsigned lo = (unsigned)v, hi = (unsigned)(v >> 32);
    asm volatile("" : "+v"(lo), "+v"(hi));
    lo = __builtin_amdgcn_readfirstlane(lo); hi = __builtin_amdgcn_readfirstlane(hi);
    return (P*)(((unsigned long long)hi << 32) | lo);
}
__device__ __forceinline__ LAS unsigned char* launder_lds(LAS unsigned char* p) { unsigned v = (unsigned)(uintptr_t)p; asm volatile("" : "+v"(v)); v = __builtin_amdgcn_readfirstlane(v); return (LAS unsigned char*)(uintptr_t)v; }
typedef const float* const __attribute__((address_space(4)))* kargp_t;
__device__ __forceinline__ kargp_t launder_kptr(kargp_t p) { unsigned long long v = (unsigned long long)p; unsigned lo = (unsigned)v, hi = (unsigned)(v >> 32);
    asm volatile("" : "+v"(lo), "+v"(hi)); lo = __builtin_amdgcn_readfirstlane(lo); hi = __builtin_amdgcn_readfirstlane(hi); return (kargp_t)(((unsigned long long)hi << 32) | lo); }
struct Args { const float* in[33]; float* out; unsigned char* ws; int ph_lo, ph_hi; };
constexpr int N_PHASES = 1 + NL * 10 + 2 + 1;

#define PHASE_BEGIN if (pc >= lo && pc < hi) { { int t_ = threadIdx.x; asm volatile("" : "+v"(t_) :: "memory"); c.tid = t_; c.lane = t_ & 63; c.wave = __builtin_amdgcn_readfirstlane(t_ >> 6); { unsigned g_ = gridDim.x, w_ = blockIdx.x; asm volatile("" : "+v"(g_), "+v"(w_)); c.G = __builtin_amdgcn_readfirstlane(g_); c.wg = __builtin_amdgcn_readfirstlane(w_); } c.gw = c.wg * NWAVES + c.wave; c.NGW = c.G * NWAVES; c.lds = launder_lds(c.lds); c.ws = launder_ptr(c.ws); c.in = launder_kptr(c.in); c.X = launder_ptr(c.X); }
#ifdef PROBE_BAR2
#define PHASE_END   if (pc + 1 < hi) { XcdBarrier b2_ = bar; b2_.bar = launder_ptr(bar.bar); xcd_barrier(b2_); xcd_barrier(b2_); } } ++pc;
#else
#define PHASE_END   if (pc + 1 < hi) { XcdBarrier b2_ = bar; b2_.bar = launder_ptr(bar.bar); xcd_barrier(b2_); } } ++pc;
#endif
template <int L> __device__ __forceinline__ void layer_body(Ctx& c, const int lo, const int hi, int& pc, const XcdBarrier& bar) {
        constexpr int l = L; constexpr bool moe = (L & 1) != 0; constexpr int fi = L >> 1;
        const float* MODL = WSP(float, O_MOD) + (size_t)l * 4 * 6144;
        PHASE_BEGIN if constexpr (ON(1)) { if (NREP(16) > 1) norm_phase(c, l, 0, -1, l == 0 ? c.in[0] : nullptr); norm_phase(c, l, 0, (l > 0 && ((l - 1) & 1)) ? l - 1 : -1, l == 0 ? c.in[0] : nullptr); } PHASE_END
        PHASE_BEGIN if constexpr (ON(2)) { pg8::Gemm g{WSP(bf16_t, O_H), WSP(bf16_t, O_WIN) + (size_t)l * NP * 1024, 1024, 1024, 1024}; pg8::StaticOrder S; S.init(T / 256, NP / 256, c.G, c.wg);
            for (int rep_ = 0; rep_ < NREP(27); ++rep_) run_gemm_oct<0>(c, g, S, FProj{WSP(bf16_t, O_PROJ), WSP(float, O_SMALLF)}); } PHASE_END
        PHASE_BEGIN
#ifdef GDNPREP_STOP
            for (int u = c.wg; u < NB * NCH * 4; u += c.G) gdn_prep_unit(c, l, u, GDNPREP_STOP);
#endif
            for (int rep_ = 0; rep_ < NREP(24); ++rep_) for (int u = c.wg; u < NB * NCH * 4; u += c.G) gdn_prep_unit(c, l, u);
            for (int rep_ = 0; rep_ < NREP(25); ++rep_) for (int u = c.wg; u < NB * NCH * 2; u += c.G) ssd_prep_unit(c, l, u);
            if constexpr (ON(3)) mla_rows_phase(c);
        PHASE_END
        PHASE_BEGIN
            if (c.wg < 128) {
                if (c.wave == 0) { for (int rep_ = 0; rep_ < NREP(20); ++rep_) gdn_scan_wave(c, (c.wg & 7) * 2 + (c.wg >> 6), (c.wg >> 3) & 7); }
                else { ssd_scan_phase(c);
                    { LAS float* scr = (LAS float*)(c.lds + 73728 + (c.wave - 1) * 8448); const int rank = c.wg * 7 + (c.wave - 1), count = 896 + (c.G - 128) * 8;
                      for (int r2_ = 0; r2_ < NREP(15); ++r2_) { if (moe) moe_convert_queue(c, l, scr); next_layer_convert_queue(c, l, scr); } } }
            } else {
                const int G2 = c.G - 128, w2 = c.wg - 128;
                for (int rep_ = 0; rep_ < NREP(18); ++rep_) {
                { pg8::Gemm g{WSP(bf16_t, O_PROJ) + C_CQ, WSP(bf16_t, O_WUQ) + (size_t)l * 768 * 512, 512, NP, 512}; pg8::StaticOrder S; S.init(T / 256, 3, G2, w2);
                  run_gemm_oct<1>(c, g, S, FQ{WSP(bf16_t, O_Q), WSP(float, O_RQ), WSP(float, O_ROPE)}); }
                { pg8::Gemm g{WSP(bf16_t, O_PROJ) + C_CKV, WSP(bf16_t, O_WUK) + (size_t)l * 512 * 256, 256, NP, 256}; pg8::StaticOrder S; S.init(T / 256, 2, G2, w2);
                  run_gemm_oct<2>(c, g, S, FKN{WSP(bf16_t, O_KN), WSP(float, O_RKV)}); }
                { pg8::Gemm g{WSP(bf16_t, O_WUV) + (size_t)l * 512 * 256, WSP(bf16_t, O_PROJ) + C_CKV, 256, 256, NP}; pg8::StaticOrder S; S.init(2, T / 256, G2, w2);
                  run_gemm_oct<3>(c, g, S, FVT{WSP(bf16_t, O_VT), WSP(float, O_RKV)}); } }
                { LAS float* scr = (LAS float*)(c.lds + c.wave * 8448); const int rank = 896 + w2 * 8 + c.wave, count = 896 + G2 * 8;
                  for (int r2_ = 0; r2_ < NREP(15); ++r2_) { if (moe) moe_convert_queue(c, l, scr); next_layer_convert_queue(c, l, scr); } }
            }
        PHASE_END
        PHASE_BEGIN
            for (int rep_ = 0; rep_ < NREP(21); ++rep_) for (int it = c.wg; it < 256; it += c.G) attn_item(c, (it & 7) * 32 + (it >> 3));
            for (int rep_ = 0; rep_ < NREP(22); ++rep_) gdn_out_phase(c, l);
            for (int rep_ = 0; rep_ < NREP(23); ++rep_) for (int u = c.wg; u < NB * NCH * 2; u += c.G) ssd_finish_unit(c, l, u);
        PHASE_END
        PHASE_BEGIN for (int rep_ = 0; rep_ < NREP(19); ++rep_) { pg8::BranchOrder S; S.base.init(T / 256, 4, c.G, c.wg); S.nbr = 3; S.astride = (long)(O_YB - O_YA) / 2; S.bstride = (long)1024 * 512;
            pg8::Gemm g{WSP(bf16_t, O_YA), WSP(bf16_t, O_WBR) + (size_t)l * 3 * 1024 * 512, 512, 512, 512};
            run_gemm_oct<4>(c, g, S, FMergeAll{WSP(bf16_t, O_PROJ), WSP(bf16_t, O_MB)}); } PHASE_END
        PHASE_BEGIN if constexpr (ON(7)) { pg8::Gemm g{WSP(bf16_t, O_MB), WSP(bf16_t, O_WOUT) + (size_t)l * 1024 * 1024, 1024, 1024, 1024}; pg8::StaticOrder S; S.init(T / 256, 4, c.G, c.wg);
            if (NREP(17) > 1) run_gemm_oct<7>(c, g, S, FRes{WSP(float, O_MF), l == 0 ? c.in[0] : c.X, MODL + 2048}); run_gemm_oct<7>(c, g, S, FRes{c.X, l == 0 ? c.in[0] : c.X, MODL + 2048}); } PHASE_END
        PHASE_BEGIN if constexpr (ON(8)) { for (int rep_ = 0; rep_ < NREP(16); ++rep_) { if (moe) norm2_moe_phase(c, l); else norm_phase(c, l, 1, -1); } } PHASE_END
        if (moe) { PHASE_BEGIN for (int rep_ = 0; rep_ < NREP(28); ++rep_) moe_assign_phase(c, l); PHASE_END }
        PHASE_BEGIN if constexpr (ON(10)) {
            if (!moe) { pg8::Gemm g{WSP(bf16_t, O_H), WSP(bf16_t, O_WGU) + (size_t)fi * 2 * FF * 1024, 1024, 1024, 1024}; pg8::StaticOrder S; S.init(T / 256, 2 * FF / 256, c.G, c.wg);
                for (int rep_ = 0; rep_ < NREP(29); ++rep_) run_gemm_gu<8>(c, g, S, FGU{WSP(bf16_t, O_PROJ), FF}); }
            else { pg8::Gemm g{WSP(bf16_t, O_XS), WSP(bf16_t, O_WEGU), 1024, 1024, 1024}; pg8::MoeOrder S{WSP(int, O_BLKE), *WSP(int, O_NBLK), 2 * EF / 256, c.G, c.wg, (long)2 * EF * 1024};
                for (int rep_ = 0; rep_ < NREP(30); ++rep_) run_gemm_gu<10>(c, g, S, FGU{WSP(bf16_t, O_PROJ), EF}); }
        } PHASE_END
        PHASE_BEGIN if constexpr (ON(11)) {
            if (!moe) { pg8::Gemm g{WSP(bf16_t, O_PROJ), WSP(bf16_t, O_WDN) + (size_t)fi * 1024 * FF, FF, FF, FF}; pg8::StaticOrder S; S.init(T / 256, 4, c.G, c.wg);
                if (NREP(17) > 1) run_gemm_oct<9>(c, g, S, FRes{WSP(float, O_MF), c.X, MODL + 5120}); run_gemm_oct<9>(c, g, S, FRes{c.X, c.X, MODL + 5120}); }
            else { const int nblk = *WSP(int, O_NBLK), nmainb = WSP(int, O_NBLK)[1];
                { pg8::Gemm g{WSP(bf16_t, O_PROJ), WSP(bf16_t, O_WEDN), EF, EF, EF}; pg8::MoeOrder S{WSP(int, O_BLKE), nmainb, 4, c.G, c.wg, (long)1024 * EF};
                  for (int rep_ = 0; rep_ < NREP(31); ++rep_) run_gemm_oct<11>(c, g, S, FY{WSP(bf16_t, O_YS)}); }
                { pg8::Gemm g{WSP(bf16_t, O_PROJ), WSP(bf16_t, O_WEDN), 512, EF, EF}; pg8::MoeTailOrder S{WSP(int, O_BLKE), nmainb, nblk - nmainb, 7, 512, c.G, c.wg, (long)1024 * EF};
                  run_gemm_oct<12>(c, g, S, FYT{WSP(float, O_MF), nmainb * 256}); } }
        } PHASE_END
    }

__global__ void __launch_bounds__(NTHR, 2) mk_fwd(Args args) {
    extern __shared__ __attribute__((aligned(16))) unsigned char lds_raw[];
    Ctx c;
    c.lds = (LAS unsigned char*)lds_raw;
    c.tid = threadIdx.x; c.lane = c.tid & 63; c.wave = __builtin_amdgcn_readfirstlane(c.tid >> 6);
    c.G = gridDim.x; c.wg = blockIdx.x; c.gw = c.wg * NWAVES + c.wave; c.NGW = c.G * NWAVES;
    c.in = (const float* const __attribute__((address_space(4)))*)__builtin_amdgcn_kernarg_segment_ptr(); c.X = args.out; c.ws = args.ws;
    volatile LAS unsigned* MISC = (volatile LAS unsigned*)(c.lds + LDSCTL_OFF);
    for (int u = c.tid; u < 128; u += NTHR) MISC[u] = 0u;
    __syncthreads();
    const int lo = args.ph_lo, hi = args.ph_hi;
    XcdBarrier bar; bar.bar = (unsigned*)(c.ws + O_CTL) + 1024 + (size_t)(lo & 63) * XCD_BAR_WORDS; bar.x = 0; bar.st = MISC + 8;
    if (hi - lo > 1) bar = xcd_barrier_post(bar.bar, MISC + 8);
    int pc = 0;

    PHASE_BEGIN for (int rep_ = 0; rep_ < NREP(26); ++rep_) p0_prologue(c); PHASE_END

    layer_body<0>(c, lo, hi, pc, bar); layer_body<1>(c, lo, hi, pc, bar); layer_body<2>(c, lo, hi, pc, bar); layer_body<3>(c, lo, hi, pc, bar);
    PHASE_BEGIN if constexpr (ON(12)) final_phase(c, NL - 1); PHASE_END
#undef PHASE_BEGIN
#undef PHASE_END
}

extern "C" void kernel_launch(void* const* d_in, const int* in_sizes, int n_in, void* d_out, int out_size, void* d_ws, size_t ws_size, hipStream_t stream) {
    static int grid = 0;
    if (grid == 0) {
        if (n_in != 33 || out_size != T * D || ws_size < WS_END) { fprintf(stderr, "kernel_launch: unexpected shapes (n_in %d out %d ws %zu need %zu)\n", n_in, out_size, ws_size, (size_t)WS_END); grid = -1; return; }
        int dev = 0, cus = 0, per_cu = 0;
        if (hipGetDevice(&dev) != hipSuccess || hipDeviceGetAttribute(&cus, hipDeviceAttributeMultiprocessorCount, dev) != hipSuccess) { grid = -1; return; }
        if (hipFuncSetAttribute((const void*)mk_fwd, hipFuncAttributeMaxDynamicSharedMemorySize, LDS_BYTES) != hipSuccess) { fprintf(stderr, "kernel_launch: hipFuncSetAttribute failed\n"); grid = -1; return; }
        if (hipOccupancyMaxActiveBlocksPerMultiprocessor(&per_cu, (const void*)mk_fwd, NTHR, LDS_BYTES) != hipSuccess || per_cu < 1) fprintf(stderr, "kernel_launch: occupancy query reports %d\n", per_cu);
        (void)hipGetLastError();
        grid = cus < 256 ? cus : 256;
        while (T % grid) --grid;
    }
    if (grid < 0) return;
    (void)hipMemsetAsync((char*)d_ws + O_CTL, 0, CTL_BYTES, stream);
    Args a{};
    for (int i = 0; i < 33; ++i) a.in[i] = (const float*)d_in[i];
    a.out = (float*)d_out; a.ws = (unsigned char*)d_ws;
#if N_LAUNCH_MODE == 1
    a.ph_lo = 0; a.ph_hi = N_PHASES;
    hipLaunchKernelGGL(mk_fwd, dim3(grid), dim3(NTHR), LDS_BYTES, stream, a);
#else
    for (int p = 0; p < N_PHASES; ++p) { a.ph_lo = p; a.ph_hi = p + 1; hipLaunchKernelGGL(mk_fwd, dim3(grid), dim3(NTHR), LDS_BYTES, stream, a); }
#endif
}
```

```cpp
#include <hip/hip_runtime.h>
#include <cstdio>
#include <cstdint>

#define GAS __attribute__((address_space(1)))
#define LAS __attribute__((address_space(3)))
typedef unsigned short bf16_t;
typedef short bf16x8 __attribute__((ext_vector_type(8)));
typedef short bf16x4 __attribute__((ext_vector_type(4)));
typedef float f32x4 __attribute__((ext_vector_type(4)));
typedef float f32x2 __attribute__((ext_vector_type(2)));
typedef unsigned u32x4 __attribute__((ext_vector_type(4)));
typedef unsigned u32x2 __attribute__((ext_vector_type(2)));

#ifndef FASTMASK
#define FASTMASK 0xFFFFFFFFu
#endif
#ifndef N_LAUNCH_MODE
#define N_LAUNCH_MODE 1
#endif

constexpr int T = 16384, D = 1024, NB = 4, SEQ = 4096, NL = 4, NCH = 64, CH = 64;
constexpr int NP = 7680;
constexpr int C_QKV = 0, C_GZ = 1536, C_SZ = 2048, C_XBC = 2560, C_CQ = 3584, C_CKV = 4096, C_KR = 4352, C_SMALL = 4416, C_GATE = 4608;
constexpr int FF = 2816, EF = 3584, NE = 8, NSLOT = 34560  ;
constexpr float EPS = 1e-6f;
constexpr int NWAVES = 8, NTHR = 512;

constexpr size_t MiB = 1u << 20;
constexpr size_t O_CTL = 0, CTL_BYTES = 1 * MiB;
constexpr size_t O_MOD = 1 * MiB;
constexpr size_t O_ROPE = 2 * MiB;
constexpr size_t O_RQ = 6 * MiB, O_RKV = O_RQ + 65536;
constexpr size_t O_SMALLF = 7 * MiB;
constexpr size_t O_TOPE = 8 * MiB, O_TOPW = O_TOPE + 65536, O_WGCNT = O_TOPW + 131072, O_TOKSLOT = O_WGCNT + 8192, O_BLKE = O_TOKSLOT + 131072, O_NBLK = O_BLKE + 1024;
constexpr size_t O_GL = 9 * MiB, O_DEC = O_GL + 4096, O_EA = O_DEC + 8192;
constexpr size_t O_WIN = 10 * MiB, O_WUQ = 70 * MiB, O_WUK = 73 * MiB, O_WUV = 74 * MiB, O_WBR = 75 * MiB, O_WOUT = 87 * MiB, O_WGU = 95 * MiB, O_WDN = 117 * MiB,
                 O_WEGU = 128 * MiB, O_WEDN = 240 * MiB;
constexpr size_t O_H = 296 * MiB;
constexpr size_t O_PROJ = 328 * MiB;
constexpr size_t O_KR = 568 * MiB, O_Q = 570 * MiB, O_KN = 594 * MiB, O_VT = 610 * MiB;
constexpr size_t O_YA = 626 * MiB, O_YB = 642 * MiB, O_YC = 658 * MiB;
constexpr size_t O_GU = 674 * MiB, O_GW = 706 * MiB, O_GQD = 722 * MiB, O_GKD = 738 * MiB, O_GQK = 754 * MiB, O_GO = 762 * MiB;
constexpr size_t O_YS = O_GU;
constexpr size_t O_SYP = 794 * MiB, O_SST = 826 * MiB, O_SCC = 890 * MiB;
constexpr size_t O_XS = O_SYP;
constexpr size_t O_MF = 898 * MiB, O_MB = 962 * MiB, WS_END = 994 * MiB;
static_assert((size_t)NSLOT * EF * 2 <= 240 * MiB && (size_t)NSLOT * 1024 * 2 <= 96 * MiB, "overlays");

constexpr int SCR_BYTES = 159744;
constexpr int LDSCTL_OFF = SCR_BYTES, LDS_BYTES = SCR_BYTES + 512;

#define LDS_WAIT() asm volatile("s_waitcnt lgkmcnt(0)" ::: "memory")
#define VM_WAIT() asm volatile("s_waitcnt vmcnt(0)" ::: "memory")
#define LDS_BARRIER() do { asm volatile("s_waitcnt lgkmcnt(0)" ::: "memory"); __builtin_amdgcn_s_barrier(); asm volatile("" ::: "memory"); } while (0)

__device__ __forceinline__ float bf2f(unsigned b) { return __uint_as_float(b << 16); }
__device__ __forceinline__ unsigned f2bf(float f) { unsigned r; asm("v_cvt_pk_bf16_f32 %0, %1, %1" : "=v"(r) : "v"(f)); return r & 0xffffu; }
__device__ __forceinline__ unsigned pk2(float lo, float hi) { unsigned r; asm("v_cvt_pk_bf16_f32 %0, %1, %2" : "=v"(r) : "v"(lo), "v"(hi)); return r; }
__device__ __forceinline__ float lo16(unsigned w) { return __uint_as_float(w << 16); }
__device__ __forceinline__ float hi16(unsigned w) { return __uint_as_float(w & 0xffff0000u); }
__device__ __forceinline__ u32x4 pk8(f32x4 a, f32x4 b) { u32x4 w; w.x = pk2(a[0], a[1]); w.y = pk2(a[2], a[3]); w.z = pk2(b[0], b[1]); w.w = pk2(b[2], b[3]); return w; }
__device__ __forceinline__ void unpk8(u32x4 w, f32x4& a, f32x4& b) { a = (f32x4){lo16(w.x), hi16(w.x), lo16(w.y), hi16(w.y)}; b = (f32x4){lo16(w.z), hi16(w.z), lo16(w.w), hi16(w.w)}; }
__device__ __forceinline__ float sigmoidf_(float x) { return __builtin_amdgcn_rcpf(1.f + __builtin_amdgcn_exp2f(x * -1.4426950408889634f)); }
__device__ __forceinline__ float siluf_(float x) { return x * __builtin_amdgcn_rcpf(1.f + __builtin_amdgcn_exp2f(x * -1.4426950408889634f)); }
__device__ __forceinline__ float softplusf_(float x) { return x > 20.f ? x : log1pf(expf(x)); }
#define DPP_ADD(v_, ctrl_) ((v_) + __builtin_bit_cast(float, __builtin_amdgcn_update_dpp(0, __builtin_bit_cast(int, (v_)), (ctrl_), 0xF, 0xF, true)))
__device__ __forceinline__ float row16_sum(float v) {
    v = DPP_ADD(v, 0xB1); v = DPP_ADD(v, 0x4E); v = DPP_ADD(v, 0x141); v = DPP_ADD(v, 0x140); return v;
}
__device__ __forceinline__ float wave_sum(float v) {
    v = row16_sum(v);
    { const auto r = __builtin_amdgcn_permlane16_swap(__float_as_uint(v), __float_as_uint(v), false, false); v = __uint_as_float(r[0]) + __uint_as_float(r[1]); }
    { const auto r = __builtin_amdgcn_permlane32_swap(__float_as_uint(v), __float_as_uint(v), false, false); v = __uint_as_float(r[0]) + __uint_as_float(r[1]); }
    return v;
}
namespace pg8 {
constexpr int BM = 256, BK = 64, HALF = 128, HTB = HALF * BK * 2, STAGE_BYTES = 8 * HTB, NXCD = 8, WGM = 8;
__host__ __device__ __forceinline__ int lds_byte(int r, int c) { const int st = (r >> 4) * 2 + (c >> 5), rr = r & 15, cc = c & 31, ob = rr * 64 + cc * 2; return st * 1024 + (ob ^ (((ob >> 9) & 1) << 5)); }
__host__ __device__ __forceinline__ void stage_rc(int b, int& R, int& C) { const int st = b / 1024, sb = b % 1024, swz = sb ^ (((sb >> 9) & 1) << 5); R = (st >> 1) * 16 + swz / 64; C = (st & 1) * 32 + (swz % 64) / 2; }
__host__ __device__ __forceinline__ int perm32(int rho) { const int n = rho >> 4, i = rho & 15; return 8 * (i >> 2) + 4 * n + (i & 3); }

struct Unit { int pm, pn; long boff, aoff; int kb; };
struct Gemm { const bf16_t* A; const bf16_t* Bt; int K, lda, ldb; };

struct StaticOrder {
    int nM, nN, nwg, G, c;
    __device__ void init(int nM_, int nN_, int G_, int c_) { nM = nM_; nN = nN_; nwg = nM * nN; G = G_; c = c_; }
    __device__ bool next(int i, Unit& u) const {
        const long L = (long)i * G + c; if (L >= nwg) return false;
        int wgid = (int)L; { const int q = nwg / NXCD, r = nwg % NXCD, xcd = wgid % NXCD, off = wgid / NXCD; wgid = (xcd < r ? xcd * (q + 1) : r * (q + 1) + (xcd - r) * q) + off; }
        const int nig = WGM * nN, gid = wgid / nig, fm = gid * WGM, gsz = (nM - fm) < WGM ? (nM - fm) : WGM;
        u.pm = fm + ((wgid % nig) % gsz); u.pn = (wgid % nig) / gsz; u.boff = 0; u.aoff = 0; u.kb = 0; return true;
    }
};
struct MoeOrder {
    const int* blke; int nblk, nN, G, c; long estride;
    __device__ bool next(int i, Unit& u) const {
        const long L = (long)i * G + c; if (L >= (long)nblk * nN) return false;
        const int j = (int)(L / nN); u.pm = j; u.pn = (int)(L % nN); u.boff = (long)blke[j] * estride; u.aoff = 0; u.kb = 0; return true;
    }
};

struct MoeTailOrder {
    const int* blke; int j0, ntail, nks, kslice, G, c; long estride;
    __device__ bool next(int i, Unit& u) const {
        const int L = i * G + c; if (L >= ntail * 4 * nks) return false;
        const int ks = L % nks, t = L / nks; u.pm = j0 + (t >> 2); u.pn = t & 3; u.kb = ks; u.aoff = (long)ks * kslice; u.boff = (long)blke[u.pm] * estride + (long)ks * kslice; return true;
    }
};
struct BranchOrder {
    StaticOrder base; int nbr; long astride, bstride;
    __device__ bool next(int i, Unit& u) const { const int rd = i / nbr, br = i - rd * nbr; if (!base.next(rd, u)) return false; u.kb = br; u.aoff = (long)br * astride; u.boff = (long)br * bstride; return true; }
};

template <class Epi, class Sched, bool ALIGN_EPI>
__device__ __forceinline__ void gemm_phase(LAS unsigned char* lds, const Gemm g, const Sched& S, const Epi& E) {
    int tid_ = threadIdx.x; asm volatile("" : "+v"(tid_) :: "memory");
    const int tid = tid_, wid = __builtin_amdgcn_readfirstlane(tid >> 6), lane = tid & 63, wr = wid >> 2, wc = wid & 3, fr = lane & 15, fq = lane >> 4;
    const int K = g.K, nt = K / BK;
    unsigned voffA[2], voffB[2];
#pragma unroll
    for (int i = 0; i < 2; ++i) { int R, C; stage_rc(tid * 16 + i * 8192, R, C); const int Rb = Epi::PERM ? ((R & ~31) + perm32(R & 31)) : R;
        voffA[i] = (unsigned)(R * g.lda + C) * 2u; voffB[i] = (unsigned)(Rb * g.ldb + C) * 2u; }
    const size_t kstep = (size_t)(BK * 2);
    const size_t hstepA = (size_t)HALF * g.lda * 2, hstepB = (size_t)HALF * g.ldb * 2;
    const size_t tstepA = 2 * hstepA, tstepB = 2 * hstepB;
    const unsigned ldsw = (unsigned)wid * 1024u;
    const int aoff = lds_byte(wr * 64 + fr, fq * 8), boff = lds_byte(wc * 32 + fr, fq * 8);
#define PG8_SA(b, h) (((b) * 2 + (h)) * HTB)
#define PG8_SB(b, h) ((4 + (b) * 2 + (h)) * HTB)
#define PG8_STAGE(bufoff, gbase, voff) do { _Pragma("unroll") for (int _i = 0; _i < 2; ++_i) \
        __builtin_amdgcn_global_load_lds((const unsigned*)((const char*)(gbase) + (voff)[_i]), (LAS unsigned*)(lds + (bufoff) + ldsw + _i * 8192), 16, 0, 0); } while (0)
#define PG8_LDA(dst, b, h) do { _Pragma("unroll") for (int m = 0; m < 4; ++m) _Pragma("unroll") for (int k = 0; k < 2; ++k) dst[m][k] = *(const LAS bf16x8*)(lds + PG8_SA(b, h) + aoff + m * 2048 + k * 1024); } while (0)
#define PG8_LDB(dst, b, h) do { _Pragma("unroll") for (int n = 0; n < 2; ++n) _Pragma("unroll") for (int k = 0; k < 2; ++k) dst[n][k] = *(const LAS bf16x8*)(lds + PG8_SB(b, h) + boff + n * 2048 + k * 1024); } while (0)
#define PG8_MMA(ai, bj, At, Bt) do { __builtin_amdgcn_s_setprio(1); _Pragma("unroll") for (int m = 0; m < 4; ++m) _Pragma("unroll") for (int n = 0; n < 2; ++n) _Pragma("unroll") for (int k = 0; k < 2; ++k) \
        acc[ai][bj][m][n] = __builtin_amdgcn_mfma_f32_16x16x32_bf16(Bt[n][k], At[m][k], acc[ai][bj][m][n], 0, 0, 0); __builtin_amdgcn_s_setprio(0); } while (0)
#define PG8_WAIT_V(n) asm volatile("s_waitcnt vmcnt(" #n ")" ::: "memory")
#define PG8_WAIT_L(n) asm volatile("s_waitcnt lgkmcnt(" #n ")" ::: "memory")
#define PG8_BAR __builtin_amdgcn_s_barrier()
#define PG8_SCHED __builtin_amdgcn_sched_barrier(0)
    Unit cur, nxt; int ui = 0;
    if (!S.next(0, cur)) return;
    f32x4 acc[2][2][4][2];
#pragma unroll
    for (int a = 0; a < 2; ++a)
#pragma unroll
        for (int b = 0; b < 2; ++b)
#pragma unroll
            for (int m = 0; m < 4; ++m)
#pragma unroll
                for (int n = 0; n < 2; ++n) acc[a][b][m][n] = (f32x4){0.f, 0.f, 0.f, 0.f};
    bf16x8 At[4][2], B0[2][2], B1[2][2];
    const char* cA = (const char*)(g.A + cur.aoff) + (size_t)cur.pm * tstepA; const char* cB = (const char*)(g.Bt + cur.boff) + (size_t)cur.pn * tstepB;
    PG8_STAGE(PG8_SB(0, 0), cB, voffB); PG8_STAGE(PG8_SB(0, 1), cB + hstepB, voffB); PG8_STAGE(PG8_SA(0, 0), cA, voffA); PG8_STAGE(PG8_SA(0, 1), cA + hstepA, voffA);
    if (wr == 1) PG8_BAR;
    PG8_WAIT_V(2); PG8_BAR;
    PG8_STAGE(PG8_SB(1, 0), cB + kstep, voffB); PG8_STAGE(PG8_SA(1, 0), cA + kstep, voffA); PG8_STAGE(PG8_SB(1, 1), cB + hstepB + kstep, voffB);
    PG8_WAIT_V(6); PG8_BAR;
    for (;;) {
        const bool has_next = S.next(ui + 1, nxt);
        const char* nA = has_next ? (const char*)(g.A + nxt.aoff) + (size_t)nxt.pm * tstepA : cA; const char* nB = has_next ? (const char*)(g.Bt + nxt.boff) + (size_t)nxt.pn * tstepB : cB;
        for (int t = 0; t < nt; t += 2) {
            const bool last = (t == nt - 2);
            const char* a1 = cA + (size_t)(t + 1) * kstep;
            const char* a2 = last ? nA : cA + (size_t)(t + 2) * kstep; const char* b2 = last ? nB : cB + (size_t)(t + 2) * kstep;
            const char* a3 = a2 + kstep; const char* b3 = b2 + kstep;
            PG8_LDB(B0, 0, 0); PG8_LDB(B1, 0, 1); PG8_SCHED; PG8_LDA(At, 0, 0); PG8_STAGE(PG8_SA(1, 1), a1 + hstepA, voffA);
            PG8_WAIT_V(8); PG8_WAIT_L(0); PG8_BAR; PG8_MMA(0, 0, At, B0); PG8_MMA(0, 1, At, B1); PG8_BAR; PG8_SCHED;
            PG8_LDA(At, 0, 1); PG8_STAGE(PG8_SB(0, 0), b2, voffB); PG8_STAGE(PG8_SB(0, 1), b2 + hstepB, voffB); PG8_STAGE(PG8_SA(0, 0), a2, voffA);
            PG8_WAIT_V(8); PG8_WAIT_L(0); PG8_BAR; PG8_MMA(1, 0, At, B0); PG8_MMA(1, 1, At, B1); PG8_BAR; PG8_SCHED;
            PG8_LDB(B0, 1, 0); PG8_LDB(B1, 1, 1); PG8_SCHED; PG8_LDA(At, 1, 0); PG8_STAGE(PG8_SA(0, 1), a2 + hstepA, voffA);
            PG8_WAIT_V(8); PG8_WAIT_L(0); PG8_BAR; PG8_MMA(0, 0, At, B0); PG8_MMA(0, 1, At, B1); PG8_BAR; PG8_SCHED;
            PG8_LDA(At, 1, 1); PG8_STAGE(PG8_SB(1, 0), b3, voffB); PG8_STAGE(PG8_SB(1, 1), b3 + hstepB, voffB); PG8_STAGE(PG8_SA(1, 0), a3, voffA);
            PG8_WAIT_V(8); PG8_WAIT_L(0); PG8_BAR; PG8_MMA(1, 0, At, B0); PG8_MMA(1, 1, At, B1); PG8_BAR; PG8_SCHED;
        }
        if constexpr (ALIGN_EPI) { if (wr == 0) PG8_BAR; }
        E(acc, cur, wr, wc, fr, fq);
        if (!has_next) break;
#pragma unroll
        for (int a = 0; a < 2; ++a)
#pragma unroll
            for (int b = 0; b < 2; ++b)
#pragma unroll
                for (int m = 0; m < 4; ++m)
#pragma unroll
                    for (int n = 0; n < 2; ++n) acc[a][b][m][n] = (f32x4){0.f, 0.f, 0.f, 0.f};
        cur = nxt; cA = nA; cB = nB; ++ui;
        if constexpr (ALIGN_EPI) { if (wr == 1) PG8_BAR; }
    }
    PG8_WAIT_V(0);
    if constexpr (!ALIGN_EPI) { if (wr == 0) PG8_BAR; }
    PG8_BAR;
#undef PG8_SA
#undef PG8_SB
#undef PG8_STAGE
#undef PG8_LDA
#undef PG8_LDB
#undef PG8_MMA
#undef PG8_WAIT_V
#undef PG8_WAIT_L
#undef PG8_BAR
#undef PG8_SCHED
}

template <class F> struct EpiOct {
    static constexpr bool PERM = true; F f;
    __device__ __forceinline__ void operator()(const f32x4 (&acc)[2][2][4][2], const Unit& u, int wr, int wc, int fr, int fq) const {
#pragma unroll
        for (int ai = 0; ai < 2; ++ai)
#pragma unroll
            for (int m = 0; m < 4; ++m) { const int row = u.pm * BM + ai * HALF + wr * 64 + m * 16 + fr;
#pragma unroll
                for (int bj = 0; bj < 2; ++bj) f.oct(u, row, u.pn * BM + bj * HALF + wc * 32 + 8 * fq, acc[ai][bj][m][0], acc[ai][bj][m][1]);
                if (m & 1) asm volatile("" ::: "memory"); }
    }
};
template <class F> struct EpiGU {
    static constexpr bool PERM = true; F f;
    __device__ __forceinline__ void operator()(const f32x4 (&acc)[2][2][4][2], const Unit& u, int wr, int wc, int fr, int fq) const {
#pragma unroll
        for (int ai = 0; ai < 2; ++ai)
#pragma unroll
            for (int m = 0; m < 4; ++m) { const int row = u.pm * BM + ai * HALF + wr * 64 + m * 16 + fr;
                f.gu(u, row, u.pn * HALF + wc * 32 + 8 * fq, acc[ai][0][m][0], acc[ai][0][m][1], acc[ai][1][m][0], acc[ai][1][m][1]);
                asm volatile("" ::: "memory"); }
    }
};

__device__ __forceinline__ float dot8(const float (&a)[8], u32x4 b) {
    return a[0] * lo16(b.x) + a[1] * hi16(b.x) + a[2] * lo16(b.y) + a[3] * hi16(b.y) + a[4] * lo16(b.z) + a[5] * hi16(b.z) + a[6] * lo16(b.w) + a[7] * hi16(b.w);
}
template <class F, class Sched>
__device__ __forceinline__ void gemm_simple_oct(const Gemm g, const Sched& S, const F& f) {
    Unit u;
    for (int i = 0; S.next(i, u); ++i) {
        const bf16_t* A = g.A + u.aoff + (size_t)u.pm * BM * g.lda; const bf16_t* B = g.Bt + u.boff + (size_t)u.pn * BM * g.ldb;
        for (int it = threadIdx.x; it < 256 * 32; it += NTHR) {
            const int r = it >> 5, cg = it & 31; float acc[8];
#pragma unroll
            for (int c = 0; c < 8; ++c) acc[c] = 0.f;
            const bf16_t* ar = A + (size_t)r * g.lda; const bf16_t* br = B + (size_t)(cg * 8) * g.ldb;
            for (int k = 0; k < g.K; k += 8) {
                const u32x4 a = *(const u32x4*)(ar + k); float af[8] = {lo16(a.x), hi16(a.x), lo16(a.y), hi16(a.y), lo16(a.z), hi16(a.z), lo16(a.w), hi16(a.w)};
#pragma unroll
                for (int c = 0; c < 8; ++c) acc[c] += dot8(af, *(const u32x4*)(br + (size_t)c * g.ldb + k));
            }
            f.oct(u, u.pm * BM + r, u.pn * BM + cg * 8, (f32x4){acc[0], acc[1], acc[2], acc[3]}, (f32x4){acc[4], acc[5], acc[6], acc[7]});
        }
    }
}
template <class F, class Sched>
__device__ __forceinline__ void gemm_simple_gu(const Gemm g, const Sched& S, const F& f) {
    Unit u;
    for (int i = 0; S.next(i, u); ++i) {
        const bf16_t* A = g.A + u.aoff + (size_t)u.pm * BM * g.lda; const bf16_t* B = g.Bt + u.boff + (size_t)u.pn * BM * g.ldb;
        for (int it = threadIdx.x; it < 256 * 16; it += NTHR) {
            const int r = it >> 4, cg = it & 15; float ag[8], au[8];
#pragma unroll
            for (int c = 0; c < 8; ++c) { ag[c] = 0.f; au[c] = 0.f; }
            const bf16_t* ar = A + (size_t)r * g.lda; const bf16_t* bg = B + (size_t)(cg * 8) * g.ldb; const bf16_t* bu = bg + (size_t)HALF * g.ldb;
            for (int k = 0; k < g.K; k += 8) {
                const u32x4 a = *(const u32x4*)(ar + k); float af[8] = {lo16(a.x), hi16(a.x), lo16(a.y), hi16(a.y), lo16(a.z), hi16(a.z), lo16(a.w), hi16(a.w)};
#pragma unroll
                for (int c = 0; c < 8; ++c) { ag[c] += dot8(af, *(const u32x4*)(bg + (size_t)c * g.ldb + k)); au[c] += dot8(af, *(const u32x4*)(bu + (size_t)c * g.ldb + k)); }
            }
            f.gu(u, u.pm * BM + r, u.pn * HALF + cg * 8, (f32x4){ag[0], ag[1], ag[2], ag[3]}, (f32x4){ag[4], ag[5], ag[6], ag[7]}, (f32x4){au[0], au[1], au[2], au[3]}, (f32x4){au[4], au[5], au[6], au[7]});
        }
    }
}
}
#define XB_TMO      128
#define XB_XCNT(j)  (256  + 64 * (j))
#define XB_XSUB(j)  (1280 + 64 * (j))
#define XB_XGEN(j)  (2304 + 64 * (j))
#define XB_TOP      3328
#define XB_TOPGEN   3392
#define XCD_BAR_WORDS 3456
#define XB_SPIN_CAP (1u << 22)

__device__ __forceinline__ unsigned xb_ld(unsigned* p)              { return __hip_atomic_load(p, __ATOMIC_RELAXED, __HIP_MEMORY_SCOPE_AGENT); }
__device__ __forceinline__ unsigned xb_add(unsigned* p, unsigned v) { return __hip_atomic_fetch_add(p, v, __ATOMIC_RELAXED, __HIP_MEMORY_SCOPE_AGENT); }
__device__ __forceinline__ unsigned xb_xcc_id() { return (unsigned)__builtin_amdgcn_s_getreg((3 << 11) | 20) & 0xFu; }
#define XB_SPIN(cond, bar) do { unsigned _sp = 0; while (cond) { __builtin_amdgcn_s_sleep(1); \
    if ((++_sp & 255u) == 0u) { if (xb_ld(&(bar)[XB_TMO])) break; if (_sp > XB_SPIN_CAP) { atomicAdd(&(bar)[XB_TMO], 1u); break; } } } } while (0)

struct XcdBarrier {
    unsigned* bar; unsigned x;
    volatile LAS unsigned* st;
};

__device__ __forceinline__ XcdBarrier xcd_barrier_post(unsigned* bar, volatile LAS unsigned* st) {
    XcdBarrier b; b.bar = bar; b.x = xb_xcc_id(); b.st = st;
    if (threadIdx.x == 0) (void)xb_add(&bar[XB_XCNT(b.x)], 1u);
    return b;
}
__device__ __forceinline__ void xcd_barrier_complete(unsigned* bar, unsigned x, unsigned& nloc, unsigned& nx) {
    const unsigned G = gridDim.x * gridDim.y * gridDim.z;
    unsigned sum, cnt, mine, sp = 0u;
    for (;;) {
        sum = 0u; cnt = 0u; mine = 0u;
#pragma unroll
        for (unsigned j = 0; j < 16; ++j) { const unsigned c = xb_ld(&bar[XB_XCNT(j)]); sum += c; cnt += (c > 0u) ? 1u : 0u; mine = (j == x) ? c : mine; }
        if (sum == G) break;
        __builtin_amdgcn_s_sleep(1);
        if ((++sp & 255u) == 0u) { if (xb_ld(&bar[XB_TMO])) break; if (sp > XB_SPIN_CAP) { atomicAdd(&bar[XB_TMO], 1u); break; } }
    }
    nloc = mine > 0u ? mine : 1u; nx = cnt > 0u ? cnt : 1u;
}

__device__ __forceinline__ void xcd_barrier(const XcdBarrier& b) {
    asm volatile("s_waitcnt vmcnt(0)" ::: "memory");
    __syncthreads();
    if (threadIdx.x == 0) {
        unsigned* bar = b.bar;
        __builtin_amdgcn_s_waitcnt(0);
        unsigned nloc = b.st[0], nx = b.st[1];
        if (nloc == 0u) { xcd_barrier_complete(bar, b.x, nloc, nx); b.st[0] = nloc; b.st[1] = nx; }
        const unsigned old = xb_add(&bar[XB_XSUB(b.x)], 1u);
        const unsigned gen = old / nloc;
        if (old + 1u == (gen + 1u) * nloc) {
            __builtin_amdgcn_fence(__ATOMIC_RELEASE, "agent");
            asm volatile("s_waitcnt vmcnt(0)" ::: "memory");
            const unsigned og = xb_add(&bar[XB_TOP], 1u);
            const unsigned tg = og / nx;
            if (og + 1u == (tg + 1u) * nx) xb_add(&bar[XB_TOPGEN], 1u);
            else XB_SPIN(xb_ld(&bar[XB_TOPGEN]) == tg, bar);
            __builtin_amdgcn_fence(__ATOMIC_ACQUIRE, "agent");
            xb_add(&bar[XB_XGEN(b.x)], 1u);
            asm volatile("s_waitcnt vmcnt(0)" ::: "memory");
        } else {
            XB_SPIN(xb_ld(&bar[XB_XGEN(b.x)]) == gen, bar);
            __builtin_amdgcn_fence(__ATOMIC_ACQUIRE, "agent");
            asm volatile("s_waitcnt vmcnt(0)" ::: "memory");
        }
    }
    __syncthreads();
}

struct Ctx {
    LAS unsigned char* lds; int tid, lane, wave, G, wg, gw, NGW;
    const float* const __attribute__((address_space(4)))* in; float* X; unsigned char* ws;
};
#define WSP(type, off) ((type*)(c.ws + (off)))
#define WSG(type, off) ((GAS type*)(c.ws + (off)))
#define ING(i) ((const GAS float*)c.in[i])

struct CvtJob { const float* W0; const float* W1; const float* kscale; bf16_t* WT; int ldw, K, Ndst, kind; };
__device__ __forceinline__ int cvt_src_col(int kind, int n, int& which) {
    which = 0;
    if (kind == 0) return n;
    if (kind == 1) {
        if (n < 2048) return n; if (n < 3584) return n + 8; if (n < 4416) return n + 16;
        if (n < 4420) return 2048 + (n - 4416); if (n < 4424) return 2052 + (n - 4420); if (n < 4432) return 3592 + (n - 4424);
        if (n < 4608) return -1; return 4432 + (n - 4608);
    }
    if (kind == 2) { const int h = n / 192, j = n % 192; if (j < 128) return n; const int jj = j - 128; return h * 192 + 128 + (jj & 1) * 32 + (jj >> 1); }
    const int uu = n >> 8, r = n & 255; which = r >> 7; return uu * 128 + (r & 127);
}
__device__ __forceinline__ void cvt_item(const CvtJob& jb, int item, LAS float* scr, int lane) {
    const int nblk = jb.Ndst / 32, kb = item / nblk, nb = item % nblk, k0 = 64 * kb, n0 = 32 * nb;
    int which; const int sc = cvt_src_col(jb.kind, n0 + (lane & 31), which);
    const float* W = (const float*)((uintptr_t)jb.W0 + (uintptr_t)which * ((uintptr_t)jb.W1 - (uintptr_t)jb.W0));
    float v[32];
#pragma unroll
    for (int i = 0; i < 32; ++i) { const int kk = 2 * i + (lane >> 5); v[i] = (sc >= 0) ? W[(size_t)(k0 + kk) * jb.ldw + sc] : 0.f; }
    if (jb.kscale) {
#pragma unroll
        for (int i = 0; i < 32; ++i) v[i] *= jb.kscale[k0 + 2 * i + (lane >> 5)]; }
#pragma unroll
    for (int i = 0; i < 32; ++i) scr[(2 * i + (lane >> 5)) * 33 + (lane & 31)] = v[i];
    LDS_WAIT(); asm volatile("" ::: "memory");
    const int cc = lane & 7;
#pragma unroll
    for (int j = 0; j < 4; ++j) { const int n = (lane >> 3) + 8 * j; const LAS float* s = scr + (8 * cc) * 33 + n;
        u32x4 o; o.x = pk2(s[0 * 33], s[1 * 33]); o.y = pk2(s[2 * 33], s[3 * 33]); o.z = pk2(s[4 * 33], s[5 * 33]); o.w = pk2(s[6 * 33], s[7 * 33]);
        *(u32x4*)(jb.WT + (size_t)(n0 + n) * jb.K + k0 + 8 * cc) = o; }
    LDS_WAIT(); asm volatile("" ::: "memory");
}
__device__ __forceinline__ void cvt_run(const Ctx& c, const CvtJob& jb, LAS float* scr) {
    const int nitems = (jb.K / 64) * (jb.Ndst / 32);
    for (int it = c.gw; it < nitems; it += c.NGW) cvt_item(jb, it, scr, c.lane);
}
__device__ __forceinline__ void cvt_run_ranked(const Ctx& c, const CvtJob& jb, LAS float* scr, int rank, int count) {
    const int nitems = (jb.K / 64) * (jb.Ndst / 32);
    for (int it = rank; it < nitems; it += count) cvt_item(jb, it, scr, c.lane);
}
__device__ __forceinline__ CvtJob make_job(const Ctx& c, int j) {
    CvtJob jb; jb.W0 = nullptr; jb.W1 = nullptr; jb.kscale = nullptr; jb.kind = 0;
    if (j < 8 * NL) {
        const int l = j >> 3, k = j & 7;
        if (k == 0) { jb.W0 = c.in[5] + (size_t)l * 1024 * 7504; jb.ldw = 7504; jb.K = 1024; jb.Ndst = NP; jb.kind = 1; jb.WT = WSP(bf16_t, O_WIN) + (size_t)l * NP * 1024; }
        else if (k == 1) { jb.W0 = c.in[17] + (size_t)l * 512 * 768; jb.ldw = 768; jb.K = 512; jb.Ndst = 768; jb.kind = 2; jb.kscale = c.in[16] + l * 512; jb.WT = WSP(bf16_t, O_WUQ) + (size_t)l * 768 * 512; }
        else if (k == 2) { jb.W0 = c.in[19] + (size_t)l * 256 * 512; jb.ldw = 512; jb.K = 256; jb.Ndst = 512; jb.kscale = c.in[18] + l * 256; jb.WT = WSP(bf16_t, O_WUK) + (size_t)l * 512 * 256; }
        else if (k == 3) { jb.W0 = c.in[20] + (size_t)l * 256 * 512; jb.ldw = 512; jb.K = 256; jb.Ndst = 512; jb.kscale = c.in[18] + l * 256; jb.WT = WSP(bf16_t, O_WUV) + (size_t)l * 512 * 256; }
        else if (k < 7) { jb.W0 = (k == 4 ? c.in[21] : k == 5 ? c.in[22] : c.in[23]) + (size_t)l * 512 * 1024; jb.ldw = 1024; jb.K = 512; jb.Ndst = 1024; jb.WT = WSP(bf16_t, O_WBR) + (size_t)(l * 3 + (k - 4)) * 1024 * 512; }
        else { jb.W0 = c.in[24] + (size_t)l * 1024 * 1024; jb.ldw = 1024; jb.K = 1024; jb.Ndst = 1024; jb.WT = WSP(bf16_t, O_WOUT) + (size_t)l * 1024 * 1024; }
    } else {
        const int i = (j - 8 * NL) >> 1, k = (j - 8 * NL) & 1;
        if (k == 0) { jb.W0 = c.in[25] + (size_t)i * 1024 * FF; jb.W1 = c.in[26] + (size_t)i * 1024 * FF; jb.ldw = FF; jb.K = 1024; jb.Ndst = 2 * FF; jb.kind = 3; jb.WT = WSP(bf16_t, O_WGU) + (size_t)i * 2 * FF * 1024; }
        else { jb.W0 = c.in[27] + (size_t)i * FF * 1024; jb.ldw = 1024; jb.K = FF; jb.Ndst = 1024; jb.WT = WSP(bf16_t, O_WDN) + (size_t)i * 1024 * FF; }
    }
    return jb;
}
__device__ __forceinline__ CvtJob make_moe_job(const Ctx& c, int i, int j) {
    CvtJob jb; jb.W0 = nullptr; jb.W1 = nullptr; jb.kscale = nullptr; jb.kind = 0;
    if (j < 8) { const size_t eo = (size_t)(i * 8 + j) * 1024 * EF; jb.W0 = c.in[29] + eo; jb.W1 = c.in[30] + eo; jb.ldw = EF; jb.K = 1024; jb.Ndst = 2 * EF; jb.kind = 3; jb.WT = WSP(bf16_t, O_WEGU) + (size_t)j * 2 * EF * 1024; }
    else { const int e = j - 8; jb.W0 = c.in[31] + (size_t)(i * 8 + e) * EF * 1024; jb.ldw = 1024; jb.K = EF; jb.Ndst = 1024; jb.WT = WSP(bf16_t, O_WEDN) + (size_t)e * 1024 * EF; }
    return jb;
}

__device__ __forceinline__ void cvt_item(const CvtJob& jb, int item, LAS float* scr, int lane);
struct CvtQueue { unsigned* ctr; unsigned base, off; int lane;
    __device__ __forceinline__ unsigned grab() { unsigned b = 0; if (lane == 0) b = __hip_atomic_fetch_add(ctr, 8u, __ATOMIC_RELAXED, __HIP_MEMORY_SCOPE_AGENT); return (unsigned)__builtin_amdgcn_readfirstlane(b); }
    __device__ __forceinline__ void init(unsigned* c_, int lane_) { ctr = c_; lane = lane_; off = 0; base = grab(); }
    __device__ __forceinline__ void run(const CvtJob& jb, LAS float* scr) { const unsigned n = (unsigned)(jb.K / 64) * (unsigned)(jb.Ndst / 32);
        while (base - off < n) {
#pragma unroll 1
            for (unsigned k = 0; k < 8; ++k) cvt_item(jb, (int)(base - off + k), scr, lane);
            base = grab(); }
        off += n; }
};
__device__ __forceinline__ void p0_prologue(const Ctx& c) {
    LAS float* sil = (LAS float*)c.lds;
    LAS float* red = sil + 4096;
    LAS float* scr = (LAS float*)(c.lds + 32768 + c.wave * 8704);
    for (int i = c.tid; i < 4096; i += NTHR) sil[i] = siluf_(c.in[1][i]);
    __syncthreads();
    float* MOD = WSP(float, O_MOD);
    for (int it = c.wg; it < NL * 96; it += c.G) {
        const int l = it / 96, cg = it % 96, col = cg * 64 + c.lane;
        float a0 = 0.f, a1 = 0.f, a2 = 0.f, a3 = 0.f;
        const float* w = c.in[3] + (size_t)l * 1024 * 6144 + col;
#pragma unroll 32
        for (int k = c.wave * 128; k < c.wave * 128 + 128; ++k) { const float wv = w[(size_t)k * 6144]; a0 += sil[k] * wv; a1 += sil[1024 + k] * wv; a2 += sil[2048 + k] * wv; a3 += sil[3072 + k] * wv; }
        red[(c.wave * 4 + 0) * 64 + c.lane] = a0; red[(c.wave * 4 + 1) * 64 + c.lane] = a1; red[(c.wave * 4 + 2) * 64 + c.lane] = a2; red[(c.wave * 4 + 3) * 64 + c.lane] = a3;
        __syncthreads();
        if (c.tid < 256) { const int b = c.tid >> 6, ln = c.tid & 63; float s = 0.f;
#pragma unroll
            for (int w8 = 0; w8 < 8; ++w8) s += red[(w8 * 4 + b) * 64 + ln];
            MOD[(size_t)(l * 4 + b) * 6144 + cg * 64 + ln] = s + c.in[4][l * 6144 + cg * 64 + ln]; }
        __syncthreads();
    }
    { float* ROPE = WSP(float, O_ROPE); const int* pos = (const int*)c.in[2];
      for (int idx = c.wg * NTHR + c.tid; idx < T * 32; idx += c.G * NTHR) { const int t = idx >> 5, i = idx & 31;
          const float inv = expf(-(float)(2 * i) * (1.f / 64.f) * 9.210340371976184f); const float ang = (float)pos[t] * inv; float sn, cs; sincosf(ang, &sn, &cs);
          ROPE[(size_t)idx * 2] = cs; ROPE[(size_t)idx * 2 + 1] = sn; } }
    { CvtQueue q; q.init((unsigned*)(c.ws + O_CTL) + 256 + 64 * 8, c.lane);
      for (int j = 0; j < 4; ++j) { const CvtJob jb = make_job(c, j); q.run(jb, scr); } }
}

__device__ __forceinline__ void load_row(const Ctx& c, int row, int combine_l, f32x4 (&v)[4], const float* xsrc = nullptr) {
    float* xr = c.X + (size_t)row * D + 4 * c.lane; const float* xs = (xsrc ? xsrc : c.X) + (size_t)row * D + 4 * c.lane;
#pragma unroll
    for (int j = 0; j < 4; ++j) v[j] = *(const f32x4*)(xs + 256 * j);
    if (combine_l >= 0) {
        const int b = row >> 12; const int* ts = WSP(int, O_TOKSLOT) + row * 2; const float* tw = WSP(float, O_TOPW) + row * 2;
        const int s0 = ts[0], s1 = ts[1]; const float w0 = tw[0], w1 = tw[1];
        const float* g2 = WSP(float, O_MOD) + (size_t)(combine_l * 4 + b) * 6144 + 5120 + 4 * c.lane;
        const int nmain = WSP(int, O_NBLK)[1] * 256;
        const bf16_t* y0 = WSP(bf16_t, O_YS) + (size_t)s0 * D + 4 * c.lane; const bf16_t* y1 = WSP(bf16_t, O_YS) + (size_t)s1 * D + 4 * c.lane;
        const float* z0 = WSP(float, O_MF) + (size_t)(s0 - nmain) * D + 4 * c.lane; const float* z1 = WSP(float, O_MF) + (size_t)(s1 - nmain) * D + 4 * c.lane;
#pragma unroll
        for (int j = 0; j < 4; ++j) { const f32x4 g = *(const f32x4*)(g2 + 256 * j); f32x4 ya, yb;
            if (s0 >= nmain) { ya = *(const f32x4*)(z0 + 256 * j);
#pragma unroll
                for (int k = 1; k < 7; ++k) ya = ya + *(const f32x4*)(z0 + (size_t)k * (8 * 256 * 1024) + 256 * j); }
            else { const u32x2 a = *(const u32x2*)(y0 + 256 * j); ya = (f32x4){lo16(a.x), hi16(a.x), lo16(a.y), hi16(a.y)}; }
            if (s1 >= nmain) { yb = *(const f32x4*)(z1 + 256 * j);
#pragma unroll
                for (int k = 1; k < 7; ++k) yb = yb + *(const f32x4*)(z1 + (size_t)k * (8 * 256 * 1024) + 256 * j); }
            else { const u32x2 bb = *(const u32x2*)(y1 + 256 * j); yb = (f32x4){lo16(bb.x), hi16(bb.x), lo16(bb.y), hi16(bb.y)}; }
            v[j] = v[j] + g * (ya * w0 + yb * w1); *(f32x4*)(xr + 256 * j) = v[j]; }
    }
}
__device__ __forceinline__ float row_rstd(const f32x4 (&v)[4]) {
    float ss = 0.f;
#pragma unroll
    for (int j = 0; j < 4; ++j) ss += (v[j][0] * v[j][0] + v[j][1] * v[j][1]) + (v[j][2] * v[j][2] + v[j][3] * v[j][3]);
    return rsqrtf(wave_sum(ss) * (1.f / D) + EPS);
}
__device__ __forceinline__ void norm_phase(const Ctx& c, int l, int which, int combine_l, const float* xsrc = nullptr) {
    bf16_t* H = WSP(bf16_t, O_H);
    for (int row0 = c.gw * 2; row0 < T; row0 += c.NGW * 2) {
        f32x4 v[2][4]; load_row(c, row0, combine_l, v[0], xsrc); load_row(c, row0 + 1, combine_l, v[1], xsrc);
#pragma unroll
        for (int q = 0; q < 2; ++q) { const int row = row0 + q;
            const float r = row_rstd(v[q]); const int b = row >> 12;
            const float* sh = WSP(float, O_MOD) + (size_t)(l * 4 + b) * 6144 + (which ? 3072 : 0) + 4 * c.lane; const float* sc = sh + 1024;
#pragma unroll
            for (int j = 0; j < 4; ++j) { const f32x4 s1 = *(const f32x4*)(sc + 256 * j), s0 = *(const f32x4*)(sh + 256 * j); const f32x4 h = v[q][j] * r * (s1 + 1.f) + s0;
                u32x2 o; o.x = pk2(h[0], h[1]); o.y = pk2(h[2], h[3]); *(u32x2*)(H + (size_t)row * D + 4 * c.lane + 256 * j) = o; } }
    }
}
__device__ __forceinline__ void final_phase(const Ctx& c, int combine_l) {
    for (int row = c.gw; row < T; row += c.NGW) {
        f32x4 v[4]; load_row(c, row, combine_l, v);
        const float r = row_rstd(v); const float* fw = c.in[32] + 4 * c.lane;
#pragma unroll
        for (int j = 0; j < 4; ++j) { const f32x4 w = *(const f32x4*)(fw + 256 * j); *(f32x4*)(c.X + (size_t)row * D + 4 * c.lane + 256 * j) = v[j] * r * w; }
    }
}
__device__ __forceinline__ void norm2_moe_phase(const Ctx& c, int l) {
    bf16_t* H = WSP(bf16_t, O_H);
    LAS float* rt = (LAS float*)c.lds;
    LAS int* hist = (LAS int*)(c.lds + 32768);
    const float* router = c.in[28] + (size_t)(l >> 1) * 1024 * 8;
    for (int i = c.tid; i < 8192; i += NTHR) rt[i] = router[i];
    if (c.tid < 8) hist[c.tid] = 0;
    __syncthreads();
    const int rpw = T / c.G, r0 = c.wg * rpw;
    for (int rr = c.wave; rr < rpw; rr += NWAVES) {
        const int row = r0 + rr;
        f32x4 v[4]; load_row(c, row, -1, v);
        const float r = row_rstd(v); const int b = row >> 12;
        const float* sh = WSP(float, O_MOD) + (size_t)(l * 4 + b) * 6144 + 3072 + 4 * c.lane; const float* sc = sh + 1024;
        float lg[8];
#pragma unroll
        for (int e = 0; e < 8; ++e) lg[e] = 0.f;
#pragma unroll
        for (int j = 0; j < 4; ++j) { const f32x4 s1 = *(const f32x4*)(sc + 256 * j), s0 = *(const f32x4*)(sh + 256 * j); const f32x4 h = v[j] * r * (s1 + 1.f) + s0;
            u32x2 o; o.x = pk2(h[0], h[1]); o.y = pk2(h[2], h[3]); *(u32x2*)(H + (size_t)row * D + 4 * c.lane + 256 * j) = o;
#pragma unroll
            for (int q = 0; q < 4; ++q) { const LAS f32x4* rp = (const LAS f32x4*)(rt + (4 * c.lane + 256 * j + q) * 8); const f32x4 ra = rp[0], rb = rp[1];
                lg[0] += h[q] * ra[0]; lg[1] += h[q] * ra[1]; lg[2] += h[q] * ra[2]; lg[3] += h[q] * ra[3]; lg[4] += h[q] * rb[0]; lg[5] += h[q] * rb[1]; lg[6] += h[q] * rb[2]; lg[7] += h[q] * rb[3]; } }
#pragma unroll
        for (int e = 0; e < 8; ++e) lg[e] = wave_sum(lg[e]);
        if (c.lane == 0) {
            int e0 = 0; float m0 = lg[0];
#pragma unroll
            for (int e = 1; e < 8; ++e) if (lg[e] > m0) { m0 = lg[e]; e0 = e; }
            int e1 = -1; float m1 = -3.0e38f;
#pragma unroll
            for (int e = 0; e < 8; ++e) if (e != e0 && lg[e] > m1) { m1 = lg[e]; e1 = e; }
            const float ex = __expf(m1 - m0), w0 = 1.f / (1.f + ex);
            WSP(int, O_TOPE)[row] = e0 | (e1 << 8); WSP(float, O_TOPW)[row * 2] = w0; WSP(float, O_TOPW)[row * 2 + 1] = ex * w0;
            __hip_atomic_fetch_add(&hist[e0], 1, __ATOMIC_RELAXED, __HIP_MEMORY_SCOPE_WORKGROUP); __hip_atomic_fetch_add(&hist[e1], 1, __ATOMIC_RELAXED, __HIP_MEMORY_SCOPE_WORKGROUP);
        }
    }
    __syncthreads();
    if (c.tid < 8) WSP(int, O_WGCNT)[c.wg * 8 + c.tid] = hist[c.tid];
    __syncthreads();
}
__device__ __forceinline__ void moe_assign_phase(const Ctx& c, int l) {
    LAS int* cnt = (LAS int*)c.lds;
    LAS int* tot = cnt + 2048; LAS int* base = tot + 8; LAS int* spad = base + 8; LAS int* pairs = spad + 16;
    const int rpw = T / c.G, r0 = c.wg * rpw;
    LAS int* tl = pairs + 4 * rpw;
    const int* WGC = WSP(int, O_WGCNT);
    for (int i = c.tid; i < c.G * 8; i += NTHR) cnt[i] = WGC[i];
    if (c.tid < rpw) tl[c.tid] = WSP(int, O_TOPE)[r0 + c.tid];
    __syncthreads();
    if (c.tid < 8) { int t = 0, bs = 0; for (int w = 0; w < c.G; ++w) { if (w == c.wg) bs = t; t += cnt[w * 8 + c.tid]; } tot[c.tid] = t; base[c.tid] = bs; }
    __syncthreads();
    if (c.tid == 0) {
        int sp = 0; for (int e = 0; e < 8; ++e) { spad[e] = sp; sp += (tot[e] + 255) / 256 * 256; } spad[8] = sp;
        if (c.wg == 0) { int* blke = WSP(int, O_BLKE); int nb = 0; for (int e = 0; e < 8; ++e) { const int n = (tot[e] + 255) / 256; for (int k = 0; k < n; ++k) blke[nb++] = e; } *WSP(int, O_NBLK) = nb; WSP(int, O_NBLK)[1] = ((nb * 4) / c.G) * c.G / 4; }
    }
    __syncthreads();
    if (c.wave == 0) {
        int* tokslot = WSP(int, O_TOKSLOT); int runq[8];
#pragma unroll
        for (int q = 0; q < 8; ++q) runq[q] = spad[q] + base[q];
        const unsigned long long lt = (1ull << c.lane) - 1ull;
        for (int a0 = 0; a0 < 2 * rpw; a0 += 64) { const int a = a0 + c.lane, rr = a >> 1, k = a & 1; const bool on = a < 2 * rpw; const int e = on ? ((tl[rr] >> (8 * k)) & 255) : -1; int sl = 0;
#pragma unroll
            for (int q = 0; q < 8; ++q) { const unsigned long long m = __ballot(e == q); if (e == q) sl = runq[q] + __popcll(m & lt); runq[q] += __popcll(m); }
            if (on) { tokslot[(r0 + rr) * 2 + k] = sl; pairs[a * 2] = sl; pairs[a * 2 + 1] = r0 + rr; } }
    }
    __syncthreads();
    { const bf16_t* H = WSP(bf16_t, O_H); bf16_t* XS = WSP(bf16_t, O_XS);
      for (int p = c.wave; p < rpw * 2; p += NWAVES) { const int s = pairs[p * 2], tk = pairs[p * 2 + 1];
          const u32x4* src = (const u32x4*)(H + (size_t)tk * D) + c.lane; u32x4* dst = (u32x4*)(XS + (size_t)s * D) + c.lane; dst[0] = src[0]; dst[64] = src[64]; }
      if (c.wg < 8) { const int e = c.wg, p0 = spad[e] + tot[e], p1 = spad[e + 1];
          for (int s = p0 + c.wave; s < p1; s += NWAVES) { u32x4* dst = (u32x4*)(XS + (size_t)s * D) + c.lane; dst[0] = (u32x4){0u, 0u, 0u, 0u}; dst[64] = (u32x4){0u, 0u, 0u, 0u}; } } }
    __syncthreads();
}
__device__ __forceinline__ void next_layer_convert(const Ctx& c, int l, LAS float* scr, int rank, int count) {
    if (l + 1 >= NL) return;
    for (int j = 8 * (l + 1); j < 8 * (l + 2); ++j) { const CvtJob jb = make_job(c, j); cvt_run_ranked(c, jb, scr, rank, count); }
    if (((l + 1) & 1) == 0) for (int j = 8 * NL + 2 * ((l + 1) >> 1); j < 8 * NL + 2 * ((l + 1) >> 1) + 2; ++j) { const CvtJob jb = make_job(c, j); cvt_run_ranked(c, jb, scr, rank, count); }
}
__device__ __forceinline__ void moe_convert(const Ctx& c, int l, LAS float* scr, int rank, int count) {
    for (int j = 0; j < 16; ++j) { const CvtJob jb = make_moe_job(c, l >> 1, j); cvt_run_ranked(c, jb, scr, rank, count); }
}
__device__ __forceinline__ void moe_convert_queue(const Ctx& c, int l, LAS float* scr) {
    unsigned* ctr = (unsigned*)(c.ws + O_CTL) + 256 + 64 * (l >> 1);
    constexpr unsigned NGU = 8u * 16u * (2 * EF / 32), NDN = 8u * (EF / 64) * 32u;
    for (;;) {
        unsigned base = 0; if (c.lane == 0) base = __hip_atomic_fetch_add(ctr, 8u, __ATOMIC_RELAXED, __HIP_MEMORY_SCOPE_AGENT);
        base = __builtin_amdgcn_readfirstlane(base);
        if (base >= NGU + NDN) break;
#pragma unroll 1
        for (unsigned k = 0; k < 8; ++k) { const unsigned idx = base + k; int j, item;
            if (idx < NGU) { j = idx / (NGU / 8); item = idx % (NGU / 8); } else { const unsigned r = idx - NGU; j = 8 + r / (NDN / 8); item = r % (NDN / 8); }
            const CvtJob jb = make_moe_job(c, l >> 1, j); cvt_item(jb, item, scr, c.lane); }
    }
}
__device__ __forceinline__ void next_layer_convert_queue(const Ctx& c, int l, LAS float* scr) {
    if (l + 1 >= NL) return;
    unsigned* ctr = (unsigned*)(c.ws + O_CTL) + 256 + 64 * (4 + l);
    auto grab = [&]() { unsigned b = 0; if (c.lane == 0) b = __hip_atomic_fetch_add(ctr, 8u, __ATOMIC_RELAXED, __HIP_MEMORY_SCOPE_AGENT); return (unsigned)__builtin_amdgcn_readfirstlane(b); };
    unsigned base = grab(), off = 0;
    auto run = [&](int j) { const CvtJob jb = make_job(c, j); const unsigned n = (unsigned)(jb.K / 64) * (unsigned)(jb.Ndst / 32);
        while (base - off < n) {
#pragma unroll 1
            for (unsigned k = 0; k < 8; ++k) cvt_item(jb, (int)(base - off + k), scr, c.lane);
            base = grab(); }
        off += n; };
    if (l == 0) { for (int j = 4; j < 8; ++j) run(j); run(8 * NL); run(8 * NL + 1); }
    for (int j = 8 * (l + 1); j < 8 * (l + 2); ++j) run(j);
    if (((l + 1) & 1) == 0) for (int j = 8 * NL + 2 * ((l + 1) >> 1); j < 8 * NL + 2 * ((l + 1) >> 1) + 2; ++j) run(j);
}
__device__ __forceinline__ void gdn_prep_unit(const Ctx& c, int l, int unit, int stop = 0) {
    const int h = unit & 3, n = (unit >> 2) & 63, b = unit >> 8;
    const int t0 = b * SEQ + n * CH;
    LAS bf16_t* Qb = (LAS bf16_t*)c.lds; LAS bf16_t* Kb = Qb + 64 * 136;
    LAS float* AS = (LAS float*)(c.lds + 34816);
    LAS float* KS = AS + 4096; LAS float* VS = KS + 8643; LAS float* QS = VS + 8643;
    LAS float* GS = QS + 8643; LAS float* BE = GS + 64; LAS float* EG = BE + 64;
    const GAS bf16_t* P = WSG(bf16_t, O_PROJ);
    { LAS unsigned char* rawl = c.lds;
#pragma unroll 1
      for (int k = 0; k < 7; ++k) { const int I = c.wave + 8 * k;
          if (I < 51) { const int idx = I * 64 + c.lane; if (idx < 67 * 48) { const int r = idx / 48, pc = idx % 48;
              if (n > 0 || r >= 3) __builtin_amdgcn_global_load_lds((const unsigned*)((const char*)(P + (size_t)(t0 - 3 + r) * NP + (pc >> 4) * 512 + h * 128 + (pc & 15) * 8)), (LAS unsigned*)(rawl + I * 1024), 16, 0, 0); } } }
      asm volatile("s_waitcnt vmcnt(0)" ::: "memory"); LDS_BARRIER(); }
    if (c.tid < 384) {
        const int part = c.tid >> 7, d = c.tid & 127, col = part * 512 + h * 128 + d;
        const GAS float* cw = ING(6) + (size_t)l * 4 * 1536 + col; const float w0 = cw[0], w1 = cw[1536], w2 = cw[2 * 1536], w3 = cw[3 * 1536];
        const LAS bf16_t* src = (const LAS bf16_t*)c.lds + c.tid;
        unsigned short raw[67];
#pragma unroll
        for (int r = 0; r < 67; ++r) raw[r] = (n > 0 || r >= 3) ? src[r * 384] : (unsigned short)0;
        LAS float* A = (part == 0 ? QS : part == 1 ? KS : VS) + 3 * 129 + d;
#pragma unroll
        for (int t = 0; t < 64; ++t) A[t * 129] = siluf_(w0 * bf2f(raw[t]) + w1 * bf2f(raw[t + 1]) + w2 * bf2f(raw[t + 2]) + w3 * bf2f(raw[t + 3]));
    } else if (c.tid < 448) {
        const int t = c.tid - 384; const GAS float* sf = WSG(float, O_SMALLF) + (size_t)(t0 + t) * 16;
        const float a = sf[h], bb = sf[4 + h];
        const float g = -expf(ING(7)[l * 4 + h]) * softplusf_(a + ING(8)[l * 4 + h]);
        float G = g;
#pragma unroll
        for (int o = 1; o < 64; o <<= 1) { const float up = __shfl_up(G, o); if (t >= o) G += up; }
        GS[t] = G; BE[t] = sigmoidf_(bb); EG[t] = expf(G);
    }
    LDS_BARRIER();
    if (stop == 2) return;
    for (int rr = c.wave; rr < 128; rr += NWAVES) { const bool isq = rr < 64; const int t = rr & 63; LAS float* row = (isq ? QS : KS) + (t + 3) * 129;
        const float a = row[c.lane], bq = row[c.lane + 64]; const float ss = wave_sum(a * a + bq * bq); const float sc = rsqrtf(ss + EPS) * (isq ? 0.08838834764831845f : 1.f);
        LAS bf16_t* ob = (isq ? Qb : Kb) + t * 136;
        ob[c.lane] = (bf16_t)f2bf(a * sc); ob[c.lane + 64] = (bf16_t)f2bf(bq * sc);
        if (!isq) { row[c.lane] = a * sc; row[c.lane + 64] = bq * sc; } }
    LDS_BARRIER();
    LAS float* QKs = QS;
    { const int typ = c.wave >> 2, ti = c.wave & 3, lr = c.lane & 15, g = c.lane >> 4;
      const LAS bf16_t* Xb = typ ? Qb : Kb;
#pragma unroll 1
      for (int tj = 0; tj < 4; ++tj) {
          f32x4 acc = {0.f, 0.f, 0.f, 0.f};
          if (tj <= ti) {
#pragma unroll
              for (int ks = 0; ks < 4; ++ks) { const bf16x8 af = *(const LAS bf16x8*)(Xb + (16 * ti + lr) * 136 + 32 * ks + 8 * g); const bf16x8 bf = *(const LAS bf16x8*)(Kb + (16 * tj + lr) * 136 + 32 * ks + 8 * g);
                  acc = __builtin_amdgcn_mfma_f32_16x16x32_bf16(af, bf, acc, 0, 0, 0); } }
          const int j = 16 * tj + lr;
#pragma unroll
          for (int r = 0; r < 4; ++r) { const int i = 16 * ti + 4 * g + r; float v = 0.f;
              if (typ == 0) { if (j < i) v = BE[i] * acc[r] * __expf(GS[i] - GS[j]); AS[i * 64 + j] = v; }
              else { if (j <= i) v = acc[r] * __expf(GS[i] - GS[j]); QKs[i * 65 + j] = v; } } } }
    LDS_BARRIER();
    if (stop == 4) return;
    const int chunk = (b * 4 + h) * 64 + n;
    if (c.tid >= 256) { GAS bf16_t* OPS = WSG(bf16_t, O_GW) + (size_t)chunk * (56 * 512); const float gl = GS[63];
#pragma unroll 1
      for (int q = 1024 + (c.tid - 256); q < 56 * 64; q += 256) { const int f = q >> 6, ln = q & 63, lr = ln & 15, g = ln >> 4; float v[8];
          if (f < 32) { const int ct = (f - 16) >> 2, ks = (f - 16) & 3, i = 16 * ct + lr; const float eg = EG[i]; const LAS bf16_t* qr = Qb + i * 136 + 32 * ks + 4 * g;
#pragma unroll
              for (int j = 0; j < 4; ++j) { v[j] = bf2f(qr[j]) * eg; v[4 + j] = bf2f(qr[16 + j]) * eg; } }
          else if (f < 40) { const int ct = (f - 32) >> 1, ks2 = (f - 32) & 1; const LAS float* qr = QKs + (16 * ct + lr) * 65 + 32 * ks2 + 4 * g;
#pragma unroll
              for (int j = 0; j < 4; ++j) { v[j] = qr[j]; v[4 + j] = qr[16 + j]; } }
          else { const int dt = (f - 40) >> 1, ks2 = (f - 40) & 1, dk = 16 * dt + lr, c0 = 32 * ks2 + 4 * g;
#pragma unroll
              for (int j = 0; j < 4; ++j) { v[j] = bf2f(Kb[(c0 + j) * 136 + dk]) * __expf(gl - GS[c0 + j]); v[4 + j] = bf2f(Kb[(c0 + 16 + j) * 136 + dk]) * __expf(gl - GS[c0 + 16 + j]); } }
          u32x4 o; o.x = pk2(v[0], v[1]); o.y = pk2(v[2], v[3]); o.z = pk2(v[4], v[5]); o.w = pk2(v[6], v[7]);
          *(GAS u32x4*)(OPS + (size_t)q * 8) = o; }
      if (c.tid == 256) WSG(float, O_GL)[chunk] = expf(gl);
    } else {
        const int col = c.tid; LAS float* src = ((col < 128) ? VS + col : KS + (col - 128)) + 3 * 129;
        unsigned asb = (unsigned)(uintptr_t)AS; asm volatile("" : "+v"(asb));
        const LAS float* ASv = (const LAS float*)(uintptr_t)asb; const LAS float* BEv = ASv + 4096 + 3 * 8643 + 64; const LAS float* EGv = BEv + 64;
        const LAS f32x4* A4 = (const LAS f32x4*)ASv;
        f32x2 x2[32]; f32x4 ar[16];
#pragma unroll
        for (int m = 0; m < 32; ++m) { x2[m][0] = src[(2 * m) * 129] * BEv[2 * m] * (col < 128 ? 1.f : EGv[2 * m]); x2[m][1] = src[(2 * m + 1) * 129] * BEv[2 * m + 1] * (col < 128 ? 1.f : EGv[2 * m + 1]); }
        ar[0] = A4[16];
#pragma unroll
        for (int i = 0; i < 64; ++i) {
            f32x2 acc0 = {0.f, 0.f}, acc1 = {0.f, 0.f};
#pragma unroll
            for (int q = 0; 4 * q < i; ++q) { const f32x4 aq = ar[q];
                if (4 * q + 1 < i) acc0 = acc0 + (f32x2){aq[0], aq[1]} * x2[2 * q]; else acc0[0] += aq[0] * x2[2 * q][0];
                if (4 * q + 3 < i) acc1 = acc1 + (f32x2){aq[2], aq[3]} * x2[2 * q + 1]; else if (4 * q + 2 < i) acc1[0] += aq[2] * x2[2 * q + 1][0];
                if (i + 1 < 64) ar[q] = A4[(i + 1) * 16 + q]; }
            if (i >= 1 && (i & 3) == 0 && i + 1 < 64) ar[i >> 2] = A4[(i + 1) * 16 + (i >> 2)];
            const float sx = x2[i >> 1][i & 1] - ((acc0[0] + acc0[1]) + (acc1[0] + acc1[1]));
            x2[i >> 1][i & 1] = sx; src[i * 129] = sx;
        }
    }
    LDS_BARRIER();
    if (stop == 6) return;
    { GAS bf16_t* OPS = WSG(bf16_t, O_GW) + (size_t)chunk * (56 * 512);
#pragma unroll 1
      for (int q = c.tid; q < 1024; q += NTHR) { const int f = q >> 6, ln = q & 63, lr = ln & 15, g = ln >> 4, ct = f >> 2, ks = f & 3; const LAS float* wr = KS + (16 * ct + lr + 3) * 129 + 32 * ks + 4 * g;
          u32x4 o; o.x = pk2(wr[0], wr[1]); o.y = pk2(wr[2], wr[3]); o.z = pk2(wr[16], wr[17]); o.w = pk2(wr[18], wr[19]);
          *(GAS u32x4*)(OPS + (size_t)q * 8) = o; }
      GAS float* UF = WSG(float, O_GU) + (size_t)chunk * 8192;
#pragma unroll 1
      for (int q = c.tid; q < 2048; q += NTHR) { const int es = q >> 8, ct = (q >> 6) & 3, ln = q & 63, lr = ln & 15, g = ln >> 4; const LAS float* ur = VS + (16 * ct + 4 * g + 3) * 129 + 16 * es + lr;
          *(GAS f32x4*)(UF + (size_t)q * 4) = (f32x4){ur[0], ur[129], ur[258], ur[387]}; } }
    LDS_BARRIER();
}

__device__ __forceinline__ void gdn_scan_wave(const Ctx& c, int bh, int es) {
    const int lane = c.lane; const unsigned l16 = (unsigned)lane * 16u;
    const char* ops = (const char*)(WSG(bf16_t, O_GW)) + (size_t)bh * 64 * 57344;
    const char* uf = (const char*)(WSG(float, O_GU)) + (size_t)bh * 64 * 32768 + es * 4096;
    char* sv = (char*)c.ws + O_MF + ((size_t)bh * 64 * 8 + es) * 6144;
    const GAS float* GL = WSG(float, O_GL) + bh * 64;
    LAS unsigned char* lds = c.lds;
#define GS_ISSUE(n_, buf_) do { const char* so_ = ops + (size_t)(n_) * 57344; const char* su_ = uf + (size_t)(n_) * 32768; LAS unsigned char* d_ = lds + (buf_) * 36864; \
        _Pragma("unroll") for (int f_ = 0; f_ < 16; ++f_) __builtin_amdgcn_global_load_lds((const unsigned*)(so_ + f_ * 1024 + l16), (LAS unsigned*)(d_ + f_ * 1024), 16, 0, 0); \
        _Pragma("unroll") for (int f_ = 0; f_ < 16; ++f_) __builtin_amdgcn_global_load_lds((const unsigned*)(so_ + (40 + f_) * 1024 + l16), (LAS unsigned*)(d_ + 16384 + f_ * 1024), 16, 0, 0); \
        _Pragma("unroll") for (int f_ = 0; f_ < 4; ++f_) __builtin_amdgcn_global_load_lds((const unsigned*)(su_ + f_ * 1024 + l16), (LAS unsigned*)(d_ + 32768 + f_ * 1024), 16, 0, 0); } while (0)
#define GS_FRAG(f_) (*(const LAS bf16x8*)(B + (f_) * 1024 + lane * 16))
    f32x4 S[8];
#pragma unroll
    for (int d = 0; d < 8; ++d) S[d] = (f32x4){0.f, 0.f, 0.f, 0.f};
    const float glv = GL[lane];
    asm volatile("s_waitcnt vmcnt(0)" ::: "memory");
    GS_ISSUE(0, 0);
#pragma unroll 1
    for (int n = 0; n < NCH; ++n) {
        const int buf = n & 1;
        if (n + 1 < NCH) { GS_ISSUE(n + 1, buf ^ 1); asm volatile("s_waitcnt vmcnt(36)" ::: "memory"); } else asm volatile("s_waitcnt vmcnt(0)" ::: "memory");
        const LAS unsigned char* B = lds + buf * 36864;
        GAS u32x4* svn = (GAS u32x4*)(sv + (size_t)n * 49152 + l16);
        f32x4 vn[4], acc[4]; bf16x8 Sb[4], vnb[2];
#pragma unroll
        for (int ct = 0; ct < 4; ++ct) { vn[ct] = *(const LAS f32x4*)(B + 32768 + ct * 1024 + lane * 16); acc[ct] = (f32x4){0.f, 0.f, 0.f, 0.f}; }
#pragma unroll
        for (int ks = 0; ks < 4; ++ks) { u32x4 w; w.x = pk2(S[2 * ks][0], S[2 * ks][1]); w.y = pk2(S[2 * ks][2], S[2 * ks][3]); w.z = pk2(S[2 * ks + 1][0], S[2 * ks + 1][1]); w.w = pk2(S[2 * ks + 1][2], S[2 * ks + 1][3]); Sb[ks] = __builtin_bit_cast(bf16x8, w); svn[ks * 64] = w; }
#pragma unroll
        for (int ks = 0; ks < 4; ++ks)
#pragma unroll
            for (int ct = 0; ct < 4; ++ct) acc[ct] = __builtin_amdgcn_mfma_f32_16x16x32_bf16(GS_FRAG(ct * 4 + ks), Sb[ks], acc[ct], 0, 0, 0);
#pragma unroll
        for (int ct = 0; ct < 4; ++ct) vn[ct] = vn[ct] - acc[ct];
#pragma unroll
        for (int k2 = 0; k2 < 2; ++k2) { u32x4 w; w.x = pk2(vn[2 * k2][0], vn[2 * k2][1]); w.y = pk2(vn[2 * k2][2], vn[2 * k2][3]); w.z = pk2(vn[2 * k2 + 1][0], vn[2 * k2 + 1][1]); w.w = pk2(vn[2 * k2 + 1][2], vn[2 * k2 + 1][3]); vnb[k2] = __builtin_bit_cast(bf16x8, w); svn[(4 + k2) * 64] = w; }
        const float gl = __builtin_bit_cast(float, __builtin_amdgcn_readlane(__builtin_bit_cast(int, glv), n));
#pragma unroll
        for (int d = 0; d < 8; ++d) S[d] = S[d] * gl;
#pragma unroll
        for (int k2 = 0; k2 < 2; ++k2)
#pragma unroll
            for (int d = 0; d < 8; ++d) S[d] = __builtin_amdgcn_mfma_f32_16x16x32_bf16(GS_FRAG(16 + d * 2 + k2), vnb[k2], S[d], 0, 0, 0);
    }
#undef GS_ISSUE
#undef GS_FRAG
}
__device__ __forceinline__ void gdn_out_phase(const Ctx& c, int l) {
    const int lane = c.lane, lr = lane & 15, g = lane >> 4, ts = c.wave >> 1, hf = c.wave & 1;
    const GAS bf16_t* P = WSG(bf16_t, O_PROJ); GAS bf16_t* YA = WSG(bf16_t, O_YA);
    LAS unsigned char* R = c.lds + ts * 24576;
    LAS float* SSQ = (LAS float*)(c.lds + 4 * 24576) + ts * 128;
    for (int tbase = 0; tbase < NB * 4 * NCH; tbase += c.G * 4) {
        const int task = tbase + c.wg + c.G * ts; const bool on = task < NB * 4 * NCH;
        const int bh = task >> 6, n = task & 63, b = bh >> 2, h = bh & 3, t0 = b * SEQ + n * CH;
        const char* ops = (const char*)(WSG(bf16_t, O_GW)) + (size_t)task * 57344 + lane * 16;
        const char* sv = (const char*)c.ws + O_MF + (size_t)task * 49152 + lane * 16;
        LDS_BARRIER();
        if (on) {
#pragma unroll
            for (int f = 0; f < 12; ++f) __builtin_amdgcn_global_load_lds((const unsigned*)(ops + (16 + 12 * hf + f) * 1024), (LAS unsigned*)(R + (12 * hf + f) * 1024), 16, 0, 0); }
        asm volatile("s_waitcnt vmcnt(0)" ::: "memory"); LDS_BARRIER();
        f32x4 o[4][4];
        if (on) {
#pragma unroll
            for (int e4 = 0; e4 < 4; ++e4) { const int es = 4 * hf + e4; bf16x8 sb[6];
#pragma unroll
                for (int f = 0; f < 6; ++f) sb[f] = *(const GAS bf16x8*)(sv + (es * 6 + f) * 1024);
#pragma unroll
                for (int ct = 0; ct < 4; ++ct) { f32x4 a = {0.f, 0.f, 0.f, 0.f};
#pragma unroll
                    for (int ks = 0; ks < 4; ++ks) a = __builtin_amdgcn_mfma_f32_16x16x32_bf16(*(const LAS bf16x8*)(R + (ct * 4 + ks) * 1024 + lane * 16), sb[ks], a, 0, 0, 0);
#pragma unroll
                    for (int k2 = 0; k2 < 2; ++k2) a = __builtin_amdgcn_mfma_f32_16x16x32_bf16(*(const LAS bf16x8*)(R + (16 + ct * 2 + k2) * 1024 + lane * 16), sb[4 + k2], a, 0, 0, 0);
                    o[e4][ct] = a; } }
#pragma unroll
            for (int ct = 0; ct < 4; ++ct)
#pragma unroll
                for (int r = 0; r < 4; ++r) { float ss = 0.f;
#pragma unroll
                    for (int e4 = 0; e4 < 4; ++e4) ss += o[e4][ct][r] * o[e4][ct][r];
                    ss = row16_sum(ss); if (lr == 0) SSQ[hf * 64 + 16 * ct + 4 * g + r] = ss; }
        }
        LDS_BARRIER();
        if (on) {
            LAS bf16_t* OT = (LAS bf16_t*)R;
#pragma unroll
            for (int ct = 0; ct < 4; ++ct)
#pragma unroll
                for (int r = 0; r < 4; ++r) { const int row = 16 * ct + 4 * g + r; const float rs = rsqrtf((SSQ[row] + SSQ[64 + row]) * (1.f / 128.f) + EPS);
#pragma unroll
                    for (int e4 = 0; e4 < 4; ++e4) OT[row * 136 + 16 * (4 * hf + e4) + lr] = (bf16_t)f2bf(o[e4][ct][r] * rs); }
        }
        LDS_BARRIER();
        if (on) {
            const LAS bf16_t* OT = (const LAS bf16_t*)R;
#pragma unroll
            for (int k = 0; k < 8; ++k) { const int ch = lane + 64 * k, row = 32 * hf + (ch >> 4), ec = (ch & 15) * 8; const size_t t = (size_t)(t0 + row);
                f32x4 x0, x1, z0, z1; unpk8(*(const LAS u32x4*)(OT + row * 136 + ec), x0, x1); unpk8(*(const GAS u32x4*)(P + t * NP + C_GZ + h * 128 + ec), z0, z1);
                const f32x4 w0 = *(const GAS f32x4*)(ING(9) + l * 128 + ec), w1 = *(const GAS f32x4*)(ING(9) + l * 128 + ec + 4);
#pragma unroll
                for (int i = 0; i < 4; ++i) { x0[i] = x0[i] * w0[i] * siluf_(z0[i]); x1[i] = x1[i] * w1[i] * siluf_(z1[i]); }
                *(GAS u32x4*)(YA + t * 512 + h * 128 + ec) = pk8(x0, x1); }
        }
    }
    LDS_BARRIER();
}

__device__ __forceinline__ void gdn_scan_unit(const Ctx& c, int unit) {
    const int es = unit & 3, h = (unit >> 2) & 3, b = unit >> 4;
    LAS float* SST = (LAS float*)c.lds;
    LAS bf16_t* WL = (LAS bf16_t*)(c.lds + 16896); LAS bf16_t* QDL = WL + 8192; LAS bf16_t* KDL = QDL + 8192; LAS bf16_t* QKL = KDL + 8192;
    LAS float* VN = (LAS float*)(c.lds + 16896 + 3 * 16384 + 8192);
    for (int i = c.tid; i < 128 * 33; i += NTHR) SST[i] = 0.f;
    const GAS bf16_t* W = WSG(bf16_t, O_GW); const GAS bf16_t* QD = WSG(bf16_t, O_GQD); const GAS bf16_t* KD = WSG(bf16_t, O_GKD); const GAS bf16_t* QK = WSG(bf16_t, O_GQK);
    const GAS float* U = WSG(float, O_GU); GAS float* GO = WSG(float, O_GO); const GAS float* GL = WSG(float, O_GL) + (b * 4 + h) * 64;
    const int e = c.tid & 31, cc = c.tid >> 5;
    for (int n = 0; n < NCH; ++n) {
        const int t0 = b * SEQ + n * CH;
        __syncthreads();
#pragma unroll
        for (int k = 0; k < 2; ++k) { const int p = c.tid + k * NTHR, r = p >> 4, q = p & 15; const size_t go = (size_t)(t0 + r) * 512 + h * 128 + q * 8;
            *(LAS u32x4*)(WL + r * 128 + q * 8) = *(const GAS u32x4*)(W + go); *(LAS u32x4*)(QDL + r * 128 + q * 8) = *(const GAS u32x4*)(QD + go); *(LAS u32x4*)(KDL + r * 128 + q * 8) = *(const GAS u32x4*)(KD + go); }
        { const int r = c.tid >> 3, q = c.tid & 7; *(LAS u32x4*)(QKL + r * 64 + q * 8) = *(const GAS u32x4*)(QK + ((size_t)(t0 + r) * 4 + h) * 64 + q * 8); }
        __syncthreads();
#pragma unroll 1
        for (int r = 0; r < 4; ++r) { const int ci = cc + 16 * r; float a = U[(size_t)(t0 + ci) * 512 + h * 128 + es * 32 + e];
            const LAS unsigned* wr = (const LAS unsigned*)(WL + ci * 128);
#pragma unroll 8
            for (int d2 = 0; d2 < 64; ++d2) { const unsigned w2 = wr[d2]; a -= lo16(w2) * SST[(2 * d2) * 33 + e] + hi16(w2) * SST[(2 * d2 + 1) * 33 + e]; }
            VN[ci * 33 + e] = a; }
        __syncthreads();
#pragma unroll 1
        for (int r = 0; r < 4; ++r) { const int ci = cc + 16 * r; float a = 0.f;
            const LAS unsigned* qr = (const LAS unsigned*)(QDL + ci * 128);
#pragma unroll 8
            for (int d2 = 0; d2 < 64; ++d2) { const unsigned w2 = qr[d2]; a += lo16(w2) * SST[(2 * d2) * 33 + e] + hi16(w2) * SST[(2 * d2 + 1) * 33 + e]; }
            const LAS unsigned* kr = (const LAS unsigned*)(QKL + ci * 64);
#pragma unroll 8
            for (int j2 = 0; j2 < 32; ++j2) { const unsigned w2 = kr[j2]; a += lo16(w2) * VN[(2 * j2) * 33 + e] + hi16(w2) * VN[(2 * j2 + 1) * 33 + e]; }
            GO[(size_t)(t0 + ci) * 512 + h * 128 + es * 32 + e] = a; }
        const float gl = GL[n]; float sn[8];
#pragma unroll
        for (int r = 0; r < 8; ++r) { const int dk = cc + 16 * r; float a = SST[dk * 33 + e] * gl;
#pragma unroll 8
            for (int ci = 0; ci < 64; ++ci) a += bf2f(KDL[ci * 128 + dk]) * VN[ci * 33 + e];
            sn[r] = a; }
        __syncthreads();
#pragma unroll
        for (int r = 0; r < 8; ++r) SST[(cc + 16 * r) * 33 + e] = sn[r];
    }
    __syncthreads();
}
__device__ __forceinline__ void gdn_finish_phase(const Ctx& c, int l) {
    const GAS float* GO = WSG(float, O_GO); const GAS bf16_t* P = WSG(bf16_t, O_PROJ); GAS bf16_t* YA = WSG(bf16_t, O_YA);
    const float nw0 = ING(9)[l * 128 + c.lane], nw1 = ING(9)[l * 128 + 64 + c.lane];
    for (int t = c.gw; t < T; t += c.NGW) {
#pragma unroll
        for (int h = 0; h < 4; ++h) { const float o0 = GO[(size_t)t * 512 + h * 128 + c.lane], o1 = GO[(size_t)t * 512 + h * 128 + 64 + c.lane];
            const float r = rsqrtf(wave_sum(o0 * o0 + o1 * o1) * (1.f / 128.f) + EPS);
            const float z0 = bf2f(P[(size_t)t * NP + C_GZ + h * 128 + c.lane]), z1 = bf2f(P[(size_t)t * NP + C_GZ + h * 128 + 64 + c.lane]);
            YA[(size_t)t * 512 + h * 128 + c.lane] = (bf16_t)f2bf(o0 * r * nw0 * siluf_(z0)); YA[(size_t)t * 512 + h * 128 + 64 + c.lane] = (bf16_t)f2bf(o1 * r * nw1 * siluf_(z1)); }
    }
}
__device__ __forceinline__ void ssd_prep_unit(const Ctx& c, int l, int unit) {
    const int grp = unit & 1, n = (unit >> 1) & 63, b = unit >> 7;
    const int t0 = b * SEQ + n * CH;
    LAS bf16_t* XT = (LAS bf16_t*)c.lds; LAS bf16_t* XTS = XT + 256 * 72; LAS bf16_t* BT = XTS + 256 * 72;
    LAS bf16_t* Bm = BT + 128 * 72; LAS bf16_t* Cm = Bm + 64 * 136;
    LAS float* DT = (LAS float*)(Cm + 64 * 136); LAS float* ACS = DT + 256; LAS float* SCV = ACS + 256;
    const GAS bf16_t* P = WSG(bf16_t, O_PROJ);
    if (c.wave < 4) { const int hq = c.wave, hh = grp * 4 + hq, t = c.lane;
        const float dt = softplusf_(WSG(float, O_SMALLF)[(size_t)(t0 + t) * 16 + 8 + hh] + ING(13)[l * 8 + hh]);
        float a = -expf(ING(12)[l * 8 + hh]) * dt;
#pragma unroll
        for (int o = 1; o < 64; o <<= 1) { const float up = __shfl_up(a, o); if (t >= o) a += up; }
        const float alast = __shfl(a, 63);
        DT[hq * 64 + t] = dt; ACS[hq * 64 + t] = a; SCV[hq * 64 + t] = dt * expf(alast - a); const float ea = expf(a); WSG(float, O_EA)[(size_t)(t0 + t) * 8 + hh] = ea;
        if (t == 63) WSG(float, O_DEC)[(b * 8 + hh) * 64 + n] = ea; }
    LDS_BARRIER();
    { const int ch = c.tid < 256 ? grp * 256 + c.tid : c.tid < 384 ? 512 + grp * 128 + (c.tid - 256) : 768 + grp * 128 + (c.tid - 384);
      const GAS float* cw = ING(10) + (size_t)l * 4 * 1024 + ch; const float w0 = cw[0], w1 = cw[1024], w2 = cw[2048], w3 = cw[3072], bias = ING(11)[l * 1024 + ch];
      const GAS bf16_t* src = P + (size_t)(t0 - 3) * NP + C_XBC + ch;
      unsigned short raw[67];
#pragma unroll
      for (int r = 0; r < 67; ++r) raw[r] = (n > 0 || r >= 3) ? src[(size_t)r * NP] : (unsigned short)0;
      const int hq = c.tid >> 6;
#pragma unroll
      for (int t8 = 0; t8 < 8; ++t8) { float y[8];
#pragma unroll
          for (int k = 0; k < 8; ++k) { const int t = t8 * 8 + k; y[k] = siluf_(w0 * bf2f(raw[t]) + w1 * bf2f(raw[t + 1]) + w2 * bf2f(raw[t + 2]) + w3 * bf2f(raw[t + 3]) + bias); }
          u32x4 o; o.x = pk2(y[0], y[1]); o.y = pk2(y[2], y[3]); o.z = pk2(y[4], y[5]); o.w = pk2(y[6], y[7]);
          if (c.tid < 256) { *(LAS u32x4*)(XT + c.tid * 72 + t8 * 8) = o; const LAS float* sv = SCV + hq * 64 + t8 * 8;
              u32x4 q; q.x = pk2(y[0] * sv[0], y[1] * sv[1]); q.y = pk2(y[2] * sv[2], y[3] * sv[3]); q.z = pk2(y[4] * sv[4], y[5] * sv[5]); q.w = pk2(y[6] * sv[6], y[7] * sv[7]);
              *(LAS u32x4*)(XTS + c.tid * 72 + t8 * 8) = q; }
          else if (c.tid < 384) { const int nn = c.tid - 256; *(LAS u32x4*)(BT + nn * 72 + t8 * 8) = o;
#pragma unroll
              for (int k = 0; k < 8; ++k) Bm[(t8 * 8 + k) * 136 + nn] = (bf16_t)f2bf(y[k]); }
          else { const int nn = c.tid - 384; GAS bf16_t* CC = WSG(bf16_t, O_SCC) + (size_t)t0 * 256 + grp * 128 + nn;
#pragma unroll
              for (int k = 0; k < 8; ++k) { const bf16_t v = (bf16_t)f2bf(y[k]); Cm[(t8 * 8 + k) * 136 + nn] = v; CC[(size_t)(t8 * 8 + k) * 256] = v; } } } }
    LDS_BARRIER();
    const int lr = c.lane & 15, g = c.lane >> 4;
    { const int tl = c.wave & 3, hp = c.wave >> 2, lcol = 16 * tl + lr;
      f32x4 cb[4];
#pragma unroll
      for (int ts = 0; ts < 4; ++ts) { cb[ts] = (f32x4){0.f, 0.f, 0.f, 0.f};
          if (ts <= tl) {
#pragma unroll
              for (int ks = 0; ks < 4; ++ks) cb[ts] = __builtin_amdgcn_mfma_f32_16x16x32_bf16(*(const LAS bf16x8*)(Bm + (16 * ts + lr) * 136 + 32 * ks + 8 * g), *(const LAS bf16x8*)(Cm + lcol * 136 + 32 * ks + 8 * g), cb[ts], 0, 0, 0); } }
#pragma unroll 1
      for (int hq = 2 * hp; hq < 2 * hp + 2; ++hq) { const int hh = grp * 4 + hq; const float dsk = ING(14)[l * 8 + hh], al = ACS[hq * 64 + lcol];
          f32x4 mt[4];
#pragma unroll
          for (int ts = 0; ts < 4; ++ts)
#pragma unroll
              for (int r = 0; r < 4; ++r) { const int sx = 16 * ts + 4 * g + r; float v = 0.f; if (sx <= lcol) v = cb[ts][r] * __expf(al - ACS[hq * 64 + sx]) * DT[hq * 64 + sx]; if (sx == lcol) v += dsk; mt[ts][r] = v; }
          bf16x8 mb[2];
#pragma unroll
          for (int k2 = 0; k2 < 2; ++k2) { u32x4 w; w.x = pk2(mt[2 * k2][0], mt[2 * k2][1]); w.y = pk2(mt[2 * k2][2], mt[2 * k2][3]); w.z = pk2(mt[2 * k2 + 1][0], mt[2 * k2 + 1][1]); w.w = pk2(mt[2 * k2 + 1][2], mt[2 * k2 + 1][3]); mb[k2] = __builtin_bit_cast(bf16x8, w); }
          GAS float* YP = WSG(float, O_SYP) + (size_t)(t0 + lcol) * 512 + hh * 64 + 4 * g;
#pragma unroll
          for (int tp = 0; tp < 4; ++tp) { f32x4 acc = {0.f, 0.f, 0.f, 0.f};
#pragma unroll
              for (int k2 = 0; k2 < 2; ++k2) { const LAS bf16_t* xp = XT + (hq * 64 + 16 * tp + lr) * 72 + 32 * k2 + 4 * g; const u32x2 lo = *(const LAS u32x2*)xp, hi = *(const LAS u32x2*)(xp + 16);
                  u32x4 w; w.x = lo.x; w.y = lo.y; w.z = hi.x; w.w = hi.y; acc = __builtin_amdgcn_mfma_f32_16x16x32_bf16(__builtin_bit_cast(bf16x8, w), mb[k2], acc, 0, 0, 0); }
              *(GAS f32x4*)(YP + 16 * tp) = acc; } } }
    { const int hq = c.wave >> 1, hh = grp * 4 + hq; GAS float* ST = WSG(float, O_SST) + ((size_t)((b * 8 + hh) * 64 + n)) * 8192;
#pragma unroll 1
      for (int tq = 0; tq < 4; ++tq) { const int tn = 4 * (c.wave & 1) + tq;
          const bf16x8 a0 = *(const LAS bf16x8*)(BT + (16 * tn + lr) * 72 + 8 * g), a1 = *(const LAS bf16x8*)(BT + (16 * tn + lr) * 72 + 32 + 8 * g);
#pragma unroll
          for (int tp = 0; tp < 4; ++tp) { f32x4 acc = {0.f, 0.f, 0.f, 0.f}; const LAS bf16_t* xp = XTS + (hq * 64 + 16 * tp + lr) * 72 + 8 * g;
              acc = __builtin_amdgcn_mfma_f32_16x16x32_bf16(a0, *(const LAS bf16x8*)xp, acc, 0, 0, 0); acc = __builtin_amdgcn_mfma_f32_16x16x32_bf16(a1, *(const LAS bf16x8*)(xp + 32), acc, 0, 0, 0);
              *(GAS f32x4*)(ST + (size_t)(16 * tp + lr) * 128 + 16 * tn + 4 * g) = acc; } } }
    LDS_BARRIER();
}
__device__ __forceinline__ void ssd_scan_phase(const Ctx& c) {
    const GAS float* ST = WSG(float, O_SST); const GAS float* DEC = WSG(float, O_DEC); GAS bf16_t* HB = WSG(bf16_t, O_MB);
    const int nthr = 128 * 448, me = c.wg * 448 + (c.tid - 64);
    for (int idx = me; idx < NB * 8 * 8192; idx += nthr) {
        const int bh = idx >> 13, el = idx & 8191; const GAS float* p = ST + (size_t)bh * 64 * 8192 + el; GAS bf16_t* hb = HB + (size_t)bh * 64 * 8192 + el; const GAS float* dc = DEC + bh * 64;
        float hcur = 0.f;
#pragma unroll 1
        for (int n0 = 0; n0 < 64; n0 += 32) { float s[32];
#pragma unroll
            for (int k = 0; k < 32; ++k) s[k] = p[(size_t)(n0 + k) * 8192];
#pragma unroll
            for (int k = 0; k < 32; ++k) { hb[(size_t)(n0 + k) * 8192] = (bf16_t)f2bf(hcur); hcur = hcur * dc[n0 + k] + s[k]; } }
    }
}
__device__ __forceinline__ void ssd_finish_unit(const Ctx& c, int l, int unit) {
    const int grp = unit & 1, n = (unit >> 1) & 63, b = unit >> 7;
    const int t0 = b * SEQ + n * CH;
    LAS float* YS = (LAS float*)c.lds;
    const GAS bf16_t* CC = WSG(bf16_t, O_SCC); const GAS float* EA = WSG(float, O_EA); const GAS float* YP = WSG(float, O_SYP);
    const int lr = c.lane & 15, g = c.lane >> 4;
    { const int hq = c.wave >> 1, hh = grp * 4 + hq; const GAS bf16_t* HB = WSG(bf16_t, O_MB) + ((size_t)((b * 8 + hh) * 64 + n)) * 8192;
      f32x4 acc[4][2];
#pragma unroll
      for (int tp = 0; tp < 4; ++tp) { acc[tp][0] = (f32x4){0.f, 0.f, 0.f, 0.f}; acc[tp][1] = (f32x4){0.f, 0.f, 0.f, 0.f}; }
#pragma unroll
      for (int ks = 0; ks < 4; ++ks) { bf16x8 cf[2];
#pragma unroll
          for (int q = 0; q < 2; ++q) cf[q] = *(const GAS bf16x8*)(CC + (size_t)(t0 + 16 * (2 * (c.wave & 1) + q) + lr) * 256 + grp * 128 + 32 * ks + 8 * g);
#pragma unroll
          for (int tp = 0; tp < 4; ++tp) { const bf16x8 pf = *(const GAS bf16x8*)(HB + (size_t)(16 * tp + lr) * 128 + 32 * ks + 8 * g);
              acc[tp][0] = __builtin_amdgcn_mfma_f32_16x16x32_bf16(pf, cf[0], acc[tp][0], 0, 0, 0); acc[tp][1] = __builtin_amdgcn_mfma_f32_16x16x32_bf16(pf, cf[1], acc[tp][1], 0, 0, 0); } }
#pragma unroll
      for (int q = 0; q < 2; ++q) { const int li = 16 * (2 * (c.wave & 1) + q) + lr; const float ea = EA[(size_t)(t0 + li) * 8 + hh];
#pragma unroll
          for (int tp = 0; tp < 4; ++tp) { const f32x4 yp = *(const GAS f32x4*)(YP + (size_t)(t0 + li) * 512 + hh * 64 + 16 * tp + 4 * g); const f32x4 y = yp + acc[tp][q] * ea;
              LAS float* d = YS + li * 260 + hq * 64 + 16 * tp + 4 * g; d[0] = y[0]; d[1] = y[1]; d[2] = y[2]; d[3] = y[3]; } } }
    LDS_BARRIER();
    const GAS bf16_t* P = WSG(bf16_t, O_PROJ); GAS bf16_t* YB = WSG(bf16_t, O_YB); const GAS float* nw = ING(15) + l * 512 + grp * 256;
    for (int li = c.wave; li < 64; li += NWAVES) { const int t = t0 + li; float y[4]; float ss = 0.f;
#pragma unroll
        for (int q = 0; q < 4; ++q) { const int ch = c.lane + 64 * q; const float z = bf2f(P[(size_t)t * NP + C_SZ + grp * 256 + ch]); y[q] = YS[li * 260 + ch] * siluf_(z); ss += y[q] * y[q]; }
        const float r = rsqrtf(wave_sum(ss) * (1.f / 256.f) + EPS);
#pragma unroll
        for (int q = 0; q < 4; ++q) { const int ch = c.lane + 64 * q; YB[(size_t)t * 512 + grp * 256 + ch] = (bf16_t)f2bf(y[q] * r * nw[ch]); } }
    LDS_BARRIER();
}

__device__ __forceinline__ void mla_rows_phase(const Ctx& c) {
    const GAS bf16_t* P = WSG(bf16_t, O_PROJ); const GAS float* ROPE = WSG(float, O_ROPE); GAS bf16_t* KR = WSG(bf16_t, O_KR);
    for (int t = c.gw; t < T; t += c.NGW) {
        const GAS bf16_t* pr = P + (size_t)t * NP;
        const u32x4 a = *(const GAS u32x4*)(pr + C_CQ + 8 * c.lane); const u32x2 k2 = *(const GAS u32x2*)(pr + C_CKV + 4 * c.lane);
        f32x4 a0, a1; unpk8(a, a0, a1);
        float sq = (a0[0] * a0[0] + a0[1] * a0[1]) + (a0[2] * a0[2] + a0[3] * a0[3]) + (a1[0] * a1[0] + a1[1] * a1[1]) + (a1[2] * a1[2] + a1[3] * a1[3]);
        const float k0 = lo16(k2.x), k1 = hi16(k2.x), k2f = lo16(k2.y), k3 = hi16(k2.y); float sk = (k0 * k0 + k1 * k1) + (k2f * k2f + k3 * k3);
        sq = wave_sum(sq); sk = wave_sum(sk);
        const float x = bf2f(pr[C_KR + c.lane]); const float xo = __shfl_xor(x, 32);
        if (c.lane == 0) { WSG(float, O_RQ)[t] = rsqrtf(sq * (1.f / 512.f) + EPS); WSG(float, O_RKV)[t] = rsqrtf(sk * (1.f / 256.f) + EPS); }
        if (c.lane < 32) { const float cs = ROPE[((size_t)t * 32 + c.lane) * 2], sn = ROPE[((size_t)t * 32 + c.lane) * 2 + 1];
            *(GAS unsigned*)(KR + (size_t)t * 64 + 2 * c.lane) = pk2(x * cs - xo * sn, xo * cs + x * sn); }
    }
}
__device__ __forceinline__ float xmax16(float v) { const auto r = __builtin_amdgcn_permlane16_swap(__float_as_uint(v), __float_as_uint(v), false, false); return fmaxf(__uint_as_float(r[0]), __uint_as_float(r[1])); }
__device__ __forceinline__ float xmax32(float v) { const auto r = __builtin_amdgcn_permlane32_swap(__float_as_uint(v), __float_as_uint(v), false, false); return fmaxf(__uint_as_float(r[0]), __uint_as_float(r[1])); }
__device__ __forceinline__ float xsum16(float v) { const auto r = __builtin_amdgcn_permlane16_swap(__float_as_uint(v), __float_as_uint(v), false, false); return __uint_as_float(r[0]) + __uint_as_float(r[1]); }
__device__ __forceinline__ float xsum32(float v) { const auto r = __builtin_amdgcn_permlane32_swap(__float_as_uint(v), __float_as_uint(v), false, false); return __uint_as_float(r[0]) + __uint_as_float(r[1]); }
__device__ __forceinline__ void attn_item(const Ctx& c, int item) {
    const int bh = item >> 4, qi = item & 15, b = bh >> 2, h = bh & 3;
    const GAS bf16_t* Q = WSG(bf16_t, O_Q); const GAS bf16_t* KN = WSG(bf16_t, O_KN); const GAS bf16_t* KR = WSG(bf16_t, O_KR); const GAS bf16_t* VT = WSG(bf16_t, O_VT); GAS bf16_t* YC = WSG(bf16_t, O_YC);
    const int lr = c.lane & 15, g = c.lane >> 4, sw = lr >> 1, swk = 2 * (lr >> 2) + ((lr >> 1) & 1), keyl = 8 * (lr >> 2) + (lr & 3);
    constexpr int KT_BYTES = 64 * 384, BUF_BYTES = KT_BYTES + 128 * 128;
    const char* kp[3]; int kstr[3]; const char* vp[2];
#pragma unroll
    for (int i = 0; i < 3; ++i) { const int ch = (3 * c.wave + i) * 64 + c.lane, key = ch / 24, pq = ch % 24, part = pq ^ (2 * ((key >> 3) & 3) + ((key >> 1) & 1)); const size_t tk = (size_t)(b * SEQ + key);
        if (part < 16) { kp[i] = (const char*)(KN + tk * 512 + h * 128 + part * 8); kstr[i] = 1024; } else { kp[i] = (const char*)(KR + tk * 64 + (part - 16) * 8); kstr[i] = 128; } }
#pragma unroll
    for (int i = 0; i < 2; ++i) { const int ch = (2 * c.wave + i) * 64 + c.lane, dv = ch >> 3, q8 = (ch & 7) ^ ((dv >> 1) & 7); vp[i] = (const char*)(VT + (size_t)(h * 128 + dv) * T + b * SEQ + q8 * 8); }
#define AT_DMA(kb_, buf_) do { LAS unsigned char* d_ = c.lds + (buf_) * BUF_BYTES; \
        _Pragma("unroll") for (int i_ = 0; i_ < 3; ++i_) __builtin_amdgcn_global_load_lds((const unsigned*)(kp[i_] + (size_t)(kb_) * kstr[i_]), (LAS unsigned*)(d_ + (3 * c.wave + i_) * 1024), 16, 0, 0); \
        _Pragma("unroll") for (int i_ = 0; i_ < 2; ++i_) __builtin_amdgcn_global_load_lds((const unsigned*)(vp[i_] + (size_t)(kb_) * 2), (LAS unsigned*)(d_ + KT_BYTES + (2 * c.wave + i_) * 1024), 16, 0, 0); } while (0)
    int koff[6], voff[2];
#pragma unroll
    for (int ks = 0; ks < 6; ++ks) koff[ks] = keyl * 384 + (((4 * ks + g) ^ swk) * 16);
#pragma unroll
    for (int pp = 0; pp < 2; ++pp) voff[pp] = lr * 128 + (((4 * pp + g) ^ sw) * 16);
#define AT_QK(dst_, buf_) do { const LAS unsigned char* Kt_ = c.lds + (buf_) * BUF_BYTES; \
        _Pragma("unroll") for (int a_ = 0; a_ < 4; ++a_) { dst_[a_] = (f32x4){0.f, 0.f, 0.f, 0.f}; \
            _Pragma("unroll") for (int ks_ = 0; ks_ < 6; ++ks_) dst_[a_] = __builtin_amdgcn_mfma_f32_16x16x32_bf16(*(const LAS bf16x8*)(Kt_ + ((a_ >> 1) * 32 + (a_ & 1) * 4) * 384 + koff[ks_]), qf[ks_], dst_[a_], 0, 0, 0); } } while (0)
#pragma unroll 1
    for (int half = 0; half < 2; ++half) {
        const int qb = half ? 31 - qi : qi; const int q0 = qb * 128 + c.wave * 16; const int tq = b * SEQ + q0 + lr;
        bf16x8 qf[6];
#pragma unroll
        for (int ks = 0; ks < 6; ++ks) qf[ks] = *(const GAS bf16x8*)(Q + (size_t)tq * 768 + h * 192 + 32 * ks + 8 * g);
        f32x4 o[8];
#pragma unroll
        for (int d = 0; d < 8; ++d) o[d] = (f32x4){0.f, 0.f, 0.f, 0.f};
        float mrow = -3.0e38f, lsum = 0.f;
        const int nkt = 2 * qb + 2;
        asm volatile("s_waitcnt vmcnt(0)" ::: "memory");
        LDS_BARRIER();
        AT_DMA(0, 0); AT_DMA(64, 1);
        asm volatile("s_waitcnt vmcnt(0)" ::: "memory"); LDS_BARRIER();
        f32x4 s[4], sn[4];
        AT_QK(s, 0);
#pragma unroll 1
        for (int kt = 0; kt < nkt; ++kt) {
            const int kbase = kt * 64; const int b0 = kt % 3, b1 = (kt + 1) % 3, b2 = (kt + 2) % 3;
            if (kt + 2 < nkt) AT_DMA(kbase + 128, b2);
            const bool act = kbase <= q0 + 15, actn = (kt + 1 < nkt) && (kbase + 64 <= q0 + 15);
            if (actn) AT_QK(sn, b1);
            if (act) {
                const LAS unsigned char* Vt = c.lds + b0 * BUF_BYTES + KT_BYTES;
                const int qpos = q0 + lr; float mx = -3.0e38f;
                if (kbase + 63 > q0) {
#pragma unroll
                    for (int a = 0; a < 4; ++a)
#pragma unroll
                        for (int r = 0; r < 4; ++r) { const int key = kbase + 32 * (a >> 1) + 8 * g + 4 * (a & 1) + r; if (key > qpos) s[a][r] = -3.0e38f; } }
#pragma unroll
                for (int a = 0; a < 4; ++a)
#pragma unroll
                    for (int r = 0; r < 4; ++r) mx = fmaxf(mx, s[a][r]);
                mx = xmax32(xmax16(mx));
                if (!__all(mx - mrow <= 8.f)) {
                    const float mnew = fmaxf(mrow, mx), alpha = __builtin_amdgcn_exp2f(mrow - mnew); mrow = mnew; lsum *= alpha;
#pragma unroll
                    for (int d = 0; d < 8; ++d) o[d] = o[d] * alpha; }
                float ps = 0.f;
#pragma unroll
                for (int a = 0; a < 4; ++a)
#pragma unroll
                    for (int r = 0; r < 4; ++r) { const float p = __builtin_amdgcn_exp2f(s[a][r] - mrow); s[a][r] = p; ps += p; }
                lsum += ps;
#pragma unroll
                for (int pp = 0; pp < 2; ++pp) { u32x4 pw; pw.x = pk2(s[2 * pp][0], s[2 * pp][1]); pw.y = pk2(s[2 * pp][2], s[2 * pp][3]); pw.z = pk2(s[2 * pp + 1][0], s[2 * pp + 1][1]); pw.w = pk2(s[2 * pp + 1][2], s[2 * pp + 1][3]);
                    const bf16x8 pf = __builtin_bit_cast(bf16x8, pw);
#pragma unroll
                    for (int d = 0; d < 8; ++d) o[d] = __builtin_amdgcn_mfma_f32_16x16x32_bf16(*(const LAS bf16x8*)(Vt + d * 2048 + voff[pp]), pf, o[d], 0, 0, 0); }
            }
            asm volatile("s_waitcnt vmcnt(0)" ::: "memory");
            LDS_BARRIER();
#pragma unroll
            for (int a = 0; a < 4; ++a) s[a] = sn[a];
        }
        lsum = xsum32(xsum16(lsum));
        const float inv = 1.f / lsum;
#pragma unroll
        for (int d = 0; d < 8; ++d) { u32x2 w; w.x = pk2(o[d][0] * inv, o[d][1] * inv); w.y = pk2(o[d][2] * inv, o[d][3] * inv);
            *(GAS u32x2*)(YC + (size_t)tq * 512 + h * 128 + 16 * d + 4 * g) = w; }
    }
#undef AT_DMA
#undef AT_QK
}
struct FProj { bf16_t* P; float* sf;
    __device__ __forceinline__ void oct(const pg8::Unit&, int row, int col, f32x4 v0, f32x4 v1) const {
        *(u32x4*)(P + (size_t)row * NP + col) = pk8(v0, v1);
        if (col >= C_SMALL && col < C_SMALL + 16) { float* d = sf + (size_t)row * 16 + (col - C_SMALL); *(f32x4*)d = v0; *(f32x4*)(d + 4) = v1; } } };
struct FQ { bf16_t* Q; const float* rq; const float* rope;
    __device__ __forceinline__ void oct(const pg8::Unit&, int row, int col, f32x4 v0, f32x4 v1) const {
        const float r = rq[row] * (0.07216878364870322f * 1.4426950408889634f); v0 = v0 * r; v1 = v1 * r;
        const int j = col % 192;
        if (j >= 128) { const float* cs = rope + ((size_t)row * 32 + ((j - 128) >> 1)) * 2; const f32x4 c0 = *(const f32x4*)cs, c1 = *(const f32x4*)(cs + 4);
            const f32x4 a = v0, bq = v1;
            v0[0] = a[0] * c0[0] - a[1] * c0[1]; v0[1] = a[1] * c0[0] + a[0] * c0[1]; v0[2] = a[2] * c0[2] - a[3] * c0[3]; v0[3] = a[3] * c0[2] + a[2] * c0[3];
            v1[0] = bq[0] * c1[0] - bq[1] * c1[1]; v1[1] = bq[1] * c1[0] + bq[0] * c1[1]; v1[2] = bq[2] * c1[2] - bq[3] * c1[3]; v1[3] = bq[3] * c1[2] + bq[2] * c1[3]; }
        *(u32x4*)(Q + (size_t)row * 768 + col) = pk8(v0, v1); } };
struct FKN { bf16_t* KN; const float* rkv;
    __device__ __forceinline__ void oct(const pg8::Unit&, int row, int col, f32x4 v0, f32x4 v1) const { const float r = rkv[row]; *(u32x4*)(KN + (size_t)row * 512 + col) = pk8(v0 * r, v1 * r); } };
struct FVT { bf16_t* VT; const float* rkv;
    __device__ __forceinline__ void oct(const pg8::Unit&, int row, int col, f32x4 v0, f32x4 v1) const { const f32x4 r0 = *(const f32x4*)(rkv + col), r1 = *(const f32x4*)(rkv + col + 4); *(u32x4*)(VT + (size_t)row * T + col) = pk8(v0 * r0, v1 * r1); } };
struct FMergeAll { const bf16_t* P; bf16_t* MB;
    __device__ __forceinline__ void oct(const pg8::Unit& u, int row, int col, f32x4 v0, f32x4 v1) const {
        f32x4 g0, g1; unpk8(*(const u32x4*)(P + (size_t)row * NP + C_GATE + u.kb * 1024 + col), g0, g1);
#pragma unroll
        for (int i = 0; i < 4; ++i) { v0[i] *= sigmoidf_(g0[i]); v1[i] *= sigmoidf_(g1[i]); }
        bf16_t* m = MB + (size_t)row * D + col;
        if (u.kb > 0) { f32x4 p0, p1; unpk8(*(const u32x4*)m, p0, p1); v0 = v0 + p0; v1 = v1 + p1; }
        *(u32x4*)m = pk8(v0, v1); } };
struct FRes { float* X; const float* Xs; const float* gate;
    __device__ __forceinline__ void oct(const pg8::Unit&, int row, int col, f32x4 v0, f32x4 v1) const {
        const float* g = gate + (size_t)(row >> 12) * 6144 + col; float* x = X + (size_t)row * D + col; const float* xs = Xs + (size_t)row * D + col;
        *(f32x4*)x = *(const f32x4*)xs + *(const f32x4*)g * v0; *(f32x4*)(x + 4) = *(const f32x4*)(xs + 4) + *(const f32x4*)(g + 4) * v1; } };
struct FGU { bf16_t* Hd; int ld;
    __device__ __forceinline__ void gu(const pg8::Unit&, int row, int fcol, f32x4 g0, f32x4 g1, f32x4 u0, f32x4 u1) const {
#pragma unroll
        for (int i = 0; i < 4; ++i) { g0[i] = siluf_(g0[i]) * u0[i]; g1[i] = siluf_(g1[i]) * u1[i]; }
        *(u32x4*)(Hd + (size_t)row * ld + fcol) = pk8(g0, g1); } };
struct FYT { float* YT; int row0;
    __device__ __forceinline__ void oct(const pg8::Unit& u, int row, int col, f32x4 v0, f32x4 v1) const { float* d = YT + (size_t)u.kb * (8 * 256 * 1024) + (size_t)(row - row0) * D + col;
        *(f32x4*)d = v0; *(f32x4*)(d + 4) = v1; } };
struct FY { bf16_t* Y;
    __device__ __forceinline__ void oct(const pg8::Unit&, int row, int col, f32x4 v0, f32x4 v1) const { *(u32x4*)(Y + (size_t)row * D + col) = pk8(v0, v1); } };

template <int SITE, class F, class Sched> __device__ __forceinline__ void run_gemm_oct(const Ctx& c, const pg8::Gemm& g, const Sched& S, const F& f) {
    if constexpr ((FASTMASK >> SITE) & 1u) { pg8::EpiOct<F> E{f}; pg8::gemm_phase<pg8::EpiOct<F>, Sched, true>(c.lds, g, S, E); }
    else pg8::gemm_simple_oct(g, S, f);
}
template <int SITE, class F, class Sched> __device__ __forceinline__ void run_gemm_gu(const Ctx& c, const pg8::Gemm& g, const Sched& S, const F& f) {
    if constexpr ((FASTMASK >> SITE) & 1u) { pg8::EpiGU<F> E{f}; pg8::gemm_phase<pg8::EpiGU<F>, Sched, true>(c.lds, g, S, E); }
    else pg8::gemm_simple_gu(g, S, f);
}

#ifndef PHMASK
#define PHMASK 0xFFFFFFFFu
#endif
#define ON(k) (((PHMASK) >> (k)) & 1u)
#ifndef REPMASK
#define REPMASK 0u
#endif
#define NREP(k) ((((REPMASK) >> (k)) & 1u) ? 2 : 1)
template <class P> __device__ __forceinline__ P* launder_ptr(P* p) {
    unsigned long long v = (unsigned long long)p; unsigned lo = (unsigned)v, hi = (unsigned)(v >> 32);
    asm volatile("" : "+v"(lo), "+v"(hi));
    lo = __builtin_amdgcn_readfirstlane(lo); hi = __builtin_amdgcn_readfirstlane(hi);
    return (P*)(((unsigned long long)hi << 32) | lo);
}
__device__ __forceinline__ LAS unsigned char* launder_lds(LAS unsigned char* p) { unsigned v = (unsigned)(uintptr_t)p; asm volatile("" : "+v"(v)); v = __builtin_amdgcn_readfirstlane(v); return (LAS unsigned char*)(uintptr_t)v; }
typedef const float* const __attribute__((address_space(4)))* kargp_t;
__device__ __forceinline__ kargp_t launder_kptr(kargp_t p) { unsigned long long v = (unsigned long long)p; unsigned lo = (unsigned)v, hi = (unsigned)(v >> 32);
    asm volatile("" : "+v"(lo), "+v"(hi)); lo = __builtin_amdgcn_readfirstlane(lo); hi = __builtin_amdgcn_readfirstlane(hi); return (kargp_t)(((unsigned long long)hi << 32) | lo); }
struct Args { const float* in[33]; float* out; unsigned char* ws; int ph_lo, ph_hi; };
constexpr int N_PHASES = 1 + NL * 10 + 2 + 1;

#define PHASE_BEGIN if (pc >= lo && pc < hi) { { int t_ = threadIdx.x; asm volatile("" : "+v"(t_) :: "memory"); c.tid = t_; c.lane = t_ & 63; c.wave = __builtin_amdgcn_readfirstlane(t_ >> 6); { unsigned g_ = gridDim.x, w_ = blockIdx.x; asm volatile("" : "+v"(g_), "+v"(w_)); c.G = __builtin_amdgcn_readfirstlane(g_); c.wg = __builtin_amdgcn_readfirstlane(w_); } c.gw = c.wg * NWAVES + c.wave; c.NGW = c.G * NWAVES; c.lds = launder_lds(c.lds); c.ws = launder_ptr(c.ws); c.in = launder_kptr(c.in); c.X = launder_ptr(c.X); }
#ifdef PROBE_BAR2
#define PHASE_END   if (pc + 1 < hi) { XcdBarrier b2_ = bar; b2_.bar = launder_ptr(bar.bar); xcd_barrier(b2_); xcd_barrier(b2_); } } ++pc;
#else
#define PHASE_END   if (pc + 1 < hi) { XcdBarrier b2_ = bar; b2_.bar = launder_ptr(bar.bar); xcd_barrier(b2_); } } ++pc;
#endif
template <int L> __device__ __forceinline__ void layer_body(Ctx& c, const int lo, const int hi, int& pc, const XcdBarrier& bar) {
        constexpr int l = L; constexpr bool moe = (L & 1) != 0; constexpr int fi = L >> 1;
        const float* MODL = WSP(float, O_MOD) + (size_t)l * 4 * 6144;
        PHASE_BEGIN if constexpr (ON(1)) { if (NREP(16) > 1) norm_phase(c, l, 0, -1, l == 0 ? c.in[0] : nullptr); norm_phase(c, l, 0, (l > 0 && ((l - 1) & 1)) ? l - 1 : -1, l == 0 ? c.in[0] : nullptr); } PHASE_END
        PHASE_BEGIN if constexpr (ON(2)) { pg8::Gemm g{WSP(bf16_t, O_H), WSP(bf16_t, O_WIN) + (size_t)l * NP * 1024, 1024, 1024, 1024}; pg8::StaticOrder S; S.init(T / 256, NP / 256, c.G, c.wg);
            for (int rep_ = 0; rep_ < NREP(27); ++rep_) run_gemm_oct<0>(c, g, S, FProj{WSP(bf16_t, O_PROJ), WSP(float, O_SMALLF)}); } PHASE_END
        PHASE_BEGIN
#ifdef GDNPREP_STOP
            for (int u = c.wg; u < NB * NCH * 4; u += c.G) gdn_prep_unit(c, l, u, GDNPREP_STOP);
#endif
            for (int rep_ = 0; rep_ < NREP(24); ++rep_) for (int u = c.wg; u < NB * NCH * 4; u += c.G) gdn_prep_unit(c, l, u);
            for (int rep_ = 0; rep_ < NREP(25); ++rep_) for (int u = c.wg; u < NB * NCH * 2; u += c.G) ssd_prep_unit(c, l, u);
            if constexpr (ON(3)) mla_rows_phase(c);
        PHASE_END
        PHASE_BEGIN
            if (c.wg < 128) {
                if (c.wave == 0) { for (int rep_ = 0; rep_ < NREP(20); ++rep_) gdn_scan_wave(c, (c.wg & 7) * 2 + (c.wg >> 6), (c.wg >> 3) & 7); }
                else { ssd_scan_phase(c);
                    { LAS float* scr = (LAS float*)(c.lds + 73728 + (c.wave - 1) * 8448); const int rank = c.wg * 7 + (c.wave - 1), count = 896 + (c.G - 128) * 8;
                      for (int r2_ = 0; r2_ < NREP(15); ++r2_) { if (moe) moe_convert_queue(c, l, scr); next_layer_convert_queue(c, l, scr); } } }
            } else {
                const int G2 = c.G - 128, w2 = c.wg - 128;
                for (int rep_ = 0; rep_ < NREP(18); ++rep_) {
                { pg8::Gemm g{WSP(bf16_t, O_PROJ) + C_CQ, WSP(bf16_t, O_WUQ) + (size_t)l * 768 * 512, 512, NP, 512}; pg8::StaticOrder S; S.init(T / 256, 3, G2, w2);
                  run_gemm_oct<1>(c, g, S, FQ{WSP(bf16_t, O_Q), WSP(float, O_RQ), WSP(float, O_ROPE)}); }
                { pg8::Gemm g{WSP(bf16_t, O_PROJ) + C_CKV, WSP(bf16_t, O_WUK) + (size_t)l * 512 * 256, 256, NP, 256}; pg8::StaticOrder S; S.init(T / 256, 2, G2, w2);
                  run_gemm_oct<2>(c, g, S, FKN{WSP(bf16_t, O_KN), WSP(float, O_RKV)}); }
                { pg8::Gemm g{WSP(bf16_t, O_WUV) + (size_t)l * 512 * 256, WSP(bf16_t, O_PROJ) + C_CKV, 256, 256, NP}; pg8::StaticOrder S; S.init(2, T / 256, G2, w2);
                  run_gemm_oct<3>(c, g, S, FVT{WSP(bf16_t, O_VT), WSP(float, O_RKV)}); } }
                { LAS float* scr = (LAS float*)(c.lds + c.wave * 8448); const int rank = 896 + w2 * 8 + c.wave, count = 896 + G2 * 8;
                  for (int r2_ = 0; r2_ < NREP(15); ++r2_) { if (moe) moe_convert_queue(c, l, scr); next_layer_convert_queue(c, l, scr); } }
            }
        PHASE_END
        PHASE_BEGIN
            for (int rep_ = 0; rep_ < NREP(21); ++rep_) for (int it = c.wg; it < 256; it += c.G) attn_item(c, (it & 7) * 32 + (it >> 3));
            for (int rep_ = 0; rep_ < NREP(22); ++rep_) gdn_out_phase(c, l);
            for (int rep_ = 0; rep_ < NREP(23); ++rep_) for (int u = c.wg; u < NB * NCH * 2; u += c.G) ssd_finish_unit(c, l, u);
        PHASE_END
        PHASE_BEGIN for (int rep_ = 0; rep_ < NREP(19); ++rep_) { pg8::BranchOrder S; S.base.init(T / 256, 4, c.G, c.wg); S.nbr = 3; S.astride = (long)(O_YB - O_YA) / 2; S.bstride = (long)1024 * 512;
            pg8::Gemm g{WSP(bf16_t, O_YA), WSP(bf16_t, O_WBR) + (size_t)l * 3 * 1024 * 512, 512, 512, 512};
            run_gemm_oct<4>(c, g, S, FMergeAll{WSP(bf16_t, O_PROJ), WSP(bf16_t, O_MB)}); } PHASE_END
        PHASE_BEGIN if constexpr (ON(7)) { pg8::Gemm g{WSP(bf16_t, O_MB), WSP(bf16_t, O_WOUT) + (size_t)l * 1024 * 1024, 1024, 1024, 1024}; pg8::StaticOrder S; S.init(T / 256, 4, c.G, c.wg);
            if (NREP(17) > 1) run_gemm_oct<7>(c, g, S, FRes{WSP(float, O_MF), l == 0 ? c.in[0] : c.X, MODL + 2048}); run_gemm_oct<7>(c, g, S, FRes{c.X, l == 0 ? c.in[0] : c.X, MODL + 2048}); } PHASE_END
        PHASE_BEGIN if constexpr (ON(8)) { for (int rep_ = 0; rep_ < NREP(16); ++rep_) { if (moe) norm2_moe_phase(c, l); else norm_phase(c, l, 1, -1); } } PHASE_END
        if (moe) { PHASE_BEGIN for (int rep_ = 0; rep_ < NREP(28); ++rep_) moe_assign_phase(c, l); PHASE_END }
        PHASE_BEGIN if constexpr (ON(10)) {
            if (!moe) { pg8::Gemm g{WSP(bf16_t, O_H), WSP(bf16_t, O_WGU) + (size_t)fi * 2 * FF * 1024, 1024, 1024, 1024}; pg8::StaticOrder S; S.init(T / 256, 2 * FF / 256, c.G, c.wg);
                for (int rep_ = 0; rep_ < NREP(29); ++rep_) run_gemm_gu<8>(c, g, S, FGU{WSP(bf16_t, O_PROJ), FF}); }
            else { pg8::Gemm g{WSP(bf16_t, O_XS), WSP(bf16_t, O_WEGU), 1024, 1024, 1024}; pg8::MoeOrder S{WSP(int, O_BLKE), *WSP(int, O_NBLK), 2 * EF / 256, c.G, c.wg, (long)2 * EF * 1024};
                for (int rep_ = 0; rep_ < NREP(30); ++rep_) run_gemm_gu<10>(c, g, S, FGU{WSP(bf16_t, O_PROJ), EF}); }
        } PHASE_END
        PHASE_BEGIN if constexpr (ON(11)) {
            if (!moe) { pg8::Gemm g{WSP(bf16_t, O_PROJ), WSP(bf16_t, O_WDN) + (size_t)fi * 1024 * FF, FF, FF, FF}; pg8::StaticOrder S; S.init(T / 256, 4, c.G, c.wg);
                if (NREP(17) > 1) run_gemm_oct<9>(c, g, S, FRes{WSP(float, O_MF), c.X, MODL + 5120}); run_gemm_oct<9>(c, g, S, FRes{c.X, c.X, MODL + 5120}); }
            else { const int nblk = *WSP(int, O_NBLK), nmainb = WSP(int, O_NBLK)[1];
                { pg8::Gemm g{WSP(bf16_t, O_PROJ), WSP(bf16_t, O_WEDN), EF, EF, EF}; pg8::MoeOrder S{WSP(int, O_BLKE), nmainb, 4, c.G, c.wg, (long)1024 * EF};
                  for (int rep_ = 0; rep_ < NREP(31); ++rep_) run_gemm_oct<11>(c, g, S, FY{WSP(bf16_t, O_YS)}); }
                { pg8::Gemm g{WSP(bf16_t, O_PROJ), WSP(bf16_t, O_WEDN), 512, EF, EF}; pg8::MoeTailOrder S{WSP(int, O_BLKE), nmainb, nblk - nmainb, 7, 512, c.G, c.wg, (long)1024 * EF};
                  run_gemm_oct<12>(c, g, S, FYT{WSP(float, O_MF), nmainb * 256}); } }
        } PHASE_END
    }

__global__ void __launch_bounds__(NTHR, 2) mk_fwd(Args args) {
    extern __shared__ __attribute__((aligned(16))) unsigned char lds_raw[];
    Ctx c;
    c.lds = (LAS unsigned char*)lds_raw;
    c.tid = threadIdx.x; c.lane = c.tid & 63; c.wave = __builtin_amdgcn_readfirstlane(c.tid >> 6);
    c.G = gridDim.x; c.wg = blockIdx.x; c.gw = c.wg * NWAVES + c.wave; c.NGW = c.G * NWAVES;
    c.in = (const float* const __attribute__((address_space(4)))*)__builtin_amdgcn_kernarg_segment_ptr(); c.X = args.out; c.ws = args.ws;
    volatile LAS unsigned* MISC = (volatile LAS unsigned*)(c.lds + LDSCTL_OFF);
    for (int u = c.tid; u < 128; u += NTHR) MISC[u] = 0u;
    __syncthreads();
    const int lo = args.ph_lo, hi = args.ph_hi;
    XcdBarrier bar; bar.bar = (unsigned*)(c.ws + O_CTL) + 1024 + (size_t)(lo & 63) * XCD_BAR_WORDS; bar.x = 0; bar.st = MISC + 8;
    if (hi - lo > 1) bar = xcd_barrier_post(bar.bar, MISC + 8);
    int pc = 0;

    PHASE_BEGIN for (int rep_ = 0; rep_ < NREP(26); ++rep_) p0_prologue(c); PHASE_END

    layer_body<0>(c, lo, hi, pc, bar); layer_body<1>(c, lo, hi, pc, bar); layer_body<2>(c, lo, hi, pc, bar); layer_body<3>(c, lo, hi, pc, bar);
    PHASE_BEGIN if constexpr (ON(12)) final_phase(c, NL - 1); PHASE_END
#undef PHASE_BEGIN
#undef PHASE_END
}

extern "C" void kernel_launch(void* const* d_in, const int* in_sizes, int n_in, void* d_out, int out_size, void* d_ws, size_t ws_size, hipStream_t stream) {
    static int grid = 0;
    if (grid == 0) {
        if (n_in != 33 || out_size != T * D || ws_size < WS_END) { fprintf(stderr, "kernel_launch: unexpected shapes (n_in %d out %d ws %zu need %zu)\n", n_in, out_size, ws_size, (size_t)WS_END); grid = -1; return; }
        int dev = 0, cus = 0, per_cu = 0;
        if (hipGetDevice(&dev) != hipSuccess || hipDeviceGetAttribute(&cus, hipDeviceAttributeMultiprocessorCount, dev) != hipSuccess) { grid = -1; return; }
        if (hipFuncSetAttribute((const void*)mk_fwd, hipFuncAttributeMaxDynamicSharedMemorySize, LDS_BYTES) != hipSuccess) { fprintf(stderr, "kernel_launch: hipFuncSetAttribute failed\n"); grid = -1; return; }
        if (hipOccupancyMaxActiveBlocksPerMultiprocessor(&per_cu, (const void*)mk_fwd, NTHR, LDS_BYTES) != hipSuccess || per_cu < 1) fprintf(stderr, "kernel_launch: occupancy query reports %d\n", per_cu);
        (void)hipGetLastError();
        grid = cus < 256 ? cus : 256;
        while (T % grid) --grid;
    }
    if (grid < 0) return;
    (void)hipMemsetAsync((char*)d_ws + O_CTL, 0, CTL_BYTES, stream);
    Args a{};
    for (int i = 0; i < 33; ++i) a.in[i] = (const float*)d_in[i];
    a.out = (float*)d_out; a.ws = (unsigned char*)d_ws;
#if N_LAUNCH_MODE == 1
    a.ph_lo = 0; a.ph_hi = N_PHASES;
    hipLaunchKernelGGL(mk_fwd, dim3(grid), dim3(NTHR), LDS_BYTES, stream, a);
#else
    for (int p = 0; p < N_PHASES; ++p) { a.ph_lo = p; a.ph_hi = p + 1; hipLaunchKernelGGL(mk_fwd, dim3(grid), dim3(NTHR), LDS_BYTES, stream, a); }
#endif
}
```

```cpp
#include <hip/hip_runtime.h>
#include <cstdio>
#include <cstdint>

#define GAS __attribute__((address_space(1)))
#define LAS __attribute__((address_space(3)))
typedef unsigned short bf16_t;
typedef short bf16x8 __attribute__((ext_vector_type(8)));
typedef short bf16x4 __attribute__((ext_vector_type(4)));
typedef float f32x4 __attribute__((ext_vector_type(4)));
typedef float f32x2 __attribute__((ext_vector_type(2)));
typedef unsigned u32x4 __attribute__((ext_vector_type(4)));
typedef unsigned u32x2 __attribute__((ext_vector_type(2)));

#ifndef FASTMASK
#define FASTMASK 0xFFFFFFFFu
#endif
#ifndef N_LAUNCH_MODE
#define N_LAUNCH_MODE 1
#endif

constexpr int T = 16384, D = 1024, NB = 4, SEQ = 4096, NL = 4, NCH = 64, CH = 64;
constexpr int NP = 7680;
constexpr int C_QKV = 0, C_GZ = 1536, C_SZ = 2048, C_XBC = 2560, C_CQ = 3584, C_CKV = 4096, C_KR = 4352, C_SMALL = 4416, C_GATE = 4608;
constexpr int FF = 2816, EF = 3584, NE = 8, NSLOT = 34560  ;
constexpr float EPS = 1e-6f;
constexpr int NWAVES = 8, NTHR = 512;

constexpr size_t MiB = 1u << 20;
constexpr size_t O_CTL = 0, CTL_BYTES = 1 * MiB;
constexpr size_t O_MOD = 1 * MiB;
constexpr size_t O_ROPE = 2 * MiB;
constexpr size_t O_RQ = 6 * MiB, O_RKV = O_RQ + 65536;
constexpr size_t O_SMALLF = 7 * MiB;
constexpr size_t O_TOPE = 8 * MiB, O_TOPW = O_TOPE + 65536, O_WGCNT = O_TOPW + 131072, O_TOKSLOT = O_WGCNT + 8192, O_BLKE = O_TOKSLOT + 131072, O_NBLK = O_BLKE + 1024;
constexpr size_t O_GL = 9 * MiB, O_DEC = O_GL + 4096, O_EA = O_DEC + 8192;
constexpr size_t O_WIN = 10 * MiB, O_WUQ = 70 * MiB, O_WUK = 73 * MiB, O_WUV = 74 * MiB, O_WBR = 75 * MiB, O_WOUT = 87 * MiB, O_WGU = 95 * MiB, O_WDN = 117 * MiB,
                 O_WEGU = 128 * MiB, O_WEDN = 240 * MiB;
constexpr size_t O_H = 296 * MiB;
constexpr size_t O_PROJ = 328 * MiB;
constexpr size_t O_KR = 568 * MiB, O_Q = 570 * MiB, O_KN = 594 * MiB, O_VT = 610 * MiB;
constexpr size_t O_YA = 626 * MiB, O_YB = 642 * MiB, O_YC = 658 * MiB;
constexpr size_t O_GU = 674 * MiB, O_GW = 706 * MiB, O_GQD = 722 * MiB, O_GKD = 738 * MiB, O_GQK = 754 * MiB, O_GO = 762 * MiB;
constexpr size_t O_YS = O_GU;
constexpr size_t O_SYP = 794 * MiB, O_SST = 826 * MiB, O_SCC = 890 * MiB;
constexpr size_t O_XS = O_SYP;
constexpr size_t O_MF = 898 * MiB, O_MB = 962 * MiB, WS_END = 994 * MiB;
static_assert((size_t)NSLOT * EF * 2 <= 240 * MiB && (size_t)NSLOT * 1024 * 2 <= 96 * MiB, "overlays");

constexpr int SCR_BYTES = 159744;
constexpr int LDSCTL_OFF = SCR_BYTES, LDS_BYTES = SCR_BYTES + 512;

#define LDS_WAIT() asm volatile("s_waitcnt lgkmcnt(0)" ::: "memory")
#define VM_WAIT() asm volatile("s_waitcnt vmcnt(0)" ::: "memory")
#define LDS_BARRIER() do { asm volatile("s_waitcnt lgkmcnt(0)" ::: "memory"); __builtin_amdgcn_s_barrier(); asm volatile("" ::: "memory"); } while (0)

__device__ __forceinline__ float bf2f(unsigned b) { return __uint_as_float(b << 16); }
__device__ __forceinline__ unsigned f2bf(float f) { unsigned r; asm("v_cvt_pk_bf16_f32 %0, %1, %1" : "=v"(r) : "v"(f)); return r & 0xffffu; }
__device__ __forceinline__ unsigned pk2(float lo, float hi) { unsigned r; asm("v_cvt_pk_bf16_f32 %0, %1, %2" : "=v"(r) : "v"(lo), "v"(hi)); return r; }
__device__ __forceinline__ float lo16(unsigned w) { return __uint_as_float(w << 16); }
__device__ __forceinline__ float hi16(unsigned w) { return __uint_as_float(w & 0xffff0000u); }
__device__ __forceinline__ unsigned pk2_sw(float a, float b) { unsigned ua = __float_as_uint(a), ub = __float_as_uint(b); ua += 0x7fffu + ((ua >> 16) & 1u); ub += 0x7fffu + ((ub >> 16) & 1u); return (ua >> 16) | (ub & 0xffff0000u); }
__device__ __forceinline__ u32x4 pk8(f32x4 a, f32x4 b) { u32x4 w; w.x = pk2(a[0], a[1]); w.y = pk2(a[2], a[3]); w.z = pk2(b[0], b[1]); w.w = pk2(b[2], b[3]); return w; }
__device__ __forceinline__ void unpk8(u32x4 w, f32x4& a, f32x4& b) { a = (f32x4){lo16(w.x), hi16(w.x), lo16(w.y), hi16(w.y)}; b = (f32x4){lo16(w.z), hi16(w.z), lo16(w.w), hi16(w.w)}; }
__device__ __forceinline__ float sigmoidf_(float x) { return __builtin_amdgcn_rcpf(1.f + __builtin_amdgcn_exp2f(x * -1.4426950408889634f)); }
__device__ __forceinline__ float siluf_(float x) { return x * __builtin_amdgcn_rcpf(1.f + __builtin_amdgcn_exp2f(x * -1.4426950408889634f)); }
__device__ __forceinline__ float softplusf_(float x) { return x > 20.f ? x : log1pf(expf(x)); }
#define DPP_ADD(v_, ctrl_) ((v_) + __builtin_bit_cast(float, __builtin_amdgcn_update_dpp(0, __builtin_bit_cast(int, (v_)), (ctrl_), 0xF, 0xF, true)))
__device__ __forceinline__ float row16_sum(float v) {
    v = DPP_ADD(v, 0xB1); v = DPP_ADD(v, 0x4E); v = DPP_ADD(v, 0x141); v = DPP_ADD(v, 0x140); return v;
}
__device__ __forceinline__ float wave_sum(float v) {
    v = row16_sum(v);
    { const auto r = __builtin_amdgcn_permlane16_swap(__float_as_uint(v), __float_as_uint(v), false, false); v = __uint_as_float(r[0]) + __uint_as_float(r[1]); }
    { const auto r = __builtin_amdgcn_permlane32_swap(__float_as_uint(v), __float_as_uint(v), false, false); v = __uint_as_float(r[0]) + __uint_as_float(r[1]); }
    return v;
}
namespace pg8 {
constexpr int BM = 256, BK = 64, HALF = 128, HTB = HALF * BK * 2, STAGE_BYTES = 8 * HTB, NXCD = 8, WGM = 8;
__host__ __device__ __forceinline__ int lds_byte(int r, int c) { const int st = (r >> 4) * 2 + (c >> 5), rr = r & 15, cc = c & 31, ob = rr * 64 + cc * 2; return st * 1024 + (ob ^ (((ob >> 9) & 1) << 5)); }
__host__ __device__ __forceinline__ void stage_rc(int b, int& R, int& C) { const int st = b / 1024, sb = b % 1024, swz = sb ^ (((sb >> 9) & 1) << 5); R = (st >> 1) * 16 + swz / 64; C = (st & 1) * 32 + (swz % 64) / 2; }
__host__ __device__ __forceinline__ int perm32(int rho) { const int n = rho >> 4, i = rho & 15; return 8 * (i >> 2) + 4 * n + (i & 3); }

struct Unit { int pm, pn; long boff, aoff; int kb; };
struct Gemm { const bf16_t* A; const bf16_t* Bt; int K, lda, ldb; };

struct StaticOrder {
    int nM, nN, nwg, G, c;
    __device__ void init(int nM_, int nN_, int G_, int c_) { nM = nM_; nN = nN_; nwg = nM * nN; G = G_; c = c_; }
    __device__ bool next(int i, Unit& u) const {
        const long L = (long)i * G + c; if (L >= nwg) return false;
        int wgid = (int)L; { const int q = nwg / NXCD, r = nwg % NXCD, xcd = wgid % NXCD, off = wgid / NXCD; wgid = (xcd < r ? xcd * (q + 1) : r * (q + 1) + (xcd - r) * q) + off; }
        const int nig = WGM * nN, gid = wgid / nig, fm = gid * WGM, gsz = (nM - fm) < WGM ? (nM - fm) : WGM;
        u.pm = fm + ((wgid % nig) % gsz); u.pn = (wgid % nig) / gsz; u.boff = 0; u.aoff = 0; u.kb = 0; return true;
    }
};
struct MoeOrder {
    const int* blke; int nblk, nN, G, c; long estride;
    __device__ bool next(int i, Unit& u) const {
        const long L = (long)i * G + c; if (L >= (long)nblk * nN) return false;
        const int j = (int)(L / nN); u.pm = j; u.pn = (int)(L % nN); u.boff = (long)blke[j] * estride; u.aoff = 0; u.kb = 0; return true;
    }
};

struct MoeTailOrder {
    const int* blke; int j0, ntail, nks, kslice, G, c; long estride;
    __device__ bool next(int i, Unit& u) const {
        const int L = i * G + c; if (L >= ntail * 4 * nks) return false;
        const int ks = L % nks, t = L / nks; u.pm = j0 + (t >> 2); u.pn = t & 3; u.kb = ks; u.aoff = (long)ks * kslice; u.boff = (long)blke[u.pm] * estride + (long)ks * kslice; return true;
    }
};
struct BranchOrder {
    StaticOrder base; int nbr; long astride, bstride;
    __device__ bool next(int i, Unit& u) const { const int rd = i / nbr, br = i - rd * nbr; if (!base.next(rd, u)) return false; u.kb = br; u.aoff = (long)br * astride; u.boff = (long)br * bstride; return true; }
};

template <class Epi, class Sched, bool ALIGN_EPI>
__device__ __forceinline__ void gemm_phase(LAS unsigned char* lds, const Gemm g, const Sched& S, const Epi& E) {
    int tid_ = threadIdx.x; asm volatile("" : "+v"(tid_) :: "memory");
    const int tid = tid_, wid = __builtin_amdgcn_readfirstlane(tid >> 6), lane = tid & 63, wr = wid >> 2, wc = wid & 3, fr = lane & 15, fq = lane >> 4;
    const int K = g.K, nt = K / BK;
    unsigned voffA[2], voffB[2];
#pragma unroll
    for (int i = 0; i < 2; ++i) { int R, C; stage_rc(tid * 16 + i * 8192, R, C); const int Rb = Epi::PERM ? ((R & ~31) + perm32(R & 31)) : R;
        voffA[i] = (unsigned)(R * g.lda + C) * 2u; voffB[i] = (unsigned)(Rb * g.ldb + C) * 2u; }
    const size_t kstep = (size_t)(BK * 2);
    const size_t hstepA = (size_t)HALF * g.lda * 2, hstepB = (size_t)HALF * g.ldb * 2;
    const size_t tstepA = 2 * hstepA, tstepB = 2 * hstepB;
    const unsigned ldsw = (unsigned)wid * 1024u;
    const int aoff = lds_byte(wr * 64 + fr, fq * 8), boff = lds_byte(wc * 32 + fr, fq * 8);
#define PG8_SA(b, h) (((b) * 2 + (h)) * HTB)
#define PG8_SB(b, h) ((4 + (b) * 2 + (h)) * HTB)
#define PG8_STAGE(bufoff, gbase, voff) do { _Pragma("unroll") for (int _i = 0; _i < 2; ++_i) \
        __builtin_amdgcn_global_load_lds((const unsigned*)((const char*)(gbase) + (voff)[_i]), (LAS unsigned*)(lds + (bufoff) + ldsw + _i * 8192), 16, 0, 0); } while (0)
#define PG8_LDA(dst, b, h) do { _Pragma("unroll") for (int m = 0; m < 4; ++m) _Pragma("unroll") for (int k = 0; k < 2; ++k) dst[m][k] = *(const LAS bf16x8*)(lds + PG8_SA(b, h) + aoff + m * 2048 + k * 1024); } while (0)
#define PG8_LDB(dst, b, h) do { _Pragma("unroll") for (int n = 0; n < 2; ++n) _Pragma("unroll") for (int k = 0; k < 2; ++k) dst[n][k] = *(const LAS bf16x8*)(lds + PG8_SB(b, h) + boff + n * 2048 + k * 1024); } while (0)
#define PG8_MMA(ai, bj, At, Bt) do { __builtin_amdgcn_s_setprio(1); _Pragma("unroll") for (int m = 0; m < 4; ++m) _Pragma("unroll") for (int n = 0; n < 2; ++n) _Pragma("unroll") for (int k = 0; k < 2; ++k) \
        acc[ai][bj][m][n] = __builtin_amdgcn_mfma_f32_16x16x32_bf16(Bt[n][k], At[m][k], acc[ai][bj][m][n], 0, 0, 0); __builtin_amdgcn_s_setprio(0); } while (0)
#define PG8_WAIT_V(n) asm volatile("s_waitcnt vmcnt(" #n ")" ::: "memory")
#define PG8_WAIT_L(n) asm volatile("s_waitcnt lgkmcnt(" #n ")" ::: "memory")
#define PG8_BAR __builtin_amdgcn_s_barrier()
#define PG8_SCHED __builtin_amdgcn_sched_barrier(0)
    Unit cur, nxt; int ui = 0;
    if (!S.next(0, cur)) return;
    f32x4 acc[2][2][4][2];
#pragma unroll
    for (int a = 0; a < 2; ++a)
#pragma unroll
        for (int b = 0; b < 2; ++b)
#pragma unroll
            for (int m = 0; m < 4; ++m)
#pragma unroll
                for (int n = 0; n < 2; ++n) acc[a][b][m][n] = (f32x4){0.f, 0.f, 0.f, 0.f};
    bf16x8 At[4][2], B0[2][2], B1[2][2];
    const char* cA = (const char*)(g.A + cur.aoff) + (size_t)cur.pm * tstepA; const char* cB = (const char*)(g.Bt + cur.boff) + (size_t)cur.pn * tstepB;
    PG8_STAGE(PG8_SB(0, 0), cB, voffB); PG8_STAGE(PG8_SB(0, 1), cB + hstepB, voffB); PG8_STAGE(PG8_SA(0, 0), cA, voffA); PG8_STAGE(PG8_SA(0, 1), cA + hstepA, voffA);
    if (wr == 1) PG8_BAR;
    PG8_WAIT_V(2); PG8_BAR;
    PG8_STAGE(PG8_SB(1, 0), cB + kstep, voffB); PG8_STAGE(PG8_SA(1, 0), cA + kstep, voffA); PG8_STAGE(PG8_SB(1, 1), cB + hstepB + kstep, voffB);
    PG8_WAIT_V(6); PG8_BAR;
    for (;;) {
        const bool has_next = S.next(ui + 1, nxt);
        const char* nA = has_next ? (const char*)(g.A + nxt.aoff) + (size_t)nxt.pm * tstepA : cA; const char* nB = has_next ? (const char*)(g.Bt + nxt.boff) + (size_t)nxt.pn * tstepB : cB;
        for (int t = 0; t < nt; t += 2) {
            const bool last = (t == nt - 2);
            const char* a1 = cA + (size_t)(t + 1) * kstep;
            const char* a2 = last ? nA : cA + (size_t)(t + 2) * kstep; const char* b2 = last ? nB : cB + (size_t)(t + 2) * kstep;
            const char* a3 = a2 + kstep; const char* b3 = b2 + kstep;
            PG8_LDB(B0, 0, 0); PG8_LDB(B1, 0, 1); PG8_SCHED; PG8_LDA(At, 0, 0); PG8_STAGE(PG8_SA(1, 1), a1 + hstepA, voffA);
            PG8_WAIT_V(8); PG8_WAIT_L(0); PG8_BAR; PG8_MMA(0, 0, At, B0); PG8_MMA(0, 1, At, B1); PG8_BAR; PG8_SCHED;
            PG8_LDA(At, 0, 1); PG8_STAGE(PG8_SB(0, 0), b2, voffB); PG8_STAGE(PG8_SB(0, 1), b2 + hstepB, voffB); PG8_STAGE(PG8_SA(0, 0), a2, voffA);
            PG8_WAIT_V(8); PG8_WAIT_L(0); PG8_BAR; PG8_MMA(1, 0, At, B0); PG8_MMA(1, 1, At, B1); PG8_BAR; PG8_SCHED;
            PG8_LDB(B0, 1, 0); PG8_LDB(B1, 1, 1); PG8_SCHED; PG8_LDA(At, 1, 0); PG8_STAGE(PG8_SA(0, 1), a2 + hstepA, voffA);
            PG8_WAIT_V(8); PG8_WAIT_L(0); PG8_BAR; PG8_MMA(0, 0, At, B0); PG8_MMA(0, 1, At, B1); PG8_BAR; PG8_SCHED;
            PG8_LDA(At, 1, 1); PG8_STAGE(PG8_SB(1, 0), b3, voffB); PG8_STAGE(PG8_SB(1, 1), b3 + hstepB, voffB); PG8_STAGE(PG8_SA(1, 0), a3, voffA);
            PG8_WAIT_V(8); PG8_WAIT_L(0); PG8_BAR; PG8_MMA(1, 0, At, B0); PG8_MMA(1, 1, At, B1); PG8_BAR; PG8_SCHED;
        }
        if constexpr (ALIGN_EPI) { if (wr == 0) PG8_BAR; }
        E(acc, cur, wr, wc, fr, fq);
        if (!has_next) break;
#pragma unroll
        for (int a = 0; a < 2; ++a)
#pragma unroll
            for (int b = 0; b < 2; ++b)
#pragma unroll
                for (int m = 0; m < 4; ++m)
#pragma unroll
                    for (int n = 0; n < 2; ++n) acc[a][b][m][n] = (f32x4){0.f, 0.f, 0.f, 0.f};
        cur = nxt; cA = nA; cB = nB; ++ui;
        if constexpr (ALIGN_EPI) { if (wr == 1) PG8_BAR; }
    }
    PG8_WAIT_V(0);
    if constexpr (!ALIGN_EPI) { if (wr == 0) PG8_BAR; }
    PG8_BAR;
#undef PG8_SA
#undef PG8_SB
#undef PG8_STAGE
#undef PG8_LDA
#undef PG8_LDB
#undef PG8_MMA
#undef PG8_WAIT_V
#undef PG8_WAIT_L
#undef PG8_BAR
#undef PG8_SCHED
}

template <class F> struct EpiOct {
    static constexpr bool PERM = true; F f;
    __device__ __forceinline__ void operator()(const f32x4 (&acc)[2][2][4][2], const Unit& u, int wr, int wc, int fr, int fq) const {
#pragma unroll
        for (int ai = 0; ai < 2; ++ai)
#pragma unroll
            for (int m = 0; m < 4; ++m) { const int row = u.pm * BM + ai * HALF + wr * 64 + m * 16 + fr;
#pragma unroll
                for (int bj = 0; bj < 2; ++bj) f.oct(u, row, u.pn * BM + bj * HALF + wc * 32 + 8 * fq, acc[ai][bj][m][0], acc[ai][bj][m][1]);
                if (m & 1) asm volatile("" ::: "memory"); }
    }
};
template <class F> struct EpiGU {
    static constexpr bool PERM = true; F f;
    __device__ __forceinline__ void operator()(const f32x4 (&acc)[2][2][4][2], const Unit& u, int wr, int wc, int fr, int fq) const {
#pragma unroll
        for (int ai = 0; ai < 2; ++ai)
#pragma unroll
            for (int m = 0; m < 4; ++m) { const int row = u.pm * BM + ai * HALF + wr * 64 + m * 16 + fr;
                f.gu(u, row, u.pn * HALF + wc * 32 + 8 * fq, acc[ai][0][m][0], acc[ai][0][m][1], acc[ai][1][m][0], acc[ai][1][m][1]);
                asm volatile("" ::: "memory"); }
    }
};

__device__ __forceinline__ float dot8(const float (&a)[8], u32x4 b) {
    return a[0] * lo16(b.x) + a[1] * hi16(b.x) + a[2] * lo16(b.y) + a[3] * hi16(b.y) + a[4] * lo16(b.z) + a[5] * hi16(b.z) + a[6] * lo16(b.w) + a[7] * hi16(b.w);
}
template <class F, class Sched>
__device__ __forceinline__ void gemm_simple_oct(const Gemm g, const Sched& S, const F& f) {
    Unit u;
    for (int i = 0; S.next(i, u); ++i) {
        const bf16_t* A = g.A + u.aoff + (size_t)u.pm * BM * g.lda; const bf16_t* B = g.Bt + u.boff + (size_t)u.pn * BM * g.ldb;
        for (int it = threadIdx.x; it < 256 * 32; it += NTHR) {
            const int r = it >> 5, cg = it & 31; float acc[8];
#pragma unroll
            for (int c = 0; c < 8; ++c) acc[c] = 0.f;
            const bf16_t* ar = A + (size_t)r * g.lda; const bf16_t* br = B + (size_t)(cg * 8) * g.ldb;
            for (int k = 0; k < g.K; k += 8) {
                const u32x4 a = *(const u32x4*)(ar + k); float af[8] = {lo16(a.x), hi16(a.x), lo16(a.y), hi16(a.y), lo16(a.z), hi16(a.z), lo16(a.w), hi16(a.w)};
#pragma unroll
                for (int c = 0; c < 8; ++c) acc[c] += dot8(af, *(const u32x4*)(br + (size_t)c * g.ldb + k));
            }
            f.oct(u, u.pm * BM + r, u.pn * BM + cg * 8, (f32x4){acc[0], acc[1], acc[2], acc[3]}, (f32x4){acc[4], acc[5], acc[6], acc[7]});
        }
    }
}
template <class F, class Sched>
__device__ __forceinline__ void gemm_simple_gu(const Gemm g, const Sched& S, const F& f) {
    Unit u;
    for (int i = 0; S.next(i, u); ++i) {
        const bf16_t* A = g.A + u.aoff + (size_t)u.pm * BM * g.lda; const bf16_t* B = g.Bt + u.boff + (size_t)u.pn * BM * g.ldb;
        for (int it = threadIdx.x; it < 256 * 16; it += NTHR) {
            const int r = it >> 4, cg = it & 15; float ag[8], au[8];
#pragma unroll
            for (int c = 0; c < 8; ++c) { ag[c] = 0.f; au[c] = 0.f; }
            const bf16_t* ar = A + (size_t)r * g.lda; const bf16_t* bg = B + (size_t)(cg * 8) * g.ldb; const bf16_t* bu = bg + (size_t)HALF * g.ldb;
            for (int k = 0; k < g.K; k += 8) {
                const u32x4 a = *(const u32x4*)(ar + k); float af[8] = {lo16(a.x), hi16(a.x), lo16(a.y), hi16(a.y), lo16(a.z), hi16(a.z), lo16(a.w), hi16(a.w)};
#pragma unroll
                for (int c = 0; c < 8; ++c) { ag[c] += dot8(af, *(const u32x4*)(bg + (size_t)c * g.ldb + k)); au[c] += dot8(af, *(const u32x4*)(bu + (size_t)c * g.ldb + k)); }
            }
            f.gu(u, u.pm * BM + r, u.pn * HALF + cg * 8, (f32x4){ag[0], ag[1], ag[2], ag[3]}, (f32x4){ag[4], ag[5], ag[6], ag[7]}, (f32x4){au[0], au[1], au[2], au[3]}, (f32x4){au[4], au[5], au[6], au[7]});
        }
    }
}
}
#define XB_TMO      128
#define XB_XCNT(j)  (256  + 64 * (j))
#define XB_XSUB(j)  (1280 + 64 * (j))
#define XB_XGEN(j)  (2304 + 64 * (j))
#define XB_TOP      3328
#define XB_TOPGEN   3392
#define XCD_BAR_WORDS 3456
#define XB_SPIN_CAP (1u << 22)

__device__ __forceinline__ unsigned xb_ld(unsigned* p)              { return __hip_atomic_load(p, __ATOMIC_RELAXED, __HIP_MEMORY_SCOPE_AGENT); }
__device__ __forceinline__ unsigned xb_add(unsigned* p, unsigned v) { return __hip_atomic_fetch_add(p, v, __ATOMIC_RELAXED, __HIP_MEMORY_SCOPE_AGENT); }
__device__ __forceinline__ unsigned xb_xcc_id() { return (unsigned)__builtin_amdgcn_s_getreg((3 << 11) | 20) & 0xFu; }
#define XB_SPIN(cond, bar) do { unsigned _sp = 0; while (cond) { __builtin_amdgcn_s_sleep(1); \
    if ((++_sp & 255u) == 0u) { if (xb_ld(&(bar)[XB_TMO])) break; if (_sp > XB_SPIN_CAP) { atomicAdd(&(bar)[XB_TMO], 1u); break; } } } } while (0)

struct XcdBarrier {
    unsigned* bar; unsigned x;
    volatile LAS unsigned* st;
};

__device__ __forceinline__ XcdBarrier xcd_barrier_post(unsigned* bar, volatile LAS unsigned* st) {
    XcdBarrier b; b.bar = bar; b.x = xb_xcc_id(); b.st = st;
    if (threadIdx.x == 0) (void)xb_add(&bar[XB_XCNT(b.x)], 1u);
    return b;
}
__device__ __forceinline__ void xcd_barrier_complete(unsigned* bar, unsigned x, unsigned& nloc, unsigned& nx) {
    const unsigned G = gridDim.x * gridDim.y * gridDim.z;
    unsigned sum, cnt, mine, sp = 0u;
    for (;;) {
        sum = 0u; cnt = 0u; mine = 0u;
#pragma unroll
        for (unsigned j = 0; j < 16; ++j) { const unsigned c = xb_ld(&bar[XB_XCNT(j)]); sum += c; cnt += (c > 0u) ? 1u : 0u; mine = (j == x) ? c : mine; }
        if (sum == G) break;
        __builtin_amdgcn_s_sleep(1);
        if ((++sp & 255u) == 0u) { if (xb_ld(&bar[XB_TMO])) break; if (sp > XB_SPIN_CAP) { atomicAdd(&bar[XB_TMO], 1u); break; } }
    }
    nloc = mine > 0u ? mine : 1u; nx = cnt > 0u ? cnt : 1u;
}

__device__ __forceinline__ void xcd_barrier(const XcdBarrier& b) {
    asm volatile("s_waitcnt vmcnt(0)" ::: "memory");
    __syncthreads();
    if (threadIdx.x == 0) {
        unsigned* bar = b.bar;
        __builtin_amdgcn_s_waitcnt(0);
        unsigned nloc = b.st[0], nx = b.st[1];
        if (nloc == 0u) { xcd_barrier_complete(bar, b.x, nloc, nx); b.st[0] = nloc; b.st[1] = nx; }
        const unsigned old = xb_add(&bar[XB_XSUB(b.x)], 1u);
        const unsigned gen = old / nloc;
        if (old + 1u == (gen + 1u) * nloc) {
            __builtin_amdgcn_fence(__ATOMIC_RELEASE, "agent");
            asm volatile("s_waitcnt vmcnt(0)" ::: "memory");
            const unsigned og = xb_add(&bar[XB_TOP], 1u);
            const unsigned tg = og / nx;
            if (og + 1u == (tg + 1u) * nx) xb_add(&bar[XB_TOPGEN], 1u);
            else XB_SPIN(xb_ld(&bar[XB_TOPGEN]) == tg, bar);
            __builtin_amdgcn_fence(__ATOMIC_ACQUIRE, "agent");
            xb_add(&bar[XB_XGEN(b.x)], 1u);
            asm volatile("s_waitcnt vmcnt(0)" ::: "memory");
        } else {
            XB_SPIN(xb_ld(&bar[XB_XGEN(b.x)]) == gen, bar);
            __builtin_amdgcn_fence(__ATOMIC_ACQUIRE, "agent");
            asm volatile("s_waitcnt vmcnt(0)" ::: "memory");
        }
    }
    __syncthreads();
}

struct Ctx {
    LAS unsigned char* lds; int tid, lane, wave, G, wg, gw, NGW;
    const float* const __attribute__((address_space(4)))* in; float* X; unsigned char* ws;
};
#define WSP(type, off) ((type*)(c.ws + (off)))
#define WSG(type, off) ((GAS type*)(c.ws + (off)))
#define ING(i) ((const GAS float*)c.in[i])

struct CvtJob { const float* W0; const float* W1; const float* kscale; bf16_t* WT; int ldw, K, Ndst, kind; };
__device__ __forceinline__ int cvt_src_col(int kind, int n, int& which) {
    which = 0;
    if (kind == 0) return n;
    if (kind == 1) {
        if (n < 2048) return n; if (n < 3584) return n + 8; if (n < 4416) return n + 16;
        if (n < 4420) return 2048 + (n - 4416); if (n < 4424) return 2052 + (n - 4420); if (n < 4432) return 3592 + (n - 4424);
        if (n < 4608) return -1; return 4432 + (n - 4608);
    }
    if (kind == 2) { const int h = n / 192, j = n % 192; if (j < 128) return n; const int jj = j - 128; return h * 192 + 128 + (jj & 1) * 32 + (jj >> 1); }
    const int uu = n >> 8, r = n & 255; which = r >> 7; return uu * 128 + (r & 127);
}
__device__ __forceinline__ void cvt_item(const CvtJob& jb, int item, LAS float* scr, int lane) {
    const int nblk = jb.Ndst / 32, kb = item / nblk, nb = item % nblk, k0 = 64 * kb, n0 = 32 * nb;
    int which; const int sc = cvt_src_col(jb.kind, n0 + (lane & 31), which);
    const float* W = (const float*)((uintptr_t)jb.W0 + (uintptr_t)which * ((uintptr_t)jb.W1 - (uintptr_t)jb.W0));
    float v[32];
#pragma unroll
    for (int i = 0; i < 32; ++i) { const int kk = 2 * i + (lane >> 5); v[i] = (sc >= 0) ? W[(size_t)(k0 + kk) * jb.ldw + sc] : 0.f; }
    if (jb.kscale) {
#pragma unroll
        for (int i = 0; i < 32; ++i) v[i] *= jb.kscale[k0 + 2 * i + (lane >> 5)]; }
#pragma unroll
    for (int i = 0; i < 32; ++i) scr[(2 * i + (lane >> 5)) * 33 + (lane & 31)] = v[i];
    LDS_WAIT(); asm volatile("" ::: "memory");
    const int cc = lane & 7;
#pragma unroll
    for (int j = 0; j < 4; ++j) { const int n = (lane >> 3) + 8 * j; const LAS float* s = scr + (8 * cc) * 33 + n;
        u32x4 o; o.x = pk2(s[0 * 33], s[1 * 33]); o.y = pk2(s[2 * 33], s[3 * 33]); o.z = pk2(s[4 * 33], s[5 * 33]); o.w = pk2(s[6 * 33], s[7 * 33]);
        *(u32x4*)(jb.WT + (size_t)(n0 + n) * jb.K + k0 + 8 * cc) = o; }
    LDS_WAIT(); asm volatile("" ::: "memory");
}
__device__ __forceinline__ void cvt_run(const Ctx& c, const CvtJob& jb, LAS float* scr) {
    const int nitems = (jb.K / 64) * (jb.Ndst / 32);
    for (int it = c.gw; it < nitems; it += c.NGW) cvt_item(jb, it, scr, c.lane);
}
__device__ __forceinline__ void cvt_run_ranked(const Ctx& c, const CvtJob& jb, LAS float* scr, int rank, int count) {
    const int nitems = (jb.K / 64) * (jb.Ndst / 32);
    for (int it = rank; it < nitems; it += count) cvt_item(jb, it, scr, c.lane);
}
__device__ __forceinline__ CvtJob make_job(const Ctx& c, int j) {
    CvtJob jb; jb.W0 = nullptr; jb.W1 = nullptr; jb.kscale = nullptr; jb.kind = 0;
    if (j < 8 * NL) {
        const int l = j >> 3, k = j & 7;
        if (k == 0) { jb.W0 = c.in[5] + (size_t)l * 1024 * 7504; jb.ldw = 7504; jb.K = 1024; jb.Ndst = NP; jb.kind = 1; jb.WT = WSP(bf16_t, O_WIN) + (size_t)l * NP * 1024; }
        else if (k == 1) { jb.W0 = c.in[17] + (size_t)l * 512 * 768; jb.ldw = 768; jb.K = 512; jb.Ndst = 768; jb.kind = 2; jb.kscale = c.in[16] + l * 512; jb.WT = WSP(bf16_t, O_WUQ) + (size_t)l * 768 * 512; }
        else if (k == 2) { jb.W0 = c.in[19] + (size_t)l * 256 * 512; jb.ldw = 512; jb.K = 256; jb.Ndst = 512; jb.kscale = c.in[18] + l * 256; jb.WT = WSP(bf16_t, O_WUK) + (size_t)l * 512 * 256; }
        else if (k == 3) { jb.W0 = c.in[20] + (size_t)l * 256 * 512; jb.ldw = 512; jb.K = 256; jb.Ndst = 512; jb.kscale = c.in[18] + l * 256; jb.WT = WSP(bf16_t, O_WUV) + (size_t)l * 512 * 256; }
        else if (k < 7) { jb.W0 = (k == 4 ? c.in[21] : k == 5 ? c.in[22] : c.in[23]) + (size_t)l * 512 * 1024; jb.ldw = 1024; jb.K = 512; jb.Ndst = 1024; jb.WT = WSP(bf16_t, O_WBR) + (size_t)(l * 3 + (k - 4)) * 1024 * 512; }
        else { jb.W0 = c.in[24] + (size_t)l * 1024 * 1024; jb.ldw = 1024; jb.K = 1024; jb.Ndst = 1024; jb.WT = WSP(bf16_t, O_WOUT) + (size_t)l * 1024 * 1024; }
    } else {
        const int i = (j - 8 * NL) >> 1, k = (j - 8 * NL) & 1;
        if (k == 0) { jb.W0 = c.in[25] + (size_t)i * 1024 * FF; jb.W1 = c.in[26] + (size_t)i * 1024 * FF; jb.ldw = FF; jb.K = 1024; jb.Ndst = 2 * FF; jb.kind = 3; jb.WT = WSP(bf16_t, O_WGU) + (size_t)i * 2 * FF * 1024; }
        else { jb.W0 = c.in[27] + (size_t)i * FF * 1024; jb.ldw = 1024; jb.K = FF; jb.Ndst = 1024; jb.WT = WSP(bf16_t, O_WDN) + (size_t)i * 1024 * FF; }
    }
    return jb;
}
__device__ __forceinline__ CvtJob make_moe_job(const Ctx& c, int i, int j) {
    CvtJob jb; jb.W0 = nullptr; jb.W1 = nullptr; jb.kscale = nullptr; jb.kind = 0;
    if (j < 8) { const size_t eo = (size_t)(i * 8 + j) * 1024 * EF; jb.W0 = c.in[29] + eo; jb.W1 = c.in[30] + eo; jb.ldw = EF; jb.K = 1024; jb.Ndst = 2 * EF; jb.kind = 3; jb.WT = WSP(bf16_t, O_WEGU) + (size_t)j * 2 * EF * 1024; }
    else { const int e = j - 8; jb.W0 = c.in[31] + (size_t)(i * 8 + e) * EF * 1024; jb.ldw = 1024; jb.K = EF; jb.Ndst = 1024; jb.WT = WSP(bf16_t, O_WEDN) + (size_t)e * 1024 * EF; }
    return jb;
}

__device__ __forceinline__ void cvt_item(const CvtJob& jb, int item, LAS float* scr, int lane);
struct CvtQueue { unsigned* ctr; unsigned base, off; int lane;
    __device__ __forceinline__ unsigned grab() { unsigned b = 0; if (lane == 0) b = __hip_atomic_fetch_add(ctr, 8u, __ATOMIC_RELAXED, __HIP_MEMORY_SCOPE_AGENT); return (unsigned)__builtin_amdgcn_readfirstlane(b); }
    __device__ __forceinline__ void init(unsigned* c_, int lane_) { ctr = c_; lane = lane_; off = 0; base = grab(); }
    __device__ __forceinline__ void run(const CvtJob& jb, LAS float* scr) { const unsigned n = (unsigned)(jb.K / 64) * (unsigned)(jb.Ndst / 32);
        while (base - off < n) {
#pragma unroll 1
            for (unsigned k = 0; k < 8; ++k) cvt_item(jb, (int)(base - off + k), scr, lane);
            base = grab(); }
        off += n; }
};
__device__ __forceinline__ void p0_prologue(const Ctx& c) {
    LAS float* sil = (LAS float*)c.lds;
    LAS float* red = sil + 4096;
    LAS float* scr = (LAS float*)(c.lds + 32768 + c.wave * 8704);
    for (int i = c.tid; i < 4096; i += NTHR) sil[i] = siluf_(c.in[1][i]);
    __syncthreads();
    float* MOD = WSP(float, O_MOD);
    for (int it = c.wg; it < NL * 96; it += c.G) {
        const int l = it / 96, cg = it % 96, col = cg * 64 + c.lane;
        float a0 = 0.f, a1 = 0.f, a2 = 0.f, a3 = 0.f;
        const float* w = c.in[3] + (size_t)l * 1024 * 6144 + col;
#pragma unroll 32
        for (int k = c.wave * 128; k < c.wave * 128 + 128; ++k) { const float wv = w[(size_t)k * 6144]; a0 += sil[k] * wv; a1 += sil[1024 + k] * wv; a2 += sil[2048 + k] * wv; a3 += sil[3072 + k] * wv; }
        red[(c.wave * 4 + 0) * 64 + c.lane] = a0; red[(c.wave * 4 + 1) * 64 + c.lane] = a1; red[(c.wave * 4 + 2) * 64 + c.lane] = a2; red[(c.wave * 4 + 3) * 64 + c.lane] = a3;
        __syncthreads();
        if (c.tid < 256) { const int b = c.tid >> 6, ln = c.tid & 63; float s = 0.f;
#pragma unroll
            for (int w8 = 0; w8 < 8; ++w8) s += red[(w8 * 4 + b) * 64 + ln];
            MOD[(size_t)(l * 4 + b) * 6144 + cg * 64 + ln] = s + c.in[4][l * 6144 + cg * 64 + ln]; }
        __syncthreads();
    }
    { float* ROPE = WSP(float, O_ROPE); const int* pos = (const int*)c.in[2];
      for (int idx = c.wg * NTHR + c.tid; idx < T * 32; idx += c.G * NTHR) { const int t = idx >> 5, i = idx & 31;
          const float inv = expf(-(float)(2 * i) * (1.f / 64.f) * 9.210340371976184f); const float ang = (float)pos[t] * inv; float sn, cs; sincosf(ang, &sn, &cs);
          ROPE[(size_t)idx * 2] = cs; ROPE[(size_t)idx * 2 + 1] = sn; } }
    { CvtQueue q; q.init((unsigned*)(c.ws + O_CTL) + 256 + 64 * 8, c.lane);
      for (int j = 0; j < 4; ++j) { const CvtJob jb = make_job(c, j); q.run(jb, scr); } }
}

__device__ __forceinline__ void load_row(const Ctx& c, int row, int combine_l, f32x4 (&v)[4], const float* xsrc = nullptr) {
    float* xr = c.X + (size_t)row * D + 4 * c.lane; const float* xs = (xsrc ? xsrc : c.X) + (size_t)row * D + 4 * c.lane;
#pragma unroll
    for (int j = 0; j < 4; ++j) v[j] = *(const f32x4*)(xs + 256 * j);
    if (combine_l >= 0) {
        const int b = row >> 12; const int* ts = WSP(int, O_TOKSLOT) + row * 2; const float* tw = WSP(float, O_TOPW) + row * 2;
        const int s0 = ts[0], s1 = ts[1]; const float w0 = tw[0], w1 = tw[1];
        const float* g2 = WSP(float, O_MOD) + (size_t)(combine_l * 4 + b) * 6144 + 5120 + 4 * c.lane;
        const int nmain = WSP(int, O_NBLK)[1] * 256;
        const bf16_t* y0 = WSP(bf16_t, O_YS) + (size_t)s0 * D + 4 * c.lane; const bf16_t* y1 = WSP(bf16_t, O_YS) + (size_t)s1 * D + 4 * c.lane;
        const float* z0 = WSP(float, O_MF) + (size_t)(s0 - nmain) * D + 4 * c.lane; const float* z1 = WSP(float, O_MF) + (size_t)(s1 - nmain) * D + 4 * c.lane;
#pragma unroll
        for (int j = 0; j < 4; ++j) { const f32x4 g = *(const f32x4*)(g2 + 256 * j); f32x4 ya, yb;
            if (s0 >= nmain) { ya = *(const f32x4*)(z0 + 256 * j);
#pragma unroll
                for (int k = 1; k < 7; ++k) ya = ya + *(const f32x4*)(z0 + (size_t)k * (8 * 256 * 1024) + 256 * j); }
            else { const u32x2 a = *(const u32x2*)(y0 + 256 * j); ya = (f32x4){lo16(a.x), hi16(a.x), lo16(a.y), hi16(a.y)}; }
            if (s1 >= nmain) { yb = *(const f32x4*)(z1 + 256 * j);
#pragma unroll
                for (int k = 1; k < 7; ++k) yb = yb + *(const f32x4*)(z1 + (size_t)k * (8 * 256 * 1024) + 256 * j); }
            else { const u32x2 bb = *(const u32x2*)(y1 + 256 * j); yb = (f32x4){lo16(bb.x), hi16(bb.x), lo16(bb.y), hi16(bb.y)}; }
            v[j] = v[j] + g * (ya * w0 + yb * w1); *(f32x4*)(xr + 256 * j) = v[j]; }
    }
}
__device__ __forceinline__ float row_rstd(const f32x4 (&v)[4]) {
    float ss = 0.f;
#pragma unroll
    for (int j = 0; j < 4; ++j) ss += (v[j][0] * v[j][0] + v[j][1] * v[j][1]) + (v[j][2] * v[j][2] + v[j][3] * v[j][3]);
    return rsqrtf(wave_sum(ss) * (1.f / D) + EPS);
}
__device__ __forceinline__ void norm_phase(const Ctx& c, int l, int which, int combine_l, const float* xsrc = nullptr) {
    bf16_t* H = WSP(bf16_t, O_H);
    for (int row0 = c.gw * 2; row0 < T; row0 += c.NGW * 2) {
        f32x4 v[2][4]; load_row(c, row0, combine_l, v[0], xsrc); load_row(c, row0 + 1, combine_l, v[1], xsrc);
#pragma unroll
        for (int q = 0; q < 2; ++q) { const int row = row0 + q;
            const float r = row_rstd(v[q]); const int b = row >> 12;
            const float* sh = WSP(float, O_MOD) + (size_t)(l * 4 + b) * 6144 + (which ? 3072 : 0) + 4 * c.lane; const float* sc = sh + 1024;
#pragma unroll
            for (int j = 0; j < 4; ++j) { const f32x4 s1 = *(const f32x4*)(sc + 256 * j), s0 = *(const f32x4*)(sh + 256 * j); const f32x4 h = v[q][j] * r * (s1 + 1.f) + s0;
                u32x2 o; o.x = pk2(h[0], h[1]); o.y = pk2(h[2], h[3]); *(u32x2*)(H + (size_t)row * D + 4 * c.lane + 256 * j) = o; } }
    }
}
__device__ __forceinline__ void final_phase(const Ctx& c, int combine_l) {
    for (int row = c.gw; row < T; row += c.NGW) {
        f32x4 v[4]; load_row(c, row, combine_l, v);
        const float r = row_rstd(v); const float* fw = c.in[32] + 4 * c.lane;
#pragma unroll
        for (int j = 0; j < 4; ++j) { const f32x4 w = *(const f32x4*)(fw + 256 * j); *(f32x4*)(c.X + (size_t)row * D + 4 * c.lane + 256 * j) = v[j] * r * w; }
    }
}
__device__ __forceinline__ void norm2_moe_phase(const Ctx& c, int l) {
    bf16_t* H = WSP(bf16_t, O_H);
    LAS float* rt = (LAS float*)c.lds;
    LAS int* hist = (LAS int*)(c.lds + 32768);
    const float* router = c.in[28] + (size_t)(l >> 1) * 1024 * 8;
    for (int i = c.tid; i < 8192; i += NTHR) rt[i] = router[i];
    if (c.tid < 8) hist[c.tid] = 0;
    __syncthreads();
    const int rpw = T / c.G, r0 = c.wg * rpw;
    for (int rr = c.wave; rr < rpw; rr += NWAVES) {
        const int row = r0 + rr;
        f32x4 v[4]; load_row(c, row, -1, v);
        const float r = row_rstd(v); const int b = row >> 12;
        const float* sh = WSP(float, O_MOD) + (size_t)(l * 4 + b) * 6144 + 3072 + 4 * c.lane; const float* sc = sh + 1024;
        float lg[8];
#pragma unroll
        for (int e = 0; e < 8; ++e) lg[e] = 0.f;
#pragma unroll
        for (int j = 0; j < 4; ++j) { const f32x4 s1 = *(const f32x4*)(sc + 256 * j), s0 = *(const f32x4*)(sh + 256 * j); const f32x4 h = v[j] * r * (s1 + 1.f) + s0;
            u32x2 o; o.x = pk2(h[0], h[1]); o.y = pk2(h[2], h[3]); *(u32x2*)(H + (size_t)row * D + 4 * c.lane + 256 * j) = o;
#pragma unroll
            for (int q = 0; q < 4; ++q) { const LAS f32x4* rp = (const LAS f32x4*)(rt + (4 * c.lane + 256 * j + q) * 8); const f32x4 ra = rp[0], rb = rp[1];
                lg[0] += h[q] * ra[0]; lg[1] += h[q] * ra[1]; lg[2] += h[q] * ra[2]; lg[3] += h[q] * ra[3]; lg[4] += h[q] * rb[0]; lg[5] += h[q] * rb[1]; lg[6] += h[q] * rb[2]; lg[7] += h[q] * rb[3]; } }
#pragma unroll
        for (int e = 0; e < 8; ++e) lg[e] = wave_sum(lg[e]);
        if (c.lane == 0) {
            int e0 = 0; float m0 = lg[0];
#pragma unroll
            for (int e = 1; e < 8; ++e) if (lg[e] > m0) { m0 = lg[e]; e0 = e; }
            int e1 = -1; float m1 = -3.0e38f;
#pragma unroll
            for (int e = 0; e < 8; ++e) if (e != e0 && lg[e] > m1) { m1 = lg[e]; e1 = e; }
            const float ex = __expf(m1 - m0), w0 = 1.f / (1.f + ex);
            WSP(int, O_TOPE)[row] = e0 | (e1 << 8); WSP(float, O_TOPW)[row * 2] = w0; WSP(float, O_TOPW)[row * 2 + 1] = ex * w0;
            __hip_atomic_fetch_add(&hist[e0], 1, __ATOMIC_RELAXED, __HIP_MEMORY_SCOPE_WORKGROUP); __hip_atomic_fetch_add(&hist[e1], 1, __ATOMIC_RELAXED, __HIP_MEMORY_SCOPE_WORKGROUP);
        }
    }
    __syncthreads();
    if (c.tid < 8) WSP(int, O_WGCNT)[c.wg * 8 + c.tid] = hist[c.tid];
    __syncthreads();
}
__device__ __forceinline__ void moe_assign_phase(const Ctx& c, int l) {
    LAS int* cnt = (LAS int*)c.lds;
    LAS int* tot = cnt + 2048; LAS int* base = tot + 8; LAS int* spad = base + 8; LAS int* pairs = spad + 16;
    const int rpw = T / c.G, r0 = c.wg * rpw;
    LAS int* tl = pairs + 4 * rpw;
    const int* WGC = WSP(int, O_WGCNT);
    for (int i = c.tid; i < c.G * 8; i += NTHR) cnt[i] = WGC[i];
    if (c.tid < rpw) tl[c.tid] = WSP(int, O_TOPE)[r0 + c.tid];
    __syncthreads();
    if (c.tid < 8) { int t = 0, bs = 0; for (int w = 0; w < c.G; ++w) { if (w == c.wg) bs = t; t += cnt[w * 8 + c.tid]; } tot[c.tid] = t; base[c.tid] = bs; }
    __syncthreads();
    if (c.tid == 0) {
        int sp = 0; for (int e = 0; e < 8; ++e) { spad[e] = sp; sp += (tot[e] + 255) / 256 * 256; } spad[8] = sp;
        if (c.wg == 0) { int* blke = WSP(int, O_BLKE); int nb = 0; for (int e = 0; e < 8; ++e) { const int n = (tot[e] + 255) / 256; for (int k = 0; k < n; ++k) blke[nb++] = e; } *WSP(int, O_NBLK) = nb; WSP(int, O_NBLK)[1] = ((nb * 4) / c.G) * c.G / 4; }
    }
    __syncthreads();
    if (c.wave == 0) {
        int* tokslot = WSP(int, O_TOKSLOT); int runq[8];
#pragma unroll
        for (int q = 0; q < 8; ++q) runq[q] = spad[q] + base[q];
        const unsigned long long lt = (1ull << c.lane) - 1ull;
        for (int a0 = 0; a0 < 2 * rpw; a0 += 64) { const int a = a0 + c.lane, rr = a >> 1, k = a & 1; const bool on = a < 2 * rpw; const int e = on ? ((tl[rr] >> (8 * k)) & 255) : -1; int sl = 0;
#pragma unroll
            for (int q = 0; q < 8; ++q) { const unsigned long long m = __ballot(e == q); if (e == q) sl = runq[q] + __popcll(m & lt); runq[q] += __popcll(m); }
            if (on) { tokslot[(r0 + rr) * 2 + k] = sl; pairs[a * 2] = sl; pairs[a * 2 + 1] = r0 + rr; } }
    }
    __syncthreads();
    { const bf16_t* H = WSP(bf16_t, O_H); bf16_t* XS = WSP(bf16_t, O_XS);
      for (int p = c.wave; p < rpw * 2; p += NWAVES) { const int s = pairs[p * 2], tk = pairs[p * 2 + 1];
          const u32x4* src = (const u32x4*)(H + (size_t)tk * D) + c.lane; u32x4* dst = (u32x4*)(XS + (size_t)s * D) + c.lane; dst[0] = src[0]; dst[64] = src[64]; }
      if (c.wg < 8) { const int e = c.wg, p0 = spad[e] + tot[e], p1 = spad[e + 1];
          for (int s = p0 + c.wave; s < p1; s += NWAVES) { u32x4* dst = (u32x4*)(XS + (size_t)s * D) + c.lane; dst[0] = (u32x4){0u, 0u, 0u, 0u}; dst[64] = (u32x4){0u, 0u, 0u, 0u}; } } }
    __syncthreads();
}
__device__ __forceinline__ void next_layer_convert(const Ctx& c, int l, LAS float* scr, int rank, int count) {
    if (l + 1 >= NL) return;
    for (int j = 8 * (l + 1); j < 8 * (l + 2); ++j) { const CvtJob jb = make_job(c, j); cvt_run_ranked(c, jb, scr, rank, count); }
    if (((l + 1) & 1) == 0) for (int j = 8 * NL + 2 * ((l + 1) >> 1); j < 8 * NL + 2 * ((l + 1) >> 1) + 2; ++j) { const CvtJob jb = make_job(c, j); cvt_run_ranked(c, jb, scr, rank, count); }
}
__device__ __forceinline__ void moe_convert(const Ctx& c, int l, LAS float* scr, int rank, int count) {
    for (int j = 0; j < 16; ++j) { const CvtJob jb = make_moe_job(c, l >> 1, j); cvt_run_ranked(c, jb, scr, rank, count); }
}
__device__ __forceinline__ void moe_convert_queue(const Ctx& c, int l, LAS float* scr) {
    unsigned* ctr = (unsigned*)(c.ws + O_CTL) + 256 + 64 * (l >> 1);
    constexpr unsigned NGU = 8u * 16u * (2 * EF / 32), NDN = 8u * (EF / 64) * 32u;
    for (;;) {
        unsigned base = 0; if (c.lane == 0) base = __hip_atomic_fetch_add(ctr, 8u, __ATOMIC_RELAXED, __HIP_MEMORY_SCOPE_AGENT);
        base = __builtin_amdgcn_readfirstlane(base);
        if (base >= NGU + NDN) break;
#pragma unroll 1
        for (unsigned k = 0; k < 8; ++k) { const unsigned idx = base + k; int j, item;
            if (idx < NGU) { j = idx / (NGU / 8); item = idx % (NGU / 8); } else { const unsigned r = idx - NGU; j = 8 + r / (NDN / 8); item = r % (NDN / 8); }
            const CvtJob jb = make_moe_job(c, l >> 1, j); cvt_item(jb, item, scr, c.lane); }
    }
}
__device__ __forceinline__ void next_layer_convert_queue(const Ctx& c, int l, LAS float* scr) {
    if (l + 1 >= NL) return;
    unsigned* ctr = (unsigned*)(c.ws + O_CTL) + 256 + 64 * (4 + l);
    auto grab = [&]() { unsigned b = 0; if (c.lane == 0) b = __hip_atomic_fetch_add(ctr, 8u, __ATOMIC_RELAXED, __HIP_MEMORY_SCOPE_AGENT); return (unsigned)__builtin_amdgcn_readfirstlane(b); };
    unsigned base = grab(), off = 0;
    auto run = [&](int j) { const CvtJob jb = make_job(c, j); const unsigned n = (unsigned)(jb.K / 64) * (unsigned)(jb.Ndst / 32);
        while (base - off < n) {
#pragma unroll 1
            for (unsigned k = 0; k < 8; ++k) cvt_item(jb, (int)(base - off + k), scr, c.lane);
            base = grab(); }
        off += n; };
    if (l == 0) { for (int j = 4; j < 8; ++j) run(j); run(8 * NL); run(8 * NL + 1); }
    for (int j = 8 * (l + 1); j < 8 * (l + 2); ++j) run(j);
    if (((l + 1) & 1) == 0) for (int j = 8 * NL + 2 * ((l + 1) >> 1); j < 8 * NL + 2 * ((l + 1) >> 1) + 2; ++j) run(j);
}
__device__ __forceinline__ void gdn_prep_unit(const Ctx& c, int l, int unit, int stop = 0) {
    const int h = unit & 3, n = (unit >> 2) & 63, b = unit >> 8;
    const int t0 = b * SEQ + n * CH;
    LAS bf16_t* Qb = (LAS bf16_t*)c.lds; LAS bf16_t* Kb = Qb + 64 * 136;
    LAS float* AS = (LAS float*)(c.lds + 34816);
    LAS float* KS = AS + 4096; LAS float* VS = KS + 8643; LAS float* QS = VS + 8643;
    LAS float* GS = QS + 8643; LAS float* BE = GS + 64; LAS float* EG = BE + 64;
    const GAS bf16_t* P = WSG(bf16_t, O_PROJ);
    { LAS unsigned char* rawl = c.lds;
#pragma unroll 1
      for (int k = 0; k < 7; ++k) { const int I = c.wave + 8 * k;
          if (I < 51) { const int idx = I * 64 + c.lane; if (idx < 67 * 48) { const int r = idx / 48, pc = idx % 48;
              if (n > 0 || r >= 3) __builtin_amdgcn_global_load_lds((const unsigned*)((const char*)(P + (size_t)(t0 - 3 + r) * NP + (pc >> 4) * 512 + h * 128 + (pc & 15) * 8)), (LAS unsigned*)(rawl + I * 1024), 16, 0, 0); } } }
      asm volatile("s_waitcnt vmcnt(0)" ::: "memory"); LDS_BARRIER(); }
    if (c.tid < 384) {
        const int part = c.tid >> 7, d = c.tid & 127, col = part * 512 + h * 128 + d;
        const GAS float* cw = ING(6) + (size_t)l * 4 * 1536 + col; const float w0 = cw[0], w1 = cw[1536], w2 = cw[2 * 1536], w3 = cw[3 * 1536];
        const LAS bf16_t* src = (const LAS bf16_t*)c.lds + c.tid;
        unsigned short raw[67];
#pragma unroll
        for (int r = 0; r < 67; ++r) raw[r] = (n > 0 || r >= 3) ? src[r * 384] : (unsigned short)0;
        LAS float* A = (part == 0 ? QS : part == 1 ? KS : VS) + 3 * 129 + d;
#pragma unroll
        for (int t = 0; t < 64; ++t) A[t * 129] = siluf_(w0 * bf2f(raw[t]) + w1 * bf2f(raw[t + 1]) + w2 * bf2f(raw[t + 2]) + w3 * bf2f(raw[t + 3]));
    } else if (c.tid < 448) {
        const int t = c.tid - 384; const GAS float* sf = WSG(float, O_SMALLF) + (size_t)(t0 + t) * 16;
        const float a = sf[h], bb = sf[4 + h];
        const float g = -expf(ING(7)[l * 4 + h]) * softplusf_(a + ING(8)[l * 4 + h]);
        float G = g;
#pragma unroll
        for (int o = 1; o < 64; o <<= 1) { const float up = __shfl_up(G, o); if (t >= o) G += up; }
        GS[t] = G; BE[t] = sigmoidf_(bb); EG[t] = expf(G);
    }
    LDS_BARRIER();
    if (stop == 2) return;
    for (int rr = c.wave; rr < 128; rr += NWAVES) { const bool isq = rr < 64; const int t = rr & 63; LAS float* row = (isq ? QS : KS) + (t + 3) * 129;
        const float a = row[c.lane], bq = row[c.lane + 64]; const float ss = wave_sum(a * a + bq * bq); const float sc = rsqrtf(ss + EPS) * (isq ? 0.08838834764831845f : 1.f);
        LAS bf16_t* ob = (isq ? Qb : Kb) + t * 136;
        ob[c.lane] = (bf16_t)f2bf(a * sc); ob[c.lane + 64] = (bf16_t)f2bf(bq * sc);
        if (!isq) { row[c.lane] = a * sc; row[c.lane + 64] = bq * sc; } }
    LDS_BARRIER();
    LAS float* QKs = QS;
    { const int typ = c.wave >> 2, ti = c.wave & 3, lr = c.lane & 15, g = c.lane >> 4;
      const LAS bf16_t* Xb = typ ? Qb : Kb;
#pragma unroll 1
      for (int tj = 0; tj < 4; ++tj) {
          f32x4 acc = {0.f, 0.f, 0.f, 0.f};
          if (tj <= ti) {
#pragma unroll
              for (int ks = 0; ks < 4; ++ks) { const bf16x8 af = *(const LAS bf16x8*)(Xb + (16 * ti + lr) * 136 + 32 * ks + 8 * g); const bf16x8 bf = *(const LAS bf16x8*)(Kb + (16 * tj + lr) * 136 + 32 * ks + 8 * g);
                  acc = __builtin_amdgcn_mfma_f32_16x16x32_bf16(af, bf, acc, 0, 0, 0); } }
          const int j = 16 * tj + lr;
#pragma unroll
          for (int r = 0; r < 4; ++r) { const int i = 16 * ti + 4 * g + r; float v = 0.f;
              if (typ == 0) { if (j < i) v = BE[i] * acc[r] * __expf(GS[i] - GS[j]); AS[i * 64 + j] = v; }
              else { if (j <= i) v = acc[r] * __expf(GS[i] - GS[j]); QKs[i * 65 + j] = v; } } } }
    LDS_BARRIER();
    if (stop == 4) return;
    const int chunk = (b * 4 + h) * 64 + n;
    if (c.tid >= 256) { GAS bf16_t* OPS = WSG(bf16_t, O_GW) + (size_t)chunk * (56 * 512); const float gl = GS[63];
#pragma unroll 1
      for (int q = 1024 + (c.tid - 256); q < 56 * 64; q += 256) { const int f = q >> 6, ln = q & 63, lr = ln & 15, g = ln >> 4; float v[8];
          if (f < 32) { const int ct = (f - 16) >> 2, ks = (f - 16) & 3, i = 16 * ct + lr; const float eg = EG[i]; const LAS bf16_t* qr = Qb + i * 136 + 32 * ks + 4 * g;
#pragma unroll
              for (int j = 0; j < 4; ++j) { v[j] = bf2f(qr[j]) * eg; v[4 + j] = bf2f(qr[16 + j]) * eg; } }
          else if (f < 40) { const int ct = (f - 32) >> 1, ks2 = (f - 32) & 1; const LAS float* qr = QKs + (16 * ct + lr) * 65 + 32 * ks2 + 4 * g;
#pragma unroll
              for (int j = 0; j < 4; ++j) { v[j] = qr[j]; v[4 + j] = qr[16 + j]; } }
          else { const int dt = (f - 40) >> 1, ks2 = (f - 40) & 1, dk = 16 * dt + lr, c0 = 32 * ks2 + 4 * g;
#pragma unroll
              for (int j = 0; j < 4; ++j) { v[j] = bf2f(Kb[(c0 + j) * 136 + dk]) * __expf(gl - GS[c0 + j]); v[4 + j] = bf2f(Kb[(c0 + 16 + j) * 136 + dk]) * __expf(gl - GS[c0 + 16 + j]); } }
          u32x4 o; o.x = pk2(v[0], v[1]); o.y = pk2(v[2], v[3]); o.z = pk2(v[4], v[5]); o.w = pk2(v[6], v[7]);
          *(GAS u32x4*)(OPS + (size_t)q * 8) = o; }
      if (c.tid == 256) WSG(float, O_GL)[chunk] = expf(gl);
    } else {
        const int col = c.tid; LAS float* src = ((col < 128) ? VS + col : KS + (col - 128)) + 3 * 129;
        unsigned asb = (unsigned)(uintptr_t)AS; asm volatile("" : "+v"(asb));
        const LAS float* ASv = (const LAS float*)(uintptr_t)asb; const LAS float* BEv = ASv + 4096 + 3 * 8643 + 64; const LAS float* EGv = BEv + 64;
        const LAS f32x4* A4 = (const LAS f32x4*)ASv;
        f32x2 x2[32]; f32x4 ar[16];
#pragma unroll
        for (int m = 0; m < 32; ++m) { x2[m][0] = src[(2 * m) * 129] * BEv[2 * m] * (col < 128 ? 1.f : EGv[2 * m]); x2[m][1] = src[(2 * m + 1) * 129] * BEv[2 * m + 1] * (col < 128 ? 1.f : EGv[2 * m + 1]); }
        ar[0] = A4[16];
#pragma unroll
        for (int i = 0; i < 64; ++i) {
            f32x2 acc0 = {0.f, 0.f}, acc1 = {0.f, 0.f};
#pragma unroll
            for (int q = 0; 4 * q < i; ++q) { const f32x4 aq = ar[q];
                if (4 * q + 1 < i) acc0 = acc0 + (f32x2){aq[0], aq[1]} * x2[2 * q]; else acc0[0] += aq[0] * x2[2 * q][0];
                if (4 * q + 3 < i) acc1 = acc1 + (f32x2){aq[2], aq[3]} * x2[2 * q + 1]; else if (4 * q + 2 < i) acc1[0] += aq[2] * x2[2 * q + 1][0];
                if (i + 1 < 64) ar[q] = A4[(i + 1) * 16 + q]; }
            if (i >= 1 && (i & 3) == 0 && i + 1 < 64) ar[i >> 2] = A4[(i + 1) * 16 + (i >> 2)];
            const float sx = x2[i >> 1][i & 1] - ((acc0[0] + acc0[1]) + (acc1[0] + acc1[1]));
            x2[i >> 1][i & 1] = sx; src[i * 129] = sx;
        }
    }
    LDS_BARRIER();
    if (stop == 6) return;
    { GAS bf16_t* OPS = WSG(bf16_t, O_GW) + (size_t)chunk * (56 * 512);
#pragma unroll 1
      for (int q = c.tid; q < 1024; q += NTHR) { const int f = q >> 6, ln = q & 63, lr = ln & 15, g = ln >> 4, ct = f >> 2, ks = f & 3; const LAS float* wr = KS + (16 * ct + lr + 3) * 129 + 32 * ks + 4 * g;
          u32x4 o; o.x = pk2(wr[0], wr[1]); o.y = pk2(wr[2], wr[3]); o.z = pk2(wr[16], wr[17]); o.w = pk2(wr[18], wr[19]);
          *(GAS u32x4*)(OPS + (size_t)q * 8) = o; }
      GAS float* UF = WSG(float, O_GU) + (size_t)chunk * 8192;
#pragma unroll 1
      for (int q = c.tid; q < 2048; q += NTHR) { const int es = q >> 8, ct = (q >> 6) & 3, ln = q & 63, lr = ln & 15, g = ln >> 4; const LAS float* ur = VS + (16 * ct + 4 * g + 3) * 129 + 16 * es + lr;
          *(GAS f32x4*)(UF + (size_t)q * 4) = (f32x4){ur[0], ur[129], ur[258], ur[387]}; } }
    LDS_BARRIER();
}

__device__ __forceinline__ void gdn_scan_wave(const Ctx& c, int bh, int es) {
    const int lane = c.lane; const unsigned l16 = (unsigned)lane * 16u;
    const char* ops = (const char*)(WSG(bf16_t, O_GW)) + (size_t)bh * 64 * 57344;
    const char* uf = (const char*)(WSG(float, O_GU)) + (size_t)bh * 64 * 32768 + es * 4096;
    char* sv = (char*)c.ws + O_MF + ((size_t)bh * 64 * 8 + es) * 6144;
    const GAS float* GL = WSG(float, O_GL) + bh * 64;
    LAS unsigned char* lds = c.lds;
#define GS_ISSUE(n_, buf_) do { const char* so_ = ops + (size_t)(n_) * 57344; const char* su_ = uf + (size_t)(n_) * 32768; LAS unsigned char* d_ = lds + (buf_) * 36864; \
        _Pragma("unroll") for (int f_ = 0; f_ < 16; ++f_) __builtin_amdgcn_global_load_lds((const unsigned*)(so_ + f_ * 1024 + l16), (LAS unsigned*)(d_ + f_ * 1024), 16, 0, 0); \
        _Pragma("unroll") for (int f_ = 0; f_ < 16; ++f_) __builtin_amdgcn_global_load_lds((const unsigned*)(so_ + (40 + f_) * 1024 + l16), (LAS unsigned*)(d_ + 16384 + f_ * 1024), 16, 0, 0); \
        _Pragma("unroll") for (int f_ = 0; f_ < 4; ++f_) __builtin_amdgcn_global_load_lds((const unsigned*)(su_ + f_ * 1024 + l16), (LAS unsigned*)(d_ + 32768 + f_ * 1024), 16, 0, 0); } while (0)
#define GS_FRAG(f_) (*(const LAS bf16x8*)(B + (f_) * 1024 + lane * 16))
    f32x4 S[8];
#pragma unroll
    for (int d = 0; d < 8; ++d) S[d] = (f32x4){0.f, 0.f, 0.f, 0.f};
    const float glv = GL[lane];
    asm volatile("s_waitcnt vmcnt(0)" ::: "memory");
    GS_ISSUE(0, 0);
#pragma unroll 1
    for (int n = 0; n < NCH; ++n) {
        const int buf = n & 1;
        if (n + 1 < NCH) { GS_ISSUE(n + 1, buf ^ 1); asm volatile("s_waitcnt vmcnt(36)" ::: "memory"); } else asm volatile("s_waitcnt vmcnt(0)" ::: "memory");
        const LAS unsigned char* B = lds + buf * 36864;
        GAS u32x4* svn = (GAS u32x4*)(sv + (size_t)n * 49152 + l16);
        f32x4 vn[4], acc[4]; bf16x8 Sb[4], vnb[2];
#pragma unroll
        for (int ct = 0; ct < 4; ++ct) { vn[ct] = *(const LAS f32x4*)(B + 32768 + ct * 1024 + lane * 16); acc[ct] = (f32x4){0.f, 0.f, 0.f, 0.f}; }
#pragma unroll
        for (int ks = 0; ks < 4; ++ks) { u32x4 w; w.x = pk2(S[2 * ks][0], S[2 * ks][1]); w.y = pk2(S[2 * ks][2], S[2 * ks][3]); w.z = pk2(S[2 * ks + 1][0], S[2 * ks + 1][1]); w.w = pk2(S[2 * ks + 1][2], S[2 * ks + 1][3]); Sb[ks] = __builtin_bit_cast(bf16x8, w); svn[ks * 64] = w; }
#pragma unroll
        for (int ks = 0; ks < 4; ++ks)
#pragma unroll
            for (int ct = 0; ct < 4; ++ct) acc[ct] = __builtin_amdgcn_mfma_f32_16x16x32_bf16(GS_FRAG(ct * 4 + ks), Sb[ks], acc[ct], 0, 0, 0);
#pragma unroll
        for (int ct = 0; ct < 4; ++ct) vn[ct] = vn[ct] - acc[ct];
#pragma unroll
        for (int k2 = 0; k2 < 2; ++k2) { u32x4 w; w.x = pk2(vn[2 * k2][0], vn[2 * k2][1]); w.y = pk2(vn[2 * k2][2], vn[2 * k2][3]); w.z = pk2(vn[2 * k2 + 1][0], vn[2 * k2 + 1][1]); w.w = pk2(vn[2 * k2 + 1][2], vn[2 * k2 + 1][3]); vnb[k2] = __builtin_bit_cast(bf16x8, w); svn[(4 + k2) * 64] = w; }
        const float gl = __builtin_bit_cast(float, __builtin_amdgcn_readlane(__builtin_bit_cast(int, glv), n));
#pragma unroll
        for (int d = 0; d < 8; ++d) S[d] = S[d] * gl;
#pragma unroll
        for (int k2 = 0; k2 < 2; ++k2)
#pragma unroll
            for (int d = 0; d < 8; ++d) S[d] = __builtin_amdgcn_mfma_f32_16x16x32_bf16(GS_FRAG(16 + d * 2 + k2), vnb[k2], S[d], 0, 0, 0);
    }
#undef GS_ISSUE
#undef GS_FRAG
}
__device__ __forceinline__ void gdn_out_phase(const Ctx& c, int l) {
    const int lane = c.lane, lr = lane & 15, g = lane >> 4, ts = c.wave >> 1, hf = c.wave & 1;
    const GAS bf16_t* P = WSG(bf16_t, O_PROJ); GAS bf16_t* YA = WSG(bf16_t, O_YA);
    LAS unsigned char* R = c.lds + ts * 24576;
    LAS float* SSQ = (LAS float*)(c.lds + 4 * 24576) + ts * 128;
    for (int tbase = 0; tbase < NB * 4 * NCH; tbase += c.G * 4) {
        const int task = tbase + c.wg + c.G * ts; const bool on = task < NB * 4 * NCH;
        const int bh = task >> 6, n = task & 63, b = bh >> 2, h = bh & 3, t0 = b * SEQ + n * CH;
        const char* ops = (const char*)(WSG(bf16_t, O_GW)) + (size_t)task * 57344 + lane * 16;
        const char* sv = (const char*)c.ws + O_MF + (size_t)task * 49152 + lane * 16;
        LDS_BARRIER();
        if (on) {
#pragma unroll
            for (int f = 0; f < 12; ++f) __builtin_amdgcn_global_load_lds((const unsigned*)(ops + (16 + 12 * hf + f) * 1024), (LAS unsigned*)(R + (12 * hf + f) * 1024), 16, 0, 0); }
        asm volatile("s_waitcnt vmcnt(0)" ::: "memory"); LDS_BARRIER();
        f32x4 o[4][4];
        if (on) {
#pragma unroll
            for (int e4 = 0; e4 < 4; ++e4) { const int es = 4 * hf + e4; bf16x8 sb[6];
#pragma unroll
                for (int f = 0; f < 6; ++f) sb[f] = *(const GAS bf16x8*)(sv + (es * 6 + f) * 1024);
#pragma unroll
                for (int ct = 0; ct < 4; ++ct) { f32x4 a = {0.f, 0.f, 0.f, 0.f};
#pragma unroll
                    for (int ks = 0; ks < 4; ++ks) a = __builtin_amdgcn_mfma_f32_16x16x32_bf16(*(const LAS bf16x8*)(R + (ct * 4 + ks) * 1024 + lane * 16), sb[ks], a, 0, 0, 0);
#pragma unroll
                    for (int k2 = 0; k2 < 2; ++k2) a = __builtin_amdgcn_mfma_f32_16x16x32_bf16(*(const LAS bf16x8*)(R + (16 + ct * 2 + k2) * 1024 + lane * 16), sb[4 + k2], a, 0, 0, 0);
                    o[e4][ct] = a; } }
#pragma unroll
            for (int ct = 0; ct < 4; ++ct)
#pragma unroll
                for (int r = 0; r < 4; ++r) { float ss = 0.f;
#pragma unroll
                    for (int e4 = 0; e4 < 4; ++e4) ss += o[e4][ct][r] * o[e4][ct][r];
                    ss = row16_sum(ss); if (lr == 0) SSQ[hf * 64 + 16 * ct + 4 * g + r] = ss; }
        }
        LDS_BARRIER();
        if (on) {
            LAS bf16_t* OT = (LAS bf16_t*)R;
#pragma unroll
            for (int ct = 0; ct < 4; ++ct)
#pragma unroll
                for (int r = 0; r < 4; ++r) { const int row = 16 * ct + 4 * g + r; const float rs = rsqrtf((SSQ[row] + SSQ[64 + row]) * (1.f / 128.f) + EPS);
#pragma unroll
                    for (int e4 = 0; e4 < 4; ++e4) OT[row * 136 + 16 * (4 * hf + e4) + lr] = (bf16_t)f2bf(o[e4][ct][r] * rs); }
        }
        LDS_BARRIER();
        if (on) {
            const LAS bf16_t* OT = (const LAS bf16_t*)R;
#pragma unroll
            for (int k = 0; k < 8; ++k) { const int ch = lane + 64 * k, row = 32 * hf + (ch >> 4), ec = (ch & 15) * 8; const size_t t = (size_t)(t0 + row);
                f32x4 x0, x1, z0, z1; unpk8(*(const LAS u32x4*)(OT + row * 136 + ec), x0, x1); unpk8(*(const GAS u32x4*)(P + t * NP + C_GZ + h * 128 + ec), z0, z1);
                const f32x4 w0 = *(const GAS f32x4*)(ING(9) + l * 128 + ec), w1 = *(const GAS f32x4*)(ING(9) + l * 128 + ec + 4);
#pragma unroll
                for (int i = 0; i < 4; ++i) { x0[i] = x0[i] * w0[i] * siluf_(z0[i]); x1[i] = x1[i] * w1[i] * siluf_(z1[i]); }
                *(GAS u32x4*)(YA + t * 512 + h * 128 + ec) = pk8(x0, x1); }
        }
    }
    LDS_BARRIER();
}

__device__ __forceinline__ void gdn_scan_unit(const Ctx& c, int unit) {
    const int es = unit & 3, h = (unit >> 2) & 3, b = unit >> 4;
    LAS float* SST = (LAS float*)c.lds;
    LAS bf16_t* WL = (LAS bf16_t*)(c.lds + 16896); LAS bf16_t* QDL = WL + 8192; LAS bf16_t* KDL = QDL + 8192; LAS bf16_t* QKL = KDL + 8192;
    LAS float* VN = (LAS float*)(c.lds + 16896 + 3 * 16384 + 8192);
    for (int i = c.tid; i < 128 * 33; i += NTHR) SST[i] = 0.f;
    const GAS bf16_t* W = WSG(bf16_t, O_GW); const GAS bf16_t* QD = WSG(bf16_t, O_GQD); const GAS bf16_t* KD = WSG(bf16_t, O_GKD); const GAS bf16_t* QK = WSG(bf16_t, O_GQK);
    const GAS float* U = WSG(float, O_GU); GAS float* GO = WSG(float, O_GO); const GAS float* GL = WSG(float, O_GL) + (b * 4 + h) * 64;
    const int e = c.tid & 31, cc = c.tid >> 5;
    for (int n = 0; n < NCH; ++n) {
        const int t0 = b * SEQ + n * CH;
        __syncthreads();
#pragma unroll
        for (int k = 0; k < 2; ++k) { const int p = c.tid + k * NTHR, r = p >> 4, q = p & 15; const size_t go = (size_t)(t0 + r) * 512 + h * 128 + q * 8;
            *(LAS u32x4*)(WL + r * 128 + q * 8) = *(const GAS u32x4*)(W + go); *(LAS u32x4*)(QDL + r * 128 + q * 8) = *(const GAS u32x4*)(QD + go); *(LAS u32x4*)(KDL + r * 128 + q * 8) = *(const GAS u32x4*)(KD + go); }
        { const int r = c.tid >> 3, q = c.tid & 7; *(LAS u32x4*)(QKL + r * 64 + q * 8) = *(const GAS u32x4*)(QK + ((size_t)(t0 + r) * 4 + h) * 64 + q * 8); }
        __syncthreads();
#pragma unroll 1
        for (int r = 0; r < 4; ++r) { const int ci = cc + 16 * r; float a = U[(size_t)(t0 + ci) * 512 + h * 128 + es * 32 + e];
            const LAS unsigned* wr = (const LAS unsigned*)(WL + ci * 128);
#pragma unroll 8
            for (int d2 = 0; d2 < 64; ++d2) { const unsigned w2 = wr[d2]; a -= lo16(w2) * SST[(2 * d2) * 33 + e] + hi16(w2) * SST[(2 * d2 + 1) * 33 + e]; }
            VN[ci * 33 + e] = a; }
        __syncthreads();
#pragma unroll 1
        for (int r = 0; r < 4; ++r) { const int ci = cc + 16 * r; float a = 0.f;
            const LAS unsigned* qr = (const LAS unsigned*)(QDL + ci * 128);
#pragma unroll 8
            for (int d2 = 0; d2 < 64; ++d2) { const unsigned w2 = qr[d2]; a += lo16(w2) * SST[(2 * d2) * 33 + e] + hi16(w2) * SST[(2 * d2 + 1) * 33 + e]; }
            const LAS unsigned* kr = (const LAS unsigned*)(QKL + ci * 64);
#pragma unroll 8
            for (int j2 = 0; j2 < 32; ++j2) { const unsigned w2 = kr[j2]; a += lo16(w2) * VN[(2 * j2) * 33 + e] + hi16(w2) * VN[(2 * j2 + 1) * 33 + e]; }
            GO[(size_t)(t0 + ci) * 512 + h * 128 + es * 32 + e] = a; }
        const float gl = GL[n]; float sn[8];
#pragma unroll
        for (int r = 0; r < 8; ++r) { const int dk = cc + 16 * r; float a = SST[dk * 33 + e] * gl;
#pragma unroll 8
            for (int ci = 0; ci < 64; ++ci) a += bf2f(KDL[ci * 128 + dk]) * VN[ci * 33 + e];
            sn[r] = a; }
        __syncthreads();
#pragma unroll
        for (int r = 0; r < 8; ++r) SST[(cc + 16 * r) * 33 + e] = sn[r];
    }
    __syncthreads();
}
__device__ __forceinline__ void gdn_finish_phase(const Ctx& c, int l) {
    const GAS float* GO = WSG(float, O_GO); const GAS bf16_t* P = WSG(bf16_t, O_PROJ); GAS bf16_t* YA = WSG(bf16_t, O_YA);
    const float nw0 = ING(9)[l * 128 + c.lane], nw1 = ING(9)[l * 128 + 64 + c.lane];
    for (int t = c.gw; t < T; t += c.NGW) {
#pragma unroll
        for (int h = 0; h < 4; ++h) { const float o0 = GO[(size_t)t * 512 + h * 128 + c.lane], o1 = GO[(size_t)t * 512 + h * 128 + 64 + c.lane];
            const float r = rsqrtf(wave_sum(o0 * o0 + o1 * o1) * (1.f / 128.f) + EPS);
            const float z0 = bf2f(P[(size_t)t * NP + C_GZ + h * 128 + c.lane]), z1 = bf2f(P[(size_t)t * NP + C_GZ + h * 128 + 64 + c.lane]);
            YA[(size_t)t * 512 + h * 128 + c.lane] = (bf16_t)f2bf(o0 * r * nw0 * siluf_(z0)); YA[(size_t)t * 512 + h * 128 + 64 + c.lane] = (bf16_t)f2bf(o1 * r * nw1 * siluf_(z1)); }
    }
}
__device__ __forceinline__ void ssd_prep_unit(const Ctx& c, int l, int unit) {
    const int grp = unit & 1, n = (unit >> 1) & 63, b = unit >> 7;
    const int t0 = b * SEQ + n * CH;
    LAS bf16_t* XT = (LAS bf16_t*)c.lds; LAS bf16_t* XTS = XT + 256 * 72; LAS bf16_t* BT = XTS + 256 * 72;
    LAS bf16_t* Bm = BT + 128 * 72; LAS bf16_t* Cm = Bm + 64 * 136;
    LAS float* DT = (LAS float*)(Cm + 64 * 136); LAS float* ACS = DT + 256; LAS float* SCV = ACS + 256;
    const GAS bf16_t* P = WSG(bf16_t, O_PROJ);
    if (c.wave < 4) { const int hq = c.wave, hh = grp * 4 + hq, t = c.lane;
        const float dt = softplusf_(WSG(float, O_SMALLF)[(size_t)(t0 + t) * 16 + 8 + hh] + ING(13)[l * 8 + hh]);
        float a = -expf(ING(12)[l * 8 + hh]) * dt;
#pragma unroll
        for (int o = 1; o < 64; o <<= 1) { const float up = __shfl_up(a, o); if (t >= o) a += up; }
        const float alast = __shfl(a, 63);
        DT[hq * 64 + t] = dt; ACS[hq * 64 + t] = a; SCV[hq * 64 + t] = dt * expf(alast - a); const float ea = expf(a); WSG(float, O_EA)[(size_t)(t0 + t) * 8 + hh] = ea;
        if (t == 63) WSG(float, O_DEC)[(b * 8 + hh) * 64 + n] = ea; }
    LDS_BARRIER();
    { const int ch = c.tid < 256 ? grp * 256 + c.tid : c.tid < 384 ? 512 + grp * 128 + (c.tid - 256) : 768 + grp * 128 + (c.tid - 384);
      const GAS float* cw = ING(10) + (size_t)l * 4 * 1024 + ch; const float w0 = cw[0], w1 = cw[1024], w2 = cw[2048], w3 = cw[3072], bias = ING(11)[l * 1024 + ch];
      const GAS bf16_t* src = P + (size_t)(t0 - 3) * NP + C_XBC + ch;
      unsigned short raw[67];
#pragma unroll
      for (int r = 0; r < 67; ++r) raw[r] = (n > 0 || r >= 3) ? src[(size_t)r * NP] : (unsigned short)0;
      const int hq = c.tid >> 6;
#pragma unroll
      for (int t8 = 0; t8 < 8; ++t8) { float y[8];
#pragma unroll
          for (int k = 0; k < 8; ++k) { const int t = t8 * 8 + k; y[k] = siluf_(w0 * bf2f(raw[t]) + w1 * bf2f(raw[t + 1]) + w2 * bf2f(raw[t + 2]) + w3 * bf2f(raw[t + 3]) + bias); }
          u32x4 o; o.x = pk2(y[0], y[1]); o.y = pk2(y[2], y[3]); o.z = pk2(y[4], y[5]); o.w = pk2(y[6], y[7]);
          if (c.tid < 256) { *(LAS u32x4*)(XT + c.tid * 72 + t8 * 8) = o; const LAS float* sv = SCV + hq * 64 + t8 * 8;
              u32x4 q; q.x = pk2(y[0] * sv[0], y[1] * sv[1]); q.y = pk2(y[2] * sv[2], y[3] * sv[3]); q.z = pk2(y[4] * sv[4], y[5] * sv[5]); q.w = pk2(y[6] * sv[6], y[7] * sv[7]);
              *(LAS u32x4*)(XTS + c.tid * 72 + t8 * 8) = q; }
          else if (c.tid < 384) { const int nn = c.tid - 256; *(LAS u32x4*)(BT + nn * 72 + t8 * 8) = o;
#pragma unroll
              for (int k = 0; k < 8; ++k) Bm[(t8 * 8 + k) * 136 + nn] = (bf16_t)f2bf(y[k]); }
          else { const int nn = c.tid - 384; GAS bf16_t* CC = WSG(bf16_t, O_SCC) + (size_t)t0 * 256 + grp * 128 + nn;
#pragma unroll
              for (int k = 0; k < 8; ++k) { const bf16_t v = (bf16_t)f2bf(y[k]); Cm[(t8 * 8 + k) * 136 + nn] = v; CC[(size_t)(t8 * 8 + k) * 256] = v; } } } }
    LDS_BARRIER();
    const int lr = c.lane & 15, g = c.lane >> 4;
    { const int tl = c.wave & 3, hp = c.wave >> 2, lcol = 16 * tl + lr;
      f32x4 cb[4];
#pragma unroll
      for (int ts = 0; ts < 4; ++ts) { cb[ts] = (f32x4){0.f, 0.f, 0.f, 0.f};
          if (ts <= tl) {
#pragma unroll
              for (int ks = 0; ks < 4; ++ks) cb[ts] = __builtin_amdgcn_mfma_f32_16x16x32_bf16(*(const LAS bf16x8*)(Bm + (16 * ts + lr) * 136 + 32 * ks + 8 * g), *(const LAS bf16x8*)(Cm + lcol * 136 + 32 * ks + 8 * g), cb[ts], 0, 0, 0); } }
#pragma unroll 1
      for (int hq = 2 * hp; hq < 2 * hp + 2; ++hq) { const int hh = grp * 4 + hq; const float dsk = ING(14)[l * 8 + hh], al = ACS[hq * 64 + lcol];
          f32x4 mt[4];
#pragma unroll
          for (int ts = 0; ts < 4; ++ts)
#pragma unroll
              for (int r = 0; r < 4; ++r) { const int sx = 16 * ts + 4 * g + r; float v = 0.f; if (sx <= lcol) v = cb[ts][r] * __expf(al - ACS[hq * 64 + sx]) * DT[hq * 64 + sx]; if (sx == lcol) v += dsk; mt[ts][r] = v; }
          bf16x8 mb[2];
#pragma unroll
          for (int k2 = 0; k2 < 2; ++k2) { u32x4 w; w.x = pk2(mt[2 * k2][0], mt[2 * k2][1]); w.y = pk2(mt[2 * k2][2], mt[2 * k2][3]); w.z = pk2(mt[2 * k2 + 1][0], mt[2 * k2 + 1][1]); w.w = pk2(mt[2 * k2 + 1][2], mt[2 * k2 + 1][3]); mb[k2] = __builtin_bit_cast(bf16x8, w); }
          GAS bf16_t* YP = WSG(bf16_t, O_SYP) + (size_t)(t0 + lcol) * 512 + hh * 64 + 4 * g;
#pragma unroll
          for (int tp = 0; tp < 4; ++tp) { f32x4 acc = {0.f, 0.f, 0.f, 0.f};
#pragma unroll
              for (int k2 = 0; k2 < 2; ++k2) { const LAS bf16_t* xp = XT + (hq * 64 + 16 * tp + lr) * 72 + 32 * k2 + 4 * g; const u32x2 lo = *(const LAS u32x2*)xp, hi = *(const LAS u32x2*)(xp + 16);
                  u32x4 w; w.x = lo.x; w.y = lo.y; w.z = hi.x; w.w = hi.y; acc = __builtin_amdgcn_mfma_f32_16x16x32_bf16(__builtin_bit_cast(bf16x8, w), mb[k2], acc, 0, 0, 0); }
              { u32x2 o; o.x = pk2_sw(acc[0], acc[1]); o.y = pk2_sw(acc[2], acc[3]); *(GAS u32x2*)(YP + 16 * tp) = o; } } } }
    { const int hq = c.wave >> 1, hh = grp * 4 + hq; GAS bf16_t* ST = WSG(bf16_t, O_SST) + ((size_t)((b * 8 + hh) * 64 + n)) * 8192;
#pragma unroll 1
      for (int tq = 0; tq < 4; ++tq) { const int tn = 4 * (c.wave & 1) + tq;
          const bf16x8 a0 = *(const LAS bf16x8*)(BT + (16 * tn + lr) * 72 + 8 * g), a1 = *(const LAS bf16x8*)(BT + (16 * tn + lr) * 72 + 32 + 8 * g);
#pragma unroll
          for (int tp = 0; tp < 4; ++tp) { f32x4 acc = {0.f, 0.f, 0.f, 0.f}; const LAS bf16_t* xp = XTS + (hq * 64 + 16 * tp + lr) * 72 + 8 * g;
              acc = __builtin_amdgcn_mfma_f32_16x16x32_bf16(a0, *(const LAS bf16x8*)xp, acc, 0, 0, 0); acc = __builtin_amdgcn_mfma_f32_16x16x32_bf16(a1, *(const LAS bf16x8*)(xp + 32), acc, 0, 0, 0);
              { u32x2 o; o.x = pk2_sw(acc[0], acc[1]); o.y = pk2_sw(acc[2], acc[3]); *(GAS u32x2*)(ST + (size_t)(16 * tp + lr) * 128 + 16 * tn + 4 * g) = o; } } } }
    LDS_BARRIER();
}
__device__ __forceinline__ void ssd_scan_phase(const Ctx& c) {
    const GAS bf16_t* ST = WSG(bf16_t, O_SST); const GAS float* DEC = WSG(float, O_DEC); GAS bf16_t* HB = WSG(bf16_t, O_MB);
    const int nthr = 128 * 448, me = c.wg * 448 + (c.tid - 64);
    for (int idx = me; idx < NB * 8 * 8192; idx += nthr) {
        const int bh = idx >> 13, el = idx & 8191; const GAS bf16_t* p = ST + (size_t)bh * 64 * 8192 + el; GAS bf16_t* hb = HB + (size_t)bh * 64 * 8192 + el; const GAS float* dc = DEC + bh * 64;
        float hcur = 0.f;
#pragma unroll 1
        for (int n0 = 0; n0 < 64; n0 += 32) { bf16_t s[32];
#pragma unroll
            for (int k = 0; k < 32; ++k) s[k] = p[(size_t)(n0 + k) * 8192];
#pragma unroll
            for (int k = 0; k < 32; ++k) { hb[(size_t)(n0 + k) * 8192] = (bf16_t)f2bf(hcur); hcur = hcur * dc[n0 + k] + bf2f(s[k]); } }
    }
}
__device__ __forceinline__ void ssd_finish_unit(const Ctx& c, int l, int unit) {
    const int grp = unit & 1, n = (unit >> 1) & 63, b = unit >> 7;
    const int t0 = b * SEQ + n * CH;
    LAS float* YS = (LAS float*)c.lds;
    const GAS bf16_t* CC = WSG(bf16_t, O_SCC); const GAS float* EA = WSG(float, O_EA); const GAS bf16_t* YP = WSG(bf16_t, O_SYP);
    const int lr = c.lane & 15, g = c.lane >> 4;
    { const int hq = c.wave >> 1, hh = grp * 4 + hq; const GAS bf16_t* HB = WSG(bf16_t, O_MB) + ((size_t)((b * 8 + hh) * 64 + n)) * 8192;
      f32x4 acc[4][2];
#pragma unroll
      for (int tp = 0; tp < 4; ++tp) { acc[tp][0] = (f32x4){0.f, 0.f, 0.f, 0.f}; acc[tp][1] = (f32x4){0.f, 0.f, 0.f, 0.f}; }
#pragma unroll
      for (int ks = 0; ks < 4; ++ks) { bf16x8 cf[2];
#pragma unroll
          for (int q = 0; q < 2; ++q) cf[q] = *(const GAS bf16x8*)(CC + (size_t)(t0 + 16 * (2 * (c.wave & 1) + q) + lr) * 256 + grp * 128 + 32 * ks + 8 * g);
#pragma unroll
          for (int tp = 0; tp < 4; ++tp) { const bf16x8 pf = *(const GAS bf16x8*)(HB + (size_t)(16 * tp + lr) * 128 + 32 * ks + 8 * g);
              acc[tp][0] = __builtin_amdgcn_mfma_f32_16x16x32_bf16(pf, cf[0], acc[tp][0], 0, 0, 0); acc[tp][1] = __builtin_amdgcn_mfma_f32_16x16x32_bf16(pf, cf[1], acc[tp][1], 0, 0, 0); } }
#pragma unroll
      for (int q = 0; q < 2; ++q) { const int li = 16 * (2 * (c.wave & 1) + q) + lr; const float ea = EA[(size_t)(t0 + li) * 8 + hh];
#pragma unroll
          for (int tp = 0; tp < 4; ++tp) { const u32x2 yw = *(const GAS u32x2*)(YP + (size_t)(t0 + li) * 512 + hh * 64 + 16 * tp + 4 * g); const f32x4 yp = {lo16(yw.x), hi16(yw.x), lo16(yw.y), hi16(yw.y)}; const f32x4 y = yp + acc[tp][q] * ea;
              LAS float* d = YS + li * 260 + hq * 64 + 16 * tp + 4 * g; d[0] = y[0]; d[1] = y[1]; d[2] = y[2]; d[3] = y[3]; } } }
    LDS_BARRIER();
    const GAS bf16_t* P = WSG(bf16_t, O_PROJ); GAS bf16_t* YB = WSG(bf16_t, O_YB); const GAS float* nw = ING(15) + l * 512 + grp * 256;
    for (int li = c.wave; li < 64; li += NWAVES) { const int t = t0 + li; float y[4]; float ss = 0.f;
#pragma unroll
        for (int q = 0; q < 4; ++q) { const int ch = c.lane + 64 * q; const float z = bf2f(P[(size_t)t * NP + C_SZ + grp * 256 + ch]); y[q] = YS[li * 260 + ch] * siluf_(z); ss += y[q] * y[q]; }
        const float r = rsqrtf(wave_sum(ss) * (1.f / 256.f) + EPS);
#pragma unroll
        for (int q = 0; q < 4; ++q) { const int ch = c.lane + 64 * q; YB[(size_t)t * 512 + grp * 256 + ch] = (bf16_t)f2bf(y[q] * r * nw[ch]); } }
    LDS_BARRIER();
}

__device__ __forceinline__ void mla_rows_phase(const Ctx& c) {
    const GAS bf16_t* P = WSG(bf16_t, O_PROJ); const GAS float* ROPE = WSG(float, O_ROPE); GAS bf16_t* KR = WSG(bf16_t, O_KR);
    for (int t = c.gw; t < T; t += c.NGW) {
        const GAS bf16_t* pr = P + (size_t)t * NP;
        const u32x4 a = *(const GAS u32x4*)(pr + C_CQ + 8 * c.lane); const u32x2 k2 = *(const GAS u32x2*)(pr + C_CKV + 4 * c.lane);
        f32x4 a0, a1; unpk8(a, a0, a1);
        float sq = (a0[0] * a0[0] + a0[1] * a0[1]) + (a0[2] * a0[2] + a0[3] * a0[3]) + (a1[0] * a1[0] + a1[1] * a1[1]) + (a1[2] * a1[2] + a1[3] * a1[3]);
        const float k0 = lo16(k2.x), k1 = hi16(k2.x), k2f = lo16(k2.y), k3 = hi16(k2.y); float sk = (k0 * k0 + k1 * k1) + (k2f * k2f + k3 * k3);
        sq = wave_sum(sq); sk = wave_sum(sk);
        const float x = bf2f(pr[C_KR + c.lane]); const float xo = __shfl_xor(x, 32);
        if (c.lane == 0) { WSG(float, O_RQ)[t] = rsqrtf(sq * (1.f / 512.f) + EPS); WSG(float, O_RKV)[t] = rsqrtf(sk * (1.f / 256.f) + EPS); }
        if (c.lane < 32) { const float cs = ROPE[((size_t)t * 32 + c.lane) * 2], sn = ROPE[((size_t)t * 32 + c.lane) * 2 + 1];
            *(GAS unsigned*)(KR + (size_t)t * 64 + 2 * c.lane) = pk2(x * cs - xo * sn, xo * cs + x * sn); }
    }
}
__device__ __forceinline__ float xmax16(float v) { const auto r = __builtin_amdgcn_permlane16_swap(__float_as_uint(v), __float_as_uint(v), false, false); return fmaxf(__uint_as_float(r[0]), __uint_as_float(r[1])); }
__device__ __forceinline__ float xmax32(float v) { const auto r = __builtin_amdgcn_permlane32_swap(__float_as_uint(v), __float_as_uint(v), false, false); return fmaxf(__uint_as_float(r[0]), __uint_as_float(r[1])); }
__device__ __forceinline__ float xsum16(float v) { const auto r = __builtin_amdgcn_permlane16_swap(__float_as_uint(v), __float_as_uint(v), false, false); return __uint_as_float(r[0]) + __uint_as_float(r[1]); }
__device__ __forceinline__ float xsum32(float v) { const auto r = __builtin_amdgcn_permlane32_swap(__float_as_uint(v), __float_as_uint(v), false, false); return __uint_as_float(r[0]) + __uint_as_float(r[1]); }
__device__ __forceinline__ void attn_item(const Ctx& c, int item) {
    const int bh = item >> 4, qi = item & 15, b = bh >> 2, h = bh & 3;
    const GAS bf16_t* Q = WSG(bf16_t, O_Q); const GAS bf16_t* KN = WSG(bf16_t, O_KN); const GAS bf16_t* KR = WSG(bf16_t, O_KR); const GAS bf16_t* VT = WSG(bf16_t, O_VT); GAS bf16_t* YC = WSG(bf16_t, O_YC);
    const int lr = c.lane & 15, g = c.lane >> 4, sw = lr >> 1, swk = 2 * (lr >> 2) + ((lr >> 1) & 1), keyl = 8 * (lr >> 2) + (lr & 3);
    constexpr int KT_BYTES = 64 * 384, BUF_BYTES = KT_BYTES + 128 * 128;
    const char* kp[3]; int kstr[3]; const char* vp[2];
#pragma unroll
    for (int i = 0; i < 3; ++i) { const int ch = (3 * c.wave + i) * 64 + c.lane, key = ch / 24, pq = ch % 24, part = pq ^ (2 * ((key >> 3) & 3) + ((key >> 1) & 1)); const size_t tk = (size_t)(b * SEQ + key);
        if (part < 16) { kp[i] = (const char*)(KN + tk * 512 + h * 128 + part * 8); kstr[i] = 1024; } else { kp[i] = (const char*)(KR + tk * 64 + (part - 16) * 8); kstr[i] = 128; } }
#pragma unroll
    for (int i = 0; i < 2; ++i) { const int ch = (2 * c.wave + i) * 64 + c.lane, dv = ch >> 3, q8 = (ch & 7) ^ ((dv >> 1) & 7); vp[i] = (const char*)(VT + (size_t)(h * 128 + dv) * T + b * SEQ + q8 * 8); }
#define AT_DMA(kb_, buf_) do { LAS unsigned char* d_ = c.lds + (buf_) * BUF_BYTES; \
        _Pragma("unroll") for (int i_ = 0; i_ < 3; ++i_) __builtin_amdgcn_global_load_lds((const unsigned*)(kp[i_] + (size_t)(kb_) * kstr[i_]), (LAS unsigned*)(d_ + (3 * c.wave + i_) * 1024), 16, 0, 0); \
        _Pragma("unroll") for (int i_ = 0; i_ < 2; ++i_) __builtin_amdgcn_global_load_lds((const unsigned*)(vp[i_] + (size_t)(kb_) * 2), (LAS unsigned*)(d_ + KT_BYTES + (2 * c.wave + i_) * 1024), 16, 0, 0); } while (0)
    int koff[6], voff[2];
#pragma unroll
    for (int ks = 0; ks < 6; ++ks) koff[ks] = keyl * 384 + (((4 * ks + g) ^ swk) * 16);
#pragma unroll
    for (int pp = 0; pp < 2; ++pp) voff[pp] = lr * 128 + (((4 * pp + g) ^ sw) * 16);
#define AT_QK(dst_, buf_) do { const LAS unsigned char* Kt_ = c.lds + (buf_) * BUF_BYTES; \
        _Pragma("unroll") for (int a_ = 0; a_ < 4; ++a_) { dst_[a_] = (f32x4){0.f, 0.f, 0.f, 0.f}; \
            _Pragma("unroll") for (int ks_ = 0; ks_ < 6; ++ks_) dst_[a_] = __builtin_amdgcn_mfma_f32_16x16x32_bf16(*(const LAS bf16x8*)(Kt_ + ((a_ >> 1) * 32 + (a_ & 1) * 4) * 384 + koff[ks_]), qf[ks_], dst_[a_], 0, 0, 0); } } while (0)
#pragma unroll 1
    for (int half = 0; half < 2; ++half) {
        const int qb = half ? 31 - qi : qi; const int q0 = qb * 128 + c.wave * 16; const int tq = b * SEQ + q0 + lr;
        bf16x8 qf[6];
#pragma unroll
        for (int ks = 0; ks < 6; ++ks) qf[ks] = *(const GAS bf16x8*)(Q + (size_t)tq * 768 + h * 192 + 32 * ks + 8 * g);
        f32x4 o[8];
#pragma unroll
        for (int d = 0; d < 8; ++d) o[d] = (f32x4){0.f, 0.f, 0.f, 0.f};
        float mrow = -3.0e38f, lsum = 0.f;
        const int nkt = 2 * qb + 2;
        asm volatile("s_waitcnt vmcnt(0)" ::: "memory");
        LDS_BARRIER();
        AT_DMA(0, 0); AT_DMA(64, 1);
        asm volatile("s_waitcnt vmcnt(0)" ::: "memory"); LDS_BARRIER();
        f32x4 s[4], sn[4];
        AT_QK(s, 0);
#pragma unroll 1
        for (int kt = 0; kt < nkt; ++kt) {
            const int kbase = kt * 64; const int b0 = kt % 3, b1 = (kt + 1) % 3, b2 = (kt + 2) % 3;
            if (kt + 2 < nkt) AT_DMA(kbase + 128, b2);
            const bool act = kbase <= q0 + 15, actn = (kt + 1 < nkt) && (kbase + 64 <= q0 + 15);
            if (actn) AT_QK(sn, b1);
            if (act) {
                const LAS unsigned char* Vt = c.lds + b0 * BUF_BYTES + KT_BYTES;
                const int qpos = q0 + lr; float mx = -3.0e38f;
                if (kbase + 63 > q0) {
#pragma unroll
                    for (int a = 0; a < 4; ++a)
#pragma unroll
                        for (int r = 0; r < 4; ++r) { const int key = kbase + 32 * (a >> 1) + 8 * g + 4 * (a & 1) + r; if (key > qpos) s[a][r] = -3.0e38f; } }
#pragma unroll
                for (int a = 0; a < 4; ++a)
#pragma unroll
                    for (int r = 0; r < 4; ++r) mx = fmaxf(mx, s[a][r]);
                mx = xmax32(xmax16(mx));
                if (!__all(mx - mrow <= 8.f)) {
                    const float mnew = fmaxf(mrow, mx), alpha = __builtin_amdgcn_exp2f(mrow - mnew); mrow = mnew; lsum *= alpha;
#pragma unroll
                    for (int d = 0; d < 8; ++d) o[d] = o[d] * alpha; }
                float ps = 0.f;
#pragma unroll
                for (int a = 0; a < 4; ++a)
#pragma unroll
                    for (int r = 0; r < 4; ++r) { const float p = __builtin_amdgcn_exp2f(s[a][r] - mrow); s[a][r] = p; ps += p; }
                lsum += ps;
#pragma unroll
                for (int pp = 0; pp < 2; ++pp) { u32x4 pw; pw.x = pk2(s[2 * pp][0], s[2 * pp][1]); pw.y = pk2(s[2 * pp][2], s[2 * pp][3]); pw.z = pk2(s[2 * pp + 1][0], s[2 * pp + 1][1]); pw.w = pk2(s[2 * pp + 1][2], s[2 * pp + 1][3]);
                    const bf16x8 pf = __builtin_bit_cast(bf16x8, pw);
#pragma unroll
                    for (int d = 0; d < 8; ++d) o[d] = __builtin_amdgcn_mfma_f32_16x16x32_bf16(*(const LAS bf16x8*)(Vt + d * 2048 + voff[pp]), pf, o[d], 0, 0, 0); }
            }
            asm volatile("s_waitcnt vmcnt(0)" ::: "memory");
            LDS_BARRIER();
#pragma unroll
            for (int a = 0; a < 4; ++a) s[a] = sn[a];
        }
        lsum = xsum32(xsum16(lsum));
        const float inv = 1.f / lsum;
#pragma unroll
        for (int d = 0; d < 8; ++d) { u32x2 w; w.x = pk2(o[d][0] * inv, o[d][1] * inv); w.y = pk2(o[d][2] * inv, o[d][3] * inv);
            *(GAS u32x2*)(YC + (size_t)tq * 512 + h * 128 + 16 * d + 4 * g) = w; }
    }
#undef AT_DMA
#undef AT_QK
}
struct FProj { bf16_t* P; float* sf;
    __device__ __forceinline__ void oct(const pg8::Unit&, int row, int col, f32x4 v0, f32x4 v1) const {
        *(u32x4*)(P + (size_t)row * NP + col) = pk8(v0, v1);
        if (col >= C_SMALL && col < C_SMALL + 16) { float* d = sf + (size_t)row * 16 + (col - C_SMALL); *(f32x4*)d = v0; *(f32x4*)(d + 4) = v1; } } };
struct FQ { bf16_t* Q; const float* rq; const float* rope;
    __device__ __forceinline__ void oct(const pg8::Unit&, int row, int col, f32x4 v0, f32x4 v1) const {
        const float r = rq[row] * (0.07216878364870322f * 1.4426950408889634f); v0 = v0 * r; v1 = v1 * r;
        const int j = col % 192;
        if (j >= 128) { const float* cs = rope + ((size_t)row * 32 + ((j - 128) >> 1)) * 2; const f32x4 c0 = *(const f32x4*)cs, c1 = *(const f32x4*)(cs + 4);
            const f32x4 a = v0, bq = v1;
            v0[0] = a[0] * c0[0] - a[1] * c0[1]; v0[1] = a[1] * c0[0] + a[0] * c0[1]; v0[2] = a[2] * c0[2] - a[3] * c0[3]; v0[3] = a[3] * c0[2] + a[2] * c0[3];
            v1[0] = bq[0] * c1[0] - bq[1] * c1[1]; v1[1] = bq[1] * c1[0] + bq[0] * c1[1]; v1[2] = bq[2] * c1[2] - bq[3] * c1[3]; v1[3] = bq[3] * c1[2] + bq[2] * c1[3]; }
        *(u32x4*)(Q + (size_t)row * 768 + col) = pk8(v0, v1); } };
struct FKN { bf16_t* KN; const float* rkv;
    __device__ __forceinline__ void oct(const pg8::Unit&, int row, int col, f32x4 v0, f32x4 v1) const { const float r = rkv[row]; *(u32x4*)(KN + (size_t)row * 512 + col) = pk8(v0 * r, v1 * r); } };
struct FVT { bf16_t* VT; const float* rkv;
    __device__ __forceinline__ void oct(const pg8::Unit&, int row, int col, f32x4 v0, f32x4 v1) const { const f32x4 r0 = *(const f32x4*)(rkv + col), r1 = *(const f32x4*)(rkv + col + 4); *(u32x4*)(VT + (size_t)row * T + col) = pk8(v0 * r0, v1 * r1); } };
struct FMergeAll { const bf16_t* P; bf16_t* MB;
    __device__ __forceinline__ void oct(const pg8::Unit& u, int row, int col, f32x4 v0, f32x4 v1) const {
        f32x4 g0, g1; unpk8(*(const u32x4*)(P + (size_t)row * NP + C_GATE + u.kb * 1024 + col), g0, g1);
#pragma unroll
        for (int i = 0; i < 4; ++i) { v0[i] *= sigmoidf_(g0[i]); v1[i] *= sigmoidf_(g1[i]); }
        bf16_t* m = MB + (size_t)row * D + col;
        if (u.kb > 0) { f32x4 p0, p1; unpk8(*(const u32x4*)m, p0, p1); v0 = v0 + p0; v1 = v1 + p1; }
        *(u32x4*)m = pk8(v0, v1); } };
struct FRes { float* X; const float* Xs; const float* gate;
    __device__ __forceinline__ void oct(const pg8::Unit&, int row, int col, f32x4 v0, f32x4 v1) const {
        const float* g = gate + (size_t)(row >> 12) * 6144 + col; float* x = X + (size_t)row * D + col; const float* xs = Xs + (size_t)row * D + col;
        *(f32x4*)x = *(const f32x4*)xs + *(const f32x4*)g * v0; *(f32x4*)(x + 4) = *(const f32x4*)(xs + 4) + *(const f32x4*)(g + 4) * v1; } };
struct FGU { bf16_t* Hd; int ld;
    __device__ __forceinline__ void gu(const pg8::Unit&, int row, int fcol, f32x4 g0, f32x4 g1, f32x4 u0, f32x4 u1) const {
#pragma unroll
        for (int i = 0; i < 4; ++i) { g0[i] = siluf_(g0[i]) * u0[i]; g1[i] = siluf_(g1[i]) * u1[i]; }
        *(u32x4*)(Hd + (size_t)row * ld + fcol) = pk8(g0, g1); } };
struct FYT { float* YT; int row0;
    __device__ __forceinline__ void oct(const pg8::Unit& u, int row, int col, f32x4 v0, f32x4 v1) const { float* d = YT + (size_t)u.kb * (8 * 256 * 1024) + (size_t)(row - row0) * D + col;
        *(f32x4*)d = v0; *(f32x4*)(d + 4) = v1; } };
struct FY { bf16_t* Y;
    __device__ __forceinline__ void oct(const pg8::Unit&, int row, int col, f32x4 v0, f32x4 v1) const { *(u32x4*)(Y + (size_t)row * D + col) = pk8(v0, v1); } };

template <int SITE, class F, class Sched> __device__ __forceinline__ void run_gemm_oct(const Ctx& c, const pg8::Gemm& g, const Sched& S, const F& f) {
    if constexpr ((FASTMASK >> SITE) & 1u) { pg8::EpiOct<F> E{f}; pg8::gemm_phase<pg8::EpiOct<F>, Sched, true>(c.lds, g, S, E); }
    else pg8::gemm_simple_oct(g, S, f);
}
template <int SITE, class F, class Sched> __device__ __forceinline__ void run_gemm_gu(const Ctx& c, const pg8::Gemm& g, const Sched& S, const F& f) {
    if constexpr ((FASTMASK >> SITE) & 1u) { pg8::EpiGU<F> E{f}; pg8::gemm_phase<pg8::EpiGU<F>, Sched, true>(c.lds, g, S, E); }
    else pg8::gemm_simple_gu(g, S, f);
}

#ifndef PHMASK
#define PHMASK 0xFFFFFFFFu
#endif
#define ON(k) (((PHMASK) >> (k)) & 1u)
#ifndef REPMASK
#define REPMASK 0u
#endif
#define NREP(k) ((((REPMASK) >> (k)) & 1u) ? 2 : 1)
template <class P> __device__ __forceinline__ P* launder_ptr(P* p) {
    unsigned long long v = (unsigned long long)p; unsigned lo = (unsigned)v, hi = (unsigned)(v >> 32);
    asm volatile("" : "+v"(lo), "+v"(hi));
    lo = __builtin_amdgcn_readfirstlane(lo); hi = __builtin_amdgcn_readfirstlane(hi);
    return (P*)(((unsigned long long)hi << 32) | lo);
}
__device__ __forceinline__ LAS unsigned char* launder_lds(LAS unsigned char* p) { unsigned v = (unsigned)(uintptr_t)p; asm volatile("" : "+v"(v)); v = __builtin_amdgcn_readfirstlane(v); return (LAS unsigned char*)(uintptr_t)v; }
typedef const float* const __attribute__((address_space(4)))* kargp_t;
__device__ __forceinline__ kargp_t launder_kptr(kargp_t p) { unsigned long long v = (unsigned long long)p; unsigned lo = (unsigned)v, hi = (unsigned)(v >> 32);
    asm volatile("" : "+v"(lo), "+v"(hi)); lo = __builtin_amdgcn_readfirstlane(lo); hi = __builtin_amdgcn_readfirstlane(hi); return (kargp_t)(((unsigned long long)hi << 32) | lo); }
struct Args { const float* in[33]; float* out; unsigned char* ws; int ph_lo, ph_hi; };
constexpr int N_PHASES = 1 + NL * 10 + 2 + 1;

#define PHASE_BEGIN if (pc >= lo && pc < hi) { { int t_ = threadIdx.x; asm volatile("" : "+v"(t_) :: "memory"); c.tid = t_; c.lane = t_ & 63; c.wave = __builtin_amdgcn_readfirstlane(t_ >> 6); { unsigned g_ = gridDim.x, w_ = blockIdx.x; asm volatile("" : "+v"(g_), "+v"(w_)); c.G = __builtin_amdgcn_readfirstlane(g_); c.wg = __builtin_amdgcn_readfirstlane(w_); } c.gw = c.wg * NWAVES + c.wave; c.NGW = c.G * NWAVES; c.lds = launder_lds(c.lds); c.ws = launder_ptr(c.ws); c.in = launder_kptr(c.in); c.X = launder_ptr(c.X); }
#ifdef PROBE_BAR2
#define PHASE_END   if (pc + 1 < hi) { XcdBarrier b2_ = bar; b2_.bar = launder_ptr(bar.bar); xcd_barrier(b2_); xcd_barrier(b2_); } } ++pc;
#else
#define PHASE_END   if (pc + 1 < hi) { XcdBarrier b2_ = bar; b2_.bar = launder_ptr(bar.bar); xcd_barrier(b2_); } } ++pc;
#endif
template <int L> __device__ __forceinline__ void layer_body(Ctx& c, const int lo, const int hi, int& pc, const XcdBarrier& bar) {
        constexpr int l = L; constexpr bool moe = (L & 1) != 0; constexpr int fi = L >> 1;
        const float* MODL = WSP(float, O_MOD) + (size_t)l * 4 * 6144;
        PHASE_BEGIN if constexpr (ON(1)) { if (NREP(16) > 1) norm_phase(c, l, 0, -1, l == 0 ? c.in[0] : nullptr); norm_phase(c, l, 0, (l > 0 && ((l - 1) & 1)) ? l - 1 : -1, l == 0 ? c.in[0] : nullptr); } PHASE_END
        PHASE_BEGIN if constexpr (ON(2)) { pg8::Gemm g{WSP(bf16_t, O_H), WSP(bf16_t, O_WIN) + (size_t)l * NP * 1024, 1024, 1024, 1024}; pg8::StaticOrder S; S.init(T / 256, NP / 256, c.G, c.wg);
            for (int rep_ = 0; rep_ < NREP(27); ++rep_) run_gemm_oct<0>(c, g, S, FProj{WSP(bf16_t, O_PROJ), WSP(float, O_SMALLF)}); } PHASE_END
        PHASE_BEGIN
#ifdef GDNPREP_STOP
            for (int u = c.wg; u < NB * NCH * 4; u += c.G) gdn_prep_unit(c, l, u, GDNPREP_STOP);
#endif
            for (int rep_ = 0; rep_ < NREP(24); ++rep_) for (int u = c.wg; u < NB * NCH * 4; u += c.G) gdn_prep_unit(c, l, u);
            for (int rep_ = 0; rep_ < NREP(25); ++rep_) for (int u = c.wg; u < NB * NCH * 2; u += c.G) ssd_prep_unit(c, l, u);
            if constexpr (ON(3)) mla_rows_phase(c);
        PHASE_END
        PHASE_BEGIN
            if (c.wg < 128) {
                if (c.wave == 0) { for (int rep_ = 0; rep_ < NREP(20); ++rep_) gdn_scan_wave(c, (c.wg & 7) * 2 + (c.wg >> 6), (c.wg >> 3) & 7); }
                else { ssd_scan_phase(c);
                    { LAS float* scr = (LAS float*)(c.lds + 73728 + (c.wave - 1) * 8448); const int rank = c.wg * 7 + (c.wave - 1), count = 896 + (c.G - 128) * 8;
                      for (int r2_ = 0; r2_ < NREP(15); ++r2_) { if (moe) moe_convert_queue(c, l, scr); next_layer_convert_queue(c, l, scr); } } }
            } else {
                const int G2 = c.G - 128, w2 = c.wg - 128;
                for (int rep_ = 0; rep_ < NREP(18); ++rep_) {
                { pg8::Gemm g{WSP(bf16_t, O_PROJ) + C_CQ, WSP(bf16_t, O_WUQ) + (size_t)l * 768 * 512, 512, NP, 512}; pg8::StaticOrder S; S.init(T / 256, 3, G2, w2);
                  run_gemm_oct<1>(c, g, S, FQ{WSP(bf16_t, O_Q), WSP(float, O_RQ), WSP(float, O_ROPE)}); }
                { pg8::Gemm g{WSP(bf16_t, O_PROJ) + C_CKV, WSP(bf16_t, O_WUK) + (size_t)l * 512 * 256, 256, NP, 256}; pg8::StaticOrder S; S.init(T / 256, 2, G2, w2);
                  run_gemm_oct<2>(c, g, S, FKN{WSP(bf16_t, O_KN), WSP(float, O_RKV)}); }
                { pg8::Gemm g{WSP(bf16_t, O_WUV) + (size_t)l * 512 * 256, WSP(bf16_t, O_PROJ) + C_CKV, 256, 256, NP}; pg8::StaticOrder S; S.init(2, T / 256, G2, w2);
                  run_gemm_oct<3>(c, g, S, FVT{WSP(bf16_t, O_VT), WSP(float, O_RKV)}); } }
                { LAS float* scr = (LAS float*)(c.lds + c.wave * 8448); const int rank = 896 + w2 * 8 + c.wave, count = 896 + G2 * 8;
                  for (int r2_ = 0; r2_ < NREP(15); ++r2_) { if (moe) moe_convert_queue(c, l, scr); next_layer_convert_queue(c, l, scr); } }
            }
        PHASE_END
        PHASE_BEGIN
            for (int rep_ = 0; rep_ < NREP(21); ++rep_) for (int it = c.wg; it < 256; it += c.G) attn_item(c, (it & 7) * 32 + (it >> 3));
            for (int rep_ = 0; rep_ < NREP(22); ++rep_) gdn_out_phase(c, l);
            for (int rep_ = 0; rep_ < NREP(23); ++rep_) for (int u = c.wg; u < NB * NCH * 2; u += c.G) ssd_finish_unit(c, l, u);
        PHASE_END
        PHASE_BEGIN for (int rep_ = 0; rep_ < NREP(19); ++rep_) { pg8::BranchOrder S; S.base.init(T / 256, 4, c.G, c.wg); S.nbr = 3; S.astride = (long)(O_YB - O_YA) / 2; S.bstride = (long)1024 * 512;
            pg8::Gemm g{WSP(bf16_t, O_YA), WSP(bf16_t, O_WBR) + (size_t)l * 3 * 1024 * 512, 512, 512, 512};
            run_gemm_oct<4>(c, g, S, FMergeAll{WSP(bf16_t, O_PROJ), WSP(bf16_t, O_MB)}); } PHASE_END
        PHASE_BEGIN if constexpr (ON(7)) { pg8::Gemm g{WSP(bf16_t, O_MB), WSP(bf16_t, O_WOUT) + (size_t)l * 1024 * 1024, 1024, 1024, 1024}; pg8::StaticOrder S; S.init(T / 256, 4, c.G, c.wg);
            if (NREP(17) > 1) run_gemm_oct<7>(c, g, S, FRes{WSP(float, O_MF), l == 0 ? c.in[0] : c.X, MODL + 2048}); run_gemm_oct<7>(c, g, S, FRes{c.X, l == 0 ? c.in[0] : c.X, MODL + 2048}); } PHASE_END
        PHASE_BEGIN if constexpr (ON(8)) { for (int rep_ = 0; rep_ < NREP(16); ++rep_) { if (moe) norm2_moe_phase(c, l); else norm_phase(c, l, 1, -1); } } PHASE_END
        if (moe) { PHASE_BEGIN for (int rep_ = 0; rep_ < NREP(28); ++rep_) moe_assign_phase(c, l); PHASE_END }
        PHASE_BEGIN if constexpr (ON(10)) {
            if (!moe) { pg8::Gemm g{WSP(bf16_t, O_H), WSP(bf16_t, O_WGU) + (size_t)fi * 2 * FF * 1024, 1024, 1024, 1024}; pg8::StaticOrder S; S.init(T / 256, 2 * FF / 256, c.G, c.wg);
                for (int rep_ = 0; rep_ < NREP(29); ++rep_) run_gemm_gu<8>(c, g, S, FGU{WSP(bf16_t, O_PROJ), FF}); }
            else { pg8::Gemm g{WSP(bf16_t, O_XS), WSP(bf16_t, O_WEGU), 1024, 1024, 1024}; pg8::MoeOrder S{WSP(int, O_BLKE), *WSP(int, O_NBLK), 2 * EF / 256, c.G, c.wg, (long)2 * EF * 1024};
                for (int rep_ = 0; rep_ < NREP(30); ++rep_) run_gemm_gu<10>(c, g, S, FGU{WSP(bf16_t, O_PROJ), EF}); }
        } PHASE_END
        PHASE_BEGIN if constexpr (ON(11)) {
            if (!moe) { pg8::Gemm g{WSP(bf16_t, O_PROJ), WSP(bf16_t, O_WDN) + (size_t)fi * 1024 * FF, FF, FF, FF}; pg8::StaticOrder S; S.init(T / 256, 4, c.G, c.wg);
                if (NREP(17) > 1) run_gemm_oct<9>(c, g, S, FRes{WSP(float, O_MF), c.X, MODL + 5120}); run_gemm_oct<9>(c, g, S, FRes{c.X, c.X, MODL + 5120}); }
            else { const int nblk = *WSP(int, O_NBLK), nmainb = WSP(int, O_NBLK)[1];
                { pg8::Gemm g{WSP(bf16_t, O_PROJ), WSP(bf16_t, O_WEDN), EF, EF, EF}; pg8::MoeOrder S{WSP(int, O_BLKE), nmainb, 4, c.G, c.wg, (long)1024 * EF};
                  for (int rep_ = 0; rep_ < NREP(31); ++rep_) run_gemm_oct<11>(c, g, S, FY{WSP(bf16_t, O_YS)}); }
                { pg8::Gemm g{WSP(bf16_t, O_PROJ), WSP(bf16_t, O_WEDN), 512, EF, EF}; pg8::MoeTailOrder S{WSP(int, O_BLKE), nmainb, nblk - nmainb, 7, 512, c.G, c.wg, (long)1024 * EF};
                  run_gemm_oct<12>(c, g, S, FYT{WSP(float, O_MF), nmainb * 256}); } }
        } PHASE_END
    }

__global__ void __launch_bounds__(NTHR, 2) mk_fwd(Args args) {
    extern __shared__ __attribute__((aligned(16))) unsigned char lds_raw[];
    Ctx c;
    c.lds = (LAS unsigned char*)lds_raw;
    c.tid = threadIdx.x; c.lane = c.tid & 63; c.wave = __builtin_amdgcn_readfirstlane(c.tid >> 6);
    c.G = gridDim.x; c.wg = blockIdx.x; c.gw = c.wg * NWAVES + c.wave; c.NGW = c.G * NWAVES;
    c.in = (const float* const __attribute__((address_space(4)))*)__builtin_amdgcn_kernarg_segment_ptr(); c.X = args.out; c.ws = args.ws;
    volatile LAS unsigned* MISC = (volatile LAS unsigned*)(c.lds + LDSCTL_OFF);
    for (int u = c.tid; u < 128; u += NTHR) MISC[u] = 0u;
    __syncthreads();
    const int lo = args.ph_lo, hi = args.ph_hi;
    XcdBarrier bar; bar.bar = (unsigned*)(c.ws + O_CTL) + 1024 + (size_t)(lo & 63) * XCD_BAR_WORDS; bar.x = 0; bar.st = MISC + 8;
    if (hi - lo > 1) bar = xcd_barrier_post(bar.bar, MISC + 8);
    int pc = 0;

    PHASE_BEGIN for (int rep_ = 0; rep_ < NREP(26); ++rep_) p0_prologue(c); PHASE_END

    layer_body<0>(c, lo, hi, pc, bar); layer_body<1>(c, lo, hi, pc, bar); layer_body<2>(c, lo, hi, pc, bar); layer_body<3>(c, lo, hi, pc, bar);
    PHASE_BEGIN if constexpr (ON(12)) final_phase(c, NL - 1); PHASE_END
#undef PHASE_BEGIN
#undef PHASE_END
}

extern "C" void kernel_launch(void* const* d_in, const int* in_sizes, int n_in, void* d_out, int out_size, void* d_ws, size_t ws_size, hipStream_t stream) {
    static int grid = 0;
    if (grid == 0) {
        if (n_in != 33 || out_size != T * D || ws_size < WS_END) { fprintf(stderr, "kernel_launch: unexpected shapes (n_in %d out %d ws %zu need %zu)\n", n_in, out_size, ws_size, (size_t)WS_END); grid = -1; return; }
        int dev = 0, cus = 0, per_cu = 0;
        if (hipGetDevice(&dev) != hipSuccess || hipDeviceGetAttribute(&cus, hipDeviceAttributeMultiprocessorCount, dev) != hipSuccess) { grid = -1; return; }
        if (hipFuncSetAttribute((const void*)mk_fwd, hipFuncAttributeMaxDynamicSharedMemorySize, LDS_BYTES) != hipSuccess) { fprintf(stderr, "kernel_launch: hipFuncSetAttribute failed\n"); grid = -1; return; }
        if (hipOccupancyMaxActiveBlocksPerMultiprocessor(&per_cu, (const void*)mk_fwd, NTHR, LDS_BYTES) != hipSuccess || per_cu < 1) fprintf(stderr, "kernel_launch: occupancy query reports %d\n", per_cu);
        (void)hipGetLastError();
        grid = cus < 256 ? cus : 256;
        while (T % grid) --grid;
    }
    if (grid < 0) return;
    (void)hipMemsetAsync((char*)d_ws + O_CTL, 0, CTL_BYTES, stream);
    Args a{};
    for (int i = 0; i < 33; ++i) a.in[i] = (const float*)d_in[i];
    a.out = (float*)d_out; a.ws = (unsigned char*)d_ws;
#if N_LAUNCH_MODE == 1
    a.ph_lo = 0; a.ph_hi = N_PHASES;
    hipLaunchKernelGGL(mk_fwd, dim3(grid), dim3(NTHR), LDS_BYTES, stream, a);
#else
    for (int p = 0; p < N_PHASES; ++p) { a.ph_lo = p; a.ph_hi = p + 1; hipLaunchKernelGGL(mk_fwd, dim3(grid), dim3(NTHR), LDS_BYTES, stream, a); }
#endif
}
```
